# Optimizing an MI355X kernel written in HIP

```python
import math
import jax, jax.numpy as jnp
from jax import lax
import numpy as np

D_MODEL = 1024
BATCH = 16
SEQ = 4096
DEPTH = 1

MEM_LEN = 256
POOL_WIDTH = D_MODEL // 2
POOL_WINDOWS = (2, 4, 8, 16)
POOL_GROUP = POOL_WIDTH // len(POOL_WINDOWS)
ATTN_WIDTH = D_MODEL - POOL_WIDTH
ATTN_HEAD_DIM = 64
ATTN_HEADS = ATTN_WIDTH // ATTN_HEAD_DIM
IN_WIDTH = POOL_WIDTH + 3 * ATTN_WIDTH
MOBA_BLOCK = 256
MOBA_TOPK = 3
Q_CHUNK = 16
XATTN_HEADS = 4
XATTN_HEAD_DIM = D_MODEL // XATTN_HEADS
D_FF = -(-8 * D_MODEL // (3 * 256)) * 256
DEEPNORM_ALPHA = (2.0 * DEPTH) ** 0.25
DEEPNORM_BETA = (8.0 * DEPTH) ** -0.25
LN_EPS = 1e-5

kernel_name = "hymba_pool_moba_deepnorm_layer"


def layer_norm(x, g, b):
    xf = x.astype(jnp.float32)
    mu = jnp.mean(xf, axis=-1, keepdims=True)
    var = jnp.mean(jnp.square(xf - mu), axis=-1, keepdims=True)
    return ((xf - mu) * lax.rsqrt(var + LN_EPS) * g + b).astype(x.dtype)


def multiscale_pool(u, w_pool, pool_scale):
    B_, S_, _ = u.shape
    uf = u.astype(jnp.float32)
    cs = jnp.pad(jnp.cumsum(uf, axis=1), ((0, 0), (1, 0), (0, 0)))
    t = jnp.arange(S_)
    groups = []
    for g, w in enumerate(POOL_WINDOWS):
        sl = slice(g * POOL_GROUP, (g + 1) * POOL_GROUP)
        c_hi = cs[:, 1:, sl]
        c_lo = jnp.pad(cs[:, :S_ + 1 - w, sl], ((0, 0), (w - 1, 0), (0, 0)))
        count = jnp.minimum(t + 1, w).astype(jnp.float32)[None, :, None]
        groups.append((c_hi - c_lo) / count - uf[..., sl])
    pooled = jnp.stack(groups, axis=2)
    mixed = jnp.einsum('bsgc,gcd->bsgd', pooled, w_pool.astype(jnp.float32))
    return (mixed.reshape(B_, S_, POOL_WIDTH) * pool_scale).astype(u.dtype)


def moba_attention(q, k, v):
    B_, S_, H, Dh = q.shape
    nb = -(-S_ // MOBA_BLOCK)
    s_pad = nb * MOBA_BLOCK
    pad = ((0, 0), (0, s_pad - S_), (0, 0), (0, 0))
    q, k, v = [jnp.pad(a, pad).transpose(0, 2, 1, 3) for a in (q, k, v)]
    kb = k.reshape(B_, H, nb, MOBA_BLOCK, Dh)
    vb = v.reshape(B_, H, nb, MOBA_BLOCK, Dh)
    k_mean = jnp.mean(kb.astype(jnp.float32), axis=3)
    topk = min(MOBA_TOPK, nb - 1)
    scale = ATTN_HEAD_DIM ** -0.5
    n_chunks = -(-S_ // Q_CHUNK)
    gather_blocks = jax.vmap(jax.vmap(lambda tab, ix: tab[ix]))

    def chunk_fn(ci):
        q0 = ci * Q_CHUNK
        blk = q0 // MOBA_BLOCK
        qc = lax.dynamic_slice_in_dim(q, q0, Q_CHUNK, axis=2)
        k_own = lax.dynamic_slice_in_dim(k, blk * MOBA_BLOCK, MOBA_BLOCK, axis=2)
        v_own = lax.dynamic_slice_in_dim(v, blk * MOBA_BLOCK, MOBA_BLOCK, axis=2)
        qpos = q0 + jnp.arange(Q_CHUNK)
        kpos = blk * MOBA_BLOCK + jnp.arange(MOBA_BLOCK)
        s_own = jnp.einsum('bhqd,bhkd->bhqk', qc, k_own,
                           preferred_element_type=jnp.float32) * scale
        s_own = jnp.where(kpos[None, :] <= qpos[:, None], s_own, -jnp.inf)
        if topk > 0:
            gate = jnp.einsum('bhqd,bhnd->bhqn', qc.astype(jnp.float32), k_mean)
            gate = jnp.where(jnp.arange(nb) < blk, gate, -jnp.inf)
            _, idx = lax.top_k(gate, topk)
            valid = idx < blk
            k_sel = gather_blocks(kb, idx)
            v_sel = gather_blocks(vb, idx)
            s_sel = jnp.einsum('bhqd,bhqnkd->bhqnk', qc, k_sel,
                               preferred_element_type=jnp.float32) * scale
            s_sel = jnp.where(valid[..., None], s_sel, -jnp.inf)
            s_sel = s_sel.reshape(B_, H, Q_CHUNK, topk * MOBA_BLOCK)
            p = jax.nn.softmax(jnp.concatenate([s_sel, s_own], axis=-1), axis=-1)
            p_sel = p[..., :topk * MOBA_BLOCK].reshape(B_, H, Q_CHUNK, topk, MOBA_BLOCK)
            p_own = p[..., topk * MOBA_BLOCK:]
            o = (jnp.einsum('bhqnk,bhqnkd->bhqd', p_sel.astype(v.dtype), v_sel,
                            preferred_element_type=jnp.float32)
                 + jnp.einsum('bhqk,bhkd->bhqd', p_own.astype(v.dtype), v_own,
                              preferred_element_type=jnp.float32))
        else:
            p_own = jax.nn.softmax(s_own, axis=-1)
            o = jnp.einsum('bhqk,bhkd->bhqd', p_own.astype(v.dtype), v_own,
                           preferred_element_type=jnp.float32)
        return o.astype(q.dtype)

    out = lax.map(chunk_fn, jnp.arange(n_chunks))
    out = out.transpose(1, 0, 3, 2, 4).reshape(B_, n_chunks * Q_CHUNK, H, Dh)
    return out[:, :S_]


def memory_cross_attention(h, mem, w_xq, w_xkv, w_xo):
    B_, S_, D = h.shape
    M = mem.shape[1]
    q = (h @ w_xq).reshape(B_, S_, XATTN_HEADS, XATTN_HEAD_DIM)
    kv = mem @ w_xkv
    k = kv[..., :D].reshape(B_, M, XATTN_HEADS, XATTN_HEAD_DIM)
    v = kv[..., D:].reshape(B_, M, XATTN_HEADS, XATTN_HEAD_DIM)
    s = jnp.einsum('bshd,bmhd->bhsm', q, k,
                   preferred_element_type=jnp.float32) * (XATTN_HEAD_DIM ** -0.5)
    p = jax.nn.softmax(s, axis=-1)
    o = jnp.einsum('bhsm,bmhd->bshd', p.astype(v.dtype), v).reshape(B_, S_, D)
    return o @ w_xo


def swiglu(h, w_gate, w_up, w_down):
    return (jax.nn.silu(h @ w_gate) * (h @ w_up)) @ w_down


def setup_inputs(seed: int = 0) -> dict:
    key = jax.random.key(seed)
    ks = jax.random.split(key, 20)
    f32 = jnp.float32
    nrm = lambda k, shape, s: jax.random.normal(k, shape, f32) * s
    L, D = DEPTH, D_MODEL
    return {
        "x": nrm(ks[0], (BATCH, SEQ, D), 1.0),
        "mem": nrm(ks[1], (BATCH, MEM_LEN, D), 1.0),
        "w_in": nrm(ks[2], (L, D, IN_WIDTH), D ** -0.5),
        "w_pool": nrm(ks[3], (L, len(POOL_WINDOWS), POOL_GROUP, POOL_GROUP), POOL_GROUP ** -0.5),
        "pool_scale": 1.0 + nrm(ks[4], (L, POOL_WIDTH), 0.02),
        "w_out": nrm(ks[5], (L, D, D), D ** -0.5 * DEEPNORM_BETA),
        "ln1_g": 1.0 + nrm(ks[6], (L, D), 0.02),
        "ln1_b": nrm(ks[7], (L, D), 0.02),
        "w_xq": nrm(ks[8], (L, D, D), D ** -0.5),
        "w_xkv": nrm(ks[9], (L, D, 2 * D), D ** -0.5),
        "w_xo": nrm(ks[10], (L, D, D), D ** -0.5 * DEEPNORM_BETA),
        "ln2_g": 1.0 + nrm(ks[11], (L, D), 0.02),
        "ln2_b": nrm(ks[12], (L, D), 0.02),
        "w_gate": nrm(ks[13], (L, D, D_FF), D ** -0.5),
        "w_up": nrm(ks[14], (L, D, D_FF), D ** -0.5),
        "w_down": nrm(ks[15], (L, D_FF, D), D_FF ** -0.5 * DEEPNORM_BETA),
        "ln3_g": 1.0 + nrm(ks[16], (L, D), 0.02),
        "ln3_b": nrm(ks[17], (L, D), 0.02),
    }


def reference(x, mem, w_in, w_pool, pool_scale, w_out, ln1_g, ln1_b, w_xq, w_xkv, w_xo,
              ln2_g, ln2_b, w_gate, w_up, w_down, ln3_g, ln3_b):
    B_, S_, _ = x.shape
    h = x
    for l in range(DEPTH):
        z = h @ w_in[l]
        u = z[..., :POOL_WIDTH]
        q = z[..., POOL_WIDTH:POOL_WIDTH + ATTN_WIDTH].reshape(B_, S_, ATTN_HEADS, ATTN_HEAD_DIM)
        k = z[..., POOL_WIDTH + ATTN_WIDTH:POOL_WIDTH + 2 * ATTN_WIDTH].reshape(B_, S_, ATTN_HEADS, ATTN_HEAD_DIM)
        v = z[..., POOL_WIDTH + 2 * ATTN_WIDTH:].reshape(B_, S_, ATTN_HEADS, ATTN_HEAD_DIM)
        pool_out = multiscale_pool(u, w_pool[l], pool_scale[l])
        attn_out = moba_attention(q, k, v).reshape(B_, S_, ATTN_WIDTH)
        mix = jnp.concatenate([pool_out, attn_out], axis=-1) @ w_out[l]
        h = layer_norm(DEEPNORM_ALPHA * h + mix, ln1_g[l], ln1_b[l])
        h = layer_norm(DEEPNORM_ALPHA * h + memory_cross_attention(h, mem, w_xq[l], w_xkv[l], w_xo[l]),
                       ln2_g[l], ln2_b[l])
        h = layer_norm(DEEPNORM_ALPHA * h + swiglu(h, w_gate[l], w_up[l], w_down[l]),
                       ln3_g[l], ln3_b[l])
    return h
```

```cpp
#include <hip/hip_runtime.h>
#include <hip/hip_cooperative_groups.h>
#include <cstdio>
#include <cstdint>
namespace cg = cooperative_groups;

#ifndef N_LAUNCH_MODE
#define N_LAUNCH_MODE 0
#endif

#define LAS __attribute__((address_space(3)))
typedef unsigned short bf16_t;
typedef short bf16x8 __attribute__((ext_vector_type(8)));
typedef short s16x4 __attribute__((ext_vector_type(4)));
typedef float f32x4 __attribute__((ext_vector_type(4)));
typedef float f32x2 __attribute__((ext_vector_type(2)));
typedef unsigned u32x4 __attribute__((ext_vector_type(4)));
typedef unsigned u32x2 __attribute__((ext_vector_type(2)));

constexpr int BATCH = 16, SEQ = 4096, DM = 1024, TOK = BATCH * SEQ;
constexpr int MEMLEN = 256, MEMROWS = BATCH * MEMLEN;
constexpr int INW = 2048, DFF = 2816, NBLK = SEQ / 256;
constexpr float ALPHA = 1.189207115002721f;
constexpr float LN_EPS = 1e-5f;
constexpr float LOG2E = 1.4426950408889634f;

constexpr size_t MiB = 1u << 20;
constexpr size_t WS_KM = 0;
constexpr size_t WS_CTL = 1 * MiB, CTL_BYTES = 16384;
constexpr size_t WS_WIN = 2 * MiB, WS_WOUT = 6 * MiB, WS_WXQ = 8 * MiB, WS_WXKV = 10 * MiB, WS_WXO = 14 * MiB, WS_WGU = 16 * MiB, WS_WDN = 27 * MiB, WS_WPOOL = 33 * MiB;
constexpr size_t WS_MEMB = 34 * MiB, WS_MEMKV = 42 * MiB;
constexpr size_t WS_XB = 64 * MiB;
constexpr size_t WS_Z = 192 * MiB;
constexpr size_t WS_MIX = 448 * MiB;
constexpr size_t WS_HF = 192 * MiB;
constexpr size_t WS_PST1 = 576 * MiB, WS_PST2 = 584 * MiB;
constexpr size_t WS_CDX = 60 * MiB, WS_CDG = 60 * MiB + 65536;
constexpr size_t WS_CDB = 60 * MiB + 131072;
constexpr size_t WS_BTM = 592 * MiB, WS_BTN = 624 * MiB;
constexpr size_t WS_END = 656 * MiB;

typedef __bf16 bf16x2_t __attribute__((ext_vector_type(2)));
__device__ __forceinline__ unsigned cvt_pk_bf16(float lo, float hi) { f32x2 v = {lo, hi}; bf16x2_t b = __builtin_convertvector(v, bf16x2_t); return __builtin_bit_cast(unsigned, b); }
__device__ __forceinline__ float xmax16(float v) { auto r = __builtin_amdgcn_permlane16_swap(__float_as_uint(v), __float_as_uint(v), false, false); return fmaxf(__uint_as_float(r[0]), __uint_as_float(r[1])); }
__device__ __forceinline__ float xmax32(float v) { auto r = __builtin_amdgcn_permlane32_swap(__float_as_uint(v), __float_as_uint(v), false, false); return fmaxf(__uint_as_float(r[0]), __uint_as_float(r[1])); }
__device__ __forceinline__ float xsum16(float v) { auto r = __builtin_amdgcn_permlane16_swap(__float_as_uint(v), __float_as_uint(v), false, false); return __uint_as_float(r[0]) + __uint_as_float(r[1]); }
__device__ __forceinline__ float xsum32(float v) { auto r = __builtin_amdgcn_permlane32_swap(__float_as_uint(v), __float_as_uint(v), false, false); return __uint_as_float(r[0]) + __uint_as_float(r[1]); }
__device__ __forceinline__ float bf2f(unsigned short b) { return __uint_as_float(((unsigned)b) << 16); }
__device__ __forceinline__ float wave_sum(float v) {
#pragma unroll
    for (int o = 1; o < 64; o <<= 1) v += __shfl_xor(v, o);
    return v;
}

namespace pg8 {
constexpr int BM = 256, BK = 64, HALF = 128, HTB = HALF * BK * 2, STAGE_BYTES = 8 * HTB, NXCD = 8, WGM = 4;
__host__ __device__ __forceinline__ int lds_byte(int r, int c) { const int st = (r >> 4) * 2 + (c >> 5), rr = r & 15, cc = c & 31, ob = rr * 64 + cc * 2; return st * 1024 + (ob ^ (((ob >> 9) & 1) << 5)); }
__host__ __device__ __forceinline__ void stage_rc(int b, int& R, int& C) { const int st = b / 1024, sb = b % 1024, swz = sb ^ (((sb >> 9) & 1) << 5); R = (st >> 1) * 16 + swz / 64; C = (st & 1) * 32 + (swz % 64) / 2; }
__host__ __device__ __forceinline__ int perm32(int rho) { const int n = rho >> 4, i = rho & 15; return 8 * (i >> 2) + 4 * n + (i & 3); }

struct Unit { int pm, pn; };
struct Gemm { const bf16_t* A; const bf16_t* Bt; int M, N, K; int lda = 0, ldb = 0, mode = 0; size_t s1 = 0; };
__device__ __forceinline__ void unit_ptrs(const Gemm& g, const Unit& u, const char*& cA, const char*& cB) {
    const int lda = g.lda ? g.lda : g.K, ldb = g.ldb ? g.ldb : g.K;
    if (g.mode <= 1) { cA = (const char*)g.A + (size_t)u.pm * BM * lda * 2; cB = (const char*)g.Bt + (size_t)u.pn * BM * ldb * 2 + (g.mode == 1 ? (size_t)(u.pm >> 4) * g.s1 : 0); }
    else if (g.mode == 2) { cA = (const char*)g.A + (size_t)(u.pm >> 2) * 256 * lda * 2 + (size_t)(u.pm & 3) * 512; cB = (const char*)g.Bt + (size_t)u.pn * BM * ldb * 2 + (size_t)(u.pm & 3) * 512; }
    else { cA = (const char*)g.A + (size_t)u.pn * BM * lda * 2 + (size_t)(u.pm & 3) * 512; cB = (const char*)g.Bt + (size_t)(u.pm >> 2) * 256 * ldb * 2 + (size_t)(u.pm & 3) * 512; }
}

struct StaticOrder {
    int nM, nN, nwg, G, c, wgm;
    __device__ void init(int M, int N, int G_, int c_, int wgm_ = WGM) { nM = M / BM; nN = N / BM; nwg = nM * nN; G = G_; c = c_; wgm = wgm_; }
    __device__ bool next(int i, Unit& u) const {
        const long L = (long)i * G + c; if (L >= nwg) return false;
        int wgid = (int)L; { const int q = nwg / NXCD, r = nwg % NXCD, xcd = wgid % NXCD, off = wgid / NXCD; wgid = (xcd < r ? xcd * (q + 1) : r * (q + 1) + (xcd - r) * q) + off; }
        const int nig = wgm * nN, gid = wgid / nig, fm = gid * wgm, gsz = (nM - fm) < wgm ? (nM - fm) : wgm;
        u.pm = fm + ((wgid % nig) % gsz); u.pn = (wgid % nig) / gsz; return true;
    }
};

struct EpiBf16 {
    static constexpr bool PERM = true;
    bf16_t* O; int ldc;
    __device__ __forceinline__ void operator()(const f32x4 (&acc)[2][2][4][2], const Unit& u, int wr, int wc, int fr, int fq) const {
        const int row0 = u.pm * BM + wr * 64 + fr; const int col0 = u.pn * BM + wc * 32 + 8 * fq;
#pragma unroll
        for (int ai = 0; ai < 2; ++ai)
#pragma unroll
            for (int m = 0; m < 4; ++m) { bf16_t* rowp = O + (size_t)(row0 + ai * HALF + m * 16) * ldc + col0;
#pragma unroll
                for (int bj = 0; bj < 2; ++bj) { const f32x4 v0 = acc[ai][bj][m][0], v1 = acc[ai][bj][m][1];
                    u32x4 w; w.x = cvt_pk_bf16(v0[0], v0[1]); w.y = cvt_pk_bf16(v0[2], v0[3]); w.z = cvt_pk_bf16(v1[0], v1[1]); w.w = cvt_pk_bf16(v1[2], v1[3]);
                    *(u32x4*)(rowp + bj * HALF) = w; } }
    }
};
__device__ __forceinline__ void row_stats(const float* pst, int row, int fq, float& mu, float& rstd) {
    const f32x4 a = *(const f32x4*)(pst + (size_t)row * 32 + 8 * fq), b = *(const f32x4*)(pst + (size_t)row * 32 + 8 * fq + 4);
    float s1 = (a[0] + a[2]) + (b[0] + b[2]), s2 = (a[1] + a[3]) + (b[1] + b[3]);
    s1 = xsum32(xsum16(s1)); s2 = xsum32(xsum16(s2));
    mu = s1 * (1.0f / 1024.0f); const float var = s2 * (1.0f / 1024.0f) - mu * mu; rstd = 1.0f / sqrtf(var + LN_EPS);
}
template <bool HAS_LN, bool HAS_OUT> struct EpiResStat {
    static constexpr bool PERM = true;
    const bf16_t* R; bf16_t* YB; int ldc; float alpha; const float* st_in; const float* g; const float* b; float* st_out;
    __device__ __forceinline__ void operator()(const f32x4 (&acc)[2][2][4][2], const Unit& u, int wr, int wc, int fr, int fq) const {
        const int row0 = u.pm * BM + wr * 64 + fr; const int col0 = u.pn * BM + wc * 32 + 8 * fq;
        f32x4 gv[2][2], bv[2][2];
        if (HAS_LN) {
#pragma unroll
            for (int bj = 0; bj < 2; ++bj)
#pragma unroll
                for (int n = 0; n < 2; ++n) { gv[bj][n] = *(const f32x4*)(g + col0 + bj * HALF + 4 * n); bv[bj][n] = *(const f32x4*)(b + col0 + bj * HALF + 4 * n); }
        }
#pragma unroll
        for (int ai = 0; ai < 2; ++ai)
#pragma unroll
            for (int m = 0; m < 4; ++m) { const int row = row0 + ai * HALF + m * 16; const size_t off = (size_t)row * ldc + col0;
                float mu = 0.f, rs = 1.f; if (HAS_LN) row_stats(st_in, row, fq, mu, rs);
                float s1 = 0.f, s2 = 0.f;
#pragma unroll
                for (int bj = 0; bj < 2; ++bj) { const u32x4 rr = *(const u32x4*)(R + off + bj * HALF);
                    f32x4 v0 = (f32x4){__uint_as_float(rr.x << 16), __uint_as_float(rr.x & 0xffff0000u), __uint_as_float(rr.y << 16), __uint_as_float(rr.y & 0xffff0000u)};
                    f32x4 v1 = (f32x4){__uint_as_float(rr.z << 16), __uint_as_float(rr.z & 0xffff0000u), __uint_as_float(rr.w << 16), __uint_as_float(rr.w & 0xffff0000u)};
                    if (HAS_LN) { v0 = (v0 - mu) * rs * gv[bj][0] + bv[bj][0]; v1 = (v1 - mu) * rs * gv[bj][1] + bv[bj][1]; }
                    const f32x4 y0 = v0 * alpha + acc[ai][bj][m][0], y1 = v1 * alpha + acc[ai][bj][m][1];
                    u32x4 w; w.x = cvt_pk_bf16(y0[0], y0[1]); w.y = cvt_pk_bf16(y0[2], y0[3]); w.z = cvt_pk_bf16(y1[0], y1[1]); w.w = cvt_pk_bf16(y1[2], y1[3]);
                    *(u32x4*)(YB + off + bj * HALF) = w;
                    s1 += ((y0[0] + y0[1]) + (y0[2] + y0[3])) + ((y1[0] + y1[1]) + (y1[2] + y1[3]));
                    s2 += ((y0[0] * y0[0] + y0[1] * y0[1]) + (y0[2] * y0[2] + y0[3] * y0[3])) + ((y1[0] * y1[0] + y1[1] * y1[1]) + (y1[2] * y1[2] + y1[3] * y1[3])); }
                if (HAS_OUT) { s1 = xsum32(xsum16(s1)); s2 = xsum32(xsum16(s2));
                    if (fq == 0) *(f32x2*)(st_out + (size_t)row * 32 + (u.pn * 4 + wc) * 2) = (f32x2){s1, s2}; } }
    }
};
struct EpiLnBf16 {
    static constexpr bool PERM = true;
    bf16_t* O; int ldc; const float* st_in; const float* cvec; const float* dvec;
    __device__ __forceinline__ void operator()(const f32x4 (&acc)[2][2][4][2], const Unit& u, int wr, int wc, int fr, int fq) const {
        const int row0 = u.pm * BM + wr * 64 + fr; const int col0 = u.pn * BM + wc * 32 + 8 * fq;
        f32x4 cv[2][2], dv[2][2];
#pragma unroll
        for (int bj = 0; bj < 2; ++bj)
#pragma unroll
            for (int n = 0; n < 2; ++n) { cv[bj][n] = *(const f32x4*)(cvec + col0 + bj * HALF + 4 * n); dv[bj][n] = *(const f32x4*)(dvec + col0 + bj * HALF + 4 * n); }
#pragma unroll
        for (int ai = 0; ai < 2; ++ai)
#pragma unroll
            for (int m = 0; m < 4; ++m) { const int row = row0 + ai * HALF + m * 16; bf16_t* rowp = O + (size_t)row * ldc + col0;
                float mu, rs; row_stats(st_in, row, fq, mu, rs);
#pragma unroll
                for (int bj = 0; bj < 2; ++bj) { const f32x4 v0 = (acc[ai][bj][m][0] - cv[bj][0] * mu) * rs + dv[bj][0], v1 = (acc[ai][bj][m][1] - cv[bj][1] * mu) * rs + dv[bj][1];
                    u32x4 w; w.x = cvt_pk_bf16(v0[0], v0[1]); w.y = cvt_pk_bf16(v0[2], v0[3]); w.z = cvt_pk_bf16(v1[0], v1[1]); w.w = cvt_pk_bf16(v1[2], v1[3]);
                    *(u32x4*)(rowp + bj * HALF) = w; } }
    }
};
struct EpiLnSwiGLU {
    static constexpr bool PERM = false;
    bf16_t* O; int ldc; const float* st_in; const float* cvec; const float* dvec;
    __device__ __forceinline__ void operator()(const f32x4 (&acc)[2][2][4][2], const Unit& u, int wr, int wc, int fr, int fq) const {
        const int row0 = u.pm * BM + wr * 64 + fr; const int col0 = u.pn * HALF + wc * 16 + 4 * fq; const int gcol0 = u.pn * BM + wc * 32 + 4 * fq;
        f32x4 cv[2][2], dv[2][2];
#pragma unroll
        for (int bj = 0; bj < 2; ++bj)
#pragma unroll
            for (int n = 0; n < 2; ++n) { cv[bj][n] = *(const f32x4*)(cvec + gcol0 + bj * HALF + 16 * n); dv[bj][n] = *(const f32x4*)(dvec + gcol0 + bj * HALF + 16 * n); }
#pragma unroll
        for (int ai = 0; ai < 2; ++ai)
#pragma unroll
            for (int m = 0; m < 4; ++m) { const int row = row0 + ai * HALF + m * 16; bf16_t* rowp = O + (size_t)row * ldc + col0;
                float mu, rs; row_stats(st_in, row, fq, mu, rs);
#pragma unroll
                for (int bj = 0; bj < 2; ++bj) { const f32x4 g = (acc[ai][bj][m][0] - cv[bj][0] * mu) * rs + dv[bj][0], up = (acc[ai][bj][m][1] - cv[bj][1] * mu) * rs + dv[bj][1]; float h[4];
#pragma unroll
                    for (int j = 0; j < 4; ++j) { const float s = g[j] * __builtin_amdgcn_rcpf(1.0f + __builtin_amdgcn_exp2f(-g[j] * LOG2E)); h[j] = s * up[j]; }
                    u32x2 w; w.x = cvt_pk_bf16(h[0], h[1]); w.y = cvt_pk_bf16(h[2], h[3]);
                    *(u32x2*)(rowp + bj * 64) = w; } }
    }
};

struct EpiPrep {
    static constexpr bool PERM = true;
    bf16_t* O; float scale; int omode;
    __device__ __forceinline__ void operator()(const f32x4 (&acc)[2][2][4][2], const Unit& u, int wr, int wc, int fr, int fq) const {
        bf16_t* base = (omode == 0) ? O + (size_t)u.pm * 256 * 1024 + u.pn * 256 : O + (size_t)(u.pm >> 2) * 1048576 + (size_t)u.pn * 256 * 1024 + (u.pm & 3) * 256;
        base += (size_t)(wr * 64 + fr) * 1024 + wc * 32 + 8 * fq;
#pragma unroll
        for (int ai = 0; ai < 2; ++ai)
#pragma unroll
            for (int m = 0; m < 4; ++m) { bf16_t* rowp = base + (size_t)(ai * HALF + m * 16) * 1024;
#pragma unroll
                for (int bj = 0; bj < 2; ++bj) { const f32x4 v0 = acc[ai][bj][m][0] * scale, v1 = acc[ai][bj][m][1] * scale;
                    u32x4 w; w.x = cvt_pk_bf16(v0[0], v0[1]); w.y = cvt_pk_bf16(v0[2], v0[3]); w.z = cvt_pk_bf16(v1[0], v1[1]); w.w = cvt_pk_bf16(v1[2], v1[3]);
                    *(u32x4*)(rowp + bj * HALF) = w; } }
    }
};
struct EpiSoftmaxP {
    static constexpr bool PERM = true;
    bf16_t* P; const float* st_in; const float* cb; const float* db; LAS float* xb;
    __device__ __forceinline__ void operator()(f32x4 (&acc)[2][2][4][2], const Unit& u, int wr, int wc, int fr, int fq) const {
        const int rl0 = wr * 64 + fr; const int col0 = u.pn * BM + wc * 32 + 8 * fq; const int bt = u.pm >> 4;
        {
            f32x4 cv[2][2], dv[2][2];
#pragma unroll
            for (int bj = 0; bj < 2; ++bj)
#pragma unroll
                for (int n = 0; n < 2; ++n) { cv[bj][n] = *(const f32x4*)(cb + bt * 1024 + col0 + bj * HALF + 4 * n); dv[bj][n] = *(const f32x4*)(db + bt * 1024 + col0 + bj * HALF + 4 * n); }
#pragma unroll
            for (int ai = 0; ai < 2; ++ai)
#pragma unroll
                for (int m = 0; m < 4; ++m) { const int rl = rl0 + ai * HALF + m * 16;
                    float mu, rs; row_stats(st_in, u.pm * BM + rl, fq, mu, rs);
                    float mx = -INFINITY;
#pragma unroll
                    for (int bj = 0; bj < 2; ++bj)
#pragma unroll
                        for (int n = 0; n < 2; ++n) { const f32x4 s = (acc[ai][bj][m][n] - cv[bj][n] * mu) * rs + dv[bj][n]; acc[ai][bj][m][n] = s;
                            mx = fmaxf(fmaxf(mx, s[0]), fmaxf(s[1], fmaxf(s[2], s[3]))); }
                    mx = xmax32(xmax16(mx));
                    if (fq == 0) xb[rl * 4 + wc] = mx; }
        }
        asm volatile("s_waitcnt lgkmcnt(0)" ::: "memory"); __builtin_amdgcn_s_barrier(); asm volatile("" ::: "memory");
#pragma unroll
        for (int ai = 0; ai < 2; ++ai)
#pragma unroll
            for (int m = 0; m < 4; ++m) { const int rl = rl0 + ai * HALF + m * 16;
                const f32x4 mm = *(const LAS f32x4*)(xb + rl * 4); const float rmax = fmaxf(fmaxf(mm[0], mm[1]), fmaxf(mm[2], mm[3])) * LOG2E;
                float sm = 0.f;
#pragma unroll
                for (int bj = 0; bj < 2; ++bj)
#pragma unroll
                    for (int n = 0; n < 2; ++n) { f32x4 p;
#pragma unroll
                        for (int j = 0; j < 4; ++j) p[j] = __builtin_amdgcn_exp2f(__builtin_fmaf(acc[ai][bj][m][n][j], LOG2E, -rmax));
                        acc[ai][bj][m][n] = p; sm += (p[0] + p[1]) + (p[2] + p[3]); }
                sm = xsum32(xsum16(sm));
                if (fq == 0) xb[1024 + rl * 4 + wc] = sm; }
        asm volatile("s_waitcnt lgkmcnt(0)" ::: "memory"); __builtin_amdgcn_s_barrier(); asm volatile("" ::: "memory");
#pragma unroll
        for (int ai = 0; ai < 2; ++ai)
#pragma unroll
            for (int m = 0; m < 4; ++m) { const int rl = rl0 + ai * HALF + m * 16;
                const f32x4 ss = *(const LAS f32x4*)(xb + 1024 + rl * 4); const float inv = 1.0f / ((ss[0] + ss[1]) + (ss[2] + ss[3]));
                bf16_t* rowp = P + (size_t)(u.pm * BM + rl) * 1024 + col0;
#pragma unroll
                for (int bj = 0; bj < 2; ++bj) { const f32x4 v0 = acc[ai][bj][m][0] * inv, v1 = acc[ai][bj][m][1] * inv;
                    u32x4 w; w.x = cvt_pk_bf16(v0[0], v0[1]); w.y = cvt_pk_bf16(v0[2], v0[3]); w.z = cvt_pk_bf16(v1[0], v1[1]); w.w = cvt_pk_bf16(v1[2], v1[3]);
                    *(u32x4*)(rowp + bj * HALF) = w; } }
    }
};

template <class Epi, class Sched>
__device__ __forceinline__ void gemm_phase(LAS unsigned char* lds, const Gemm g, const Sched S, const Epi E) {
    const int tid = threadIdx.x, wid = __builtin_amdgcn_readfirstlane(tid >> 6), lane = tid & 63, wr = wid >> 2, wc = wid & 3, fr = lane & 15, fq = lane >> 4;
    const int K = g.K, nt = K / BK;
    const int lda = g.lda ? g.lda : K, ldb = g.ldb ? g.ldb : K;
    unsigned voffA[2], voffB[2];
#pragma unroll
    for (int i = 0; i < 2; ++i) { int R, C; stage_rc(tid * 16 + i * 8192, R, C); const int Rb = Epi::PERM ? ((R & ~31) + perm32(R & 31)) : R;
        voffA[i] = (unsigned)(R * lda + C) * 2u; voffB[i] = (unsigned)(Rb * ldb + C) * 2u; }
    const size_t kstep = (size_t)(BK * 2);
    const size_t hstepA = (size_t)HALF * lda * 2, hstepB = (size_t)HALF * ldb * 2;
    const unsigned ldsw = (unsigned)wid * 1024u;
    const int aoff = lds_byte(wr * 64 + fr, fq * 8), boff = lds_byte(wc * 32 + fr, fq * 8);
#define PG8_SA(b, h) (((b) * 2 + (h)) * HTB)
#define PG8_SB(b, h) ((4 + (b) * 2 + (h)) * HTB)
#define PG8_STAGE(bufoff, gbase, voff) do { _Pragma("unroll") for (int _i = 0; _i < 2; ++_i) \
        __builtin_amdgcn_global_load_lds((const unsigned*)((const char*)(gbase) + (voff)[_i]), (LAS unsigned*)(lds + (bufoff) + ldsw + _i * 8192), 16, 0, 0); } while (0)
#define PG8_LDA(dst, b, h) do { _Pragma("unroll") for (int m = 0; m < 4; ++m) _Pragma("unroll") for (int k = 0; k < 2; ++k) dst[m][k] = *(const LAS bf16x8*)(lds + PG8_SA(b, h) + aoff + m * 2048 + k * 1024); } while (0)
#define PG8_LDB(dst, b, h) do { _Pragma("unroll") for (int n = 0; n < 2; ++n) _Pragma("unroll") for (int k = 0; k < 2; ++k) dst[n][k] = *(const LAS bf16x8*)(lds + PG8_SB(b, h) + boff + n * 2048 + k * 1024); } while (0)
#define PG8_MMA(ai, bj, At, Bt) do { __builtin_amdgcn_s_setprio(1); _Pragma("unroll") for (int m = 0; m < 4; ++m) _Pragma("unroll") for (int n = 0; n < 2; ++n) _Pragma("unroll") for (int k = 0; k < 2; ++k) \
        acc[ai][bj][m][n] = __builtin_amdgcn_mfma_f32_16x16x32_bf16(Bt[n][k], At[m][k], acc[ai][bj][m][n], 0, 0, 0); __builtin_amdgcn_s_setprio(0); } while (0)
#define PG8_WAIT_V(n) asm volatile("s_waitcnt vmcnt(" #n ")" ::: "memory")
#define PG8_WAIT_L(n) asm volatile("s_waitcnt lgkmcnt(" #n ")" ::: "memory")
#define PG8_BAR __builtin_amdgcn_s_barrier()
#define PG8_SCHED __builtin_amdgcn_sched_barrier(0)
    Unit cur, nxt; int ui = 0;
    if (!S.next(0, cur)) return;
    f32x4 acc[2][2][4][2];
#pragma unroll
    for (int a = 0; a < 2; ++a)
#pragma unroll
        for (int b = 0; b < 2; ++b)
#pragma unroll
            for (int m = 0; m < 4; ++m)
#pragma unroll
                for (int n = 0; n < 2; ++n) acc[a][b][m][n] = (f32x4){0.f, 0.f, 0.f, 0.f};
    bf16x8 At[4][2], B0[2][2], B1[2][2];
    const char* cA; const char* cB; unit_ptrs(g, cur, cA, cB);
    PG8_STAGE(PG8_SB(0, 0), cB, voffB); PG8_STAGE(PG8_SB(0, 1), cB + hstepB, voffB); PG8_STAGE(PG8_SA(0, 0), cA, voffA); PG8_STAGE(PG8_SA(0, 1), cA + hstepA, voffA);
    if (wr == 1) PG8_BAR;
    PG8_WAIT_V(2); PG8_BAR;
    PG8_STAGE(PG8_SB(1, 0), cB + kstep, voffB); PG8_STAGE(PG8_SA(1, 0), cA + kstep, voffA); PG8_STAGE(PG8_SB(1, 1), cB + hstepB + kstep, voffB);
    PG8_WAIT_V(6); PG8_BAR;
    for (;;) {
        const bool has_next = S.next(ui + 1, nxt);
        const char* nA = cA; const char* nB = cB; if (has_next) unit_ptrs(g, nxt, nA, nB);
#pragma unroll 1
        for (int t = 0; t < nt; t += 2) {
            const bool last = (t == nt - 2);
            const char* a1 = cA + (size_t)(t + 1) * kstep;
            const char* a2 = last ? nA : cA + (size_t)(t + 2) * kstep; const char* b2 = last ? nB : cB + (size_t)(t + 2) * kstep;
            const char* a3 = a2 + kstep; const char* b3 = b2 + kstep;
            PG8_LDB(B0, 0, 0); PG8_LDB(B1, 0, 1); PG8_SCHED; PG8_LDA(At, 0, 0); PG8_STAGE(PG8_SA(1, 1), a1 + hstepA, voffA);
            PG8_WAIT_V(8); PG8_WAIT_L(0); PG8_BAR; PG8_MMA(0, 0, At, B0); PG8_MMA(0, 1, At, B1); PG8_BAR; PG8_SCHED;
            PG8_LDA(At, 0, 1); PG8_STAGE(PG8_SB(0, 0), b2, voffB); PG8_STAGE(PG8_SB(0, 1), b2 + hstepB, voffB); PG8_STAGE(PG8_SA(0, 0), a2, voffA);
            PG8_WAIT_V(8); PG8_WAIT_L(0); PG8_BAR; PG8_MMA(1, 0, At, B0); PG8_MMA(1, 1, At, B1); PG8_BAR; PG8_SCHED;
            PG8_LDB(B0, 1, 0); PG8_LDB(B1, 1, 1); PG8_SCHED; PG8_LDA(At, 1, 0); PG8_STAGE(PG8_SA(0, 1), a2 + hstepA, voffA);
            PG8_WAIT_V(8); PG8_WAIT_L(0); PG8_BAR; PG8_MMA(0, 0, At, B0); PG8_MMA(0, 1, At, B1); PG8_BAR; PG8_SCHED;
            PG8_LDA(At, 1, 1); PG8_STAGE(PG8_SB(1, 0), b3, voffB); PG8_STAGE(PG8_SB(1, 1), b3 + hstepB, voffB); PG8_STAGE(PG8_SA(1, 0), a3, voffA);
            PG8_WAIT_V(8); PG8_WAIT_L(0); PG8_BAR; PG8_MMA(1, 0, At, B0); PG8_MMA(1, 1, At, B1); PG8_BAR; PG8_SCHED;
        }
        if (wr == 0) PG8_BAR;
        E(acc, cur, wr, wc, fr, fq);
        if (!has_next) break;
#pragma unroll
        for (int a = 0; a < 2; ++a)
#pragma unroll
            for (int b = 0; b < 2; ++b)
#pragma unroll
                for (int m = 0; m < 4; ++m)
#pragma unroll
                    for (int n = 0; n < 2; ++n) acc[a][b][m][n] = (f32x4){0.f, 0.f, 0.f, 0.f};
        cur = nxt; cA = nA; cB = nB; ++ui;
        if (wr == 1) PG8_BAR;
    }
    PG8_WAIT_V(0);
    PG8_BAR;
#undef PG8_SA
#undef PG8_SB
#undef PG8_STAGE
#undef PG8_LDA
#undef PG8_LDB
#undef PG8_MMA
#undef PG8_WAIT_V
#undef PG8_WAIT_L
#undef PG8_BAR
#undef PG8_SCHED
}
}

__device__ __forceinline__ s16x4 tr_read(const LAS unsigned char* p) { return __builtin_bit_cast(s16x4, __builtin_amdgcn_ds_read_tr16_b64_v4i16((LAS s16x4*)p)); }

template <int HD, int QI, int KT16 = 4>
__device__ __forceinline__ void attn_tile(const LAS unsigned char* Ks, const LAS unsigned char* Vs, const bf16x8 (&qf)[QI][HD / 32],
                                          float (&m)[QI], float (&l)[QI], f32x4 (&o)[QI][HD / 16], float sc,
                                          int maskmode, const int (&qloc)[QI], int kbase, const bool (&keep)[QI], int fr, int fq) {
    constexpr int KP = 2 * HD + 32;
    f32x4 s[QI][KT16];
#pragma unroll
    for (int qi = 0; qi < QI; ++qi)
#pragma unroll
        for (int kt = 0; kt < KT16; ++kt) s[qi][kt] = (f32x4){0.f, 0.f, 0.f, 0.f};
#pragma unroll
    for (int kt = 0; kt < KT16; ++kt)
#pragma unroll
        for (int dk = 0; dk < HD / 32; ++dk) {
            const bf16x8 kf = *(const LAS bf16x8*)(Ks + (16 * kt + fr) * KP + (32 * dk + 8 * fq) * 2);
#pragma unroll
            for (int qi = 0; qi < QI; ++qi) s[qi][kt] = __builtin_amdgcn_mfma_f32_16x16x32_bf16(kf, qf[qi][dk], s[qi][kt], 0, 0, 0);
        }
    float mxs[QI]; bool need = false;
#pragma unroll
    for (int qi = 0; qi < QI; ++qi) {
        if (maskmode == 1) {
#pragma unroll
            for (int kt = 0; kt < KT16; ++kt)
#pragma unroll
                for (int r = 0; r < 4; ++r) if (kbase + 16 * kt + 4 * fq + r > qloc[qi]) s[qi][kt][r] = -INFINITY;
        }
        float mx = fmaxf(fmaxf(s[qi][0][0], s[qi][0][1]), fmaxf(s[qi][0][2], s[qi][0][3]));
#pragma unroll
        for (int kt = 1; kt < KT16; ++kt) { mx = fmaxf(fmaxf(mx, s[qi][kt][0]), s[qi][kt][1]); mx = fmaxf(fmaxf(mx, s[qi][kt][2]), s[qi][kt][3]); }
        mx = xmax32(xmax16(mx));
        mxs[qi] = mx * sc;
        need = need || (keep[qi] && mxs[qi] > m[qi] + 8.0f);
    }
    if (__ballot(need) != 0ull) {
#pragma unroll
        for (int qi = 0; qi < QI; ++qi) {
            const bool upd = keep[qi] && mxs[qi] > m[qi] + 8.0f;
            const float mn = upd ? mxs[qi] : m[qi];
            const float al = __builtin_amdgcn_exp2f(m[qi] - mn); m[qi] = mn; l[qi] *= al;
#pragma unroll
            for (int dt = 0; dt < HD / 16; ++dt) o[qi][dt] = o[qi][dt] * al;
        }
    }
    bf16x8 pf[QI][KT16 / 2];
#pragma unroll
    for (int qi = 0; qi < QI; ++qi) {
        const float moff = keep[qi] ? -m[qi] : -INFINITY;
        float rs = 0.f;
#pragma unroll
        for (int kt = 0; kt < KT16; ++kt)
#pragma unroll
            for (int r = 0; r < 4; ++r) { const float p = __builtin_amdgcn_exp2f(__builtin_fmaf(s[qi][kt][r], sc, moff)); s[qi][kt][r] = p; rs += p; }
        l[qi] += rs;
#pragma unroll
        for (int p2 = 0; p2 < KT16 / 2; ++p2) {
            u32x4 w; w.x = cvt_pk_bf16(s[qi][2 * p2][0], s[qi][2 * p2][1]); w.y = cvt_pk_bf16(s[qi][2 * p2][2], s[qi][2 * p2][3]);
            w.z = cvt_pk_bf16(s[qi][2 * p2 + 1][0], s[qi][2 * p2 + 1][1]); w.w = cvt_pk_bf16(s[qi][2 * p2 + 1][2], s[qi][2 * p2 + 1][3]);
            pf[qi][p2] = __builtin_bit_cast(bf16x8, w);
        }
    }
    const LAS unsigned char* vb = Vs + (4 * fq + (fr >> 2)) * KP + (4 * (fr & 3)) * 2;
#pragma unroll
    for (int dt = 0; dt < HD / 16; ++dt)
#pragma unroll
        for (int p2 = 0; p2 < KT16 / 2; ++p2) {
            const s16x4 lo = tr_read(vb + (32 * p2) * KP + 32 * dt);
            const s16x4 hi = tr_read(vb + (32 * p2 + 16) * KP + 32 * dt);
            const bf16x8 vf = (bf16x8){lo[0], lo[1], lo[2], lo[3], hi[0], hi[1], hi[2], hi[3]};
#pragma unroll
            for (int qi = 0; qi < QI; ++qi) o[qi][dt] = __builtin_amdgcn_mfma_f32_16x16x32_bf16(vf, pf[qi][p2], o[qi][dt], 0, 0, 0);
        }
}

template <int HD, int QI, int KT16 = 4>
__device__ __forceinline__ void attn_tile_pl(const LAS unsigned char* Ks, const LAS unsigned char* Vs, const bf16x8 (&qf)[QI][HD / 32],
                                          float (&m)[QI], float (&l)[QI], f32x4 (&o)[QI][HD / 16], float sc,
                                          int maskmode, const int (&qloc)[QI], int kbase, const bool (&keep)[QI], int fr, int fq) {
    constexpr int KP = 2 * HD + 32;
    constexpr int NF = (HD / 32) * KT16, CH = 4, NCH = NF / CH;
    static_assert(NF % CH == 0, "fragment chunking");
    f32x4 s[QI][KT16];
#pragma unroll
    for (int qi = 0; qi < QI; ++qi)
#pragma unroll
        for (int kt = 0; kt < KT16; ++kt) s[qi][kt] = (f32x4){0.f, 0.f, 0.f, 0.f};
    const LAS unsigned char* kb = Ks + fr * KP + 16 * fq;
#define KFRAG(f) (*(const LAS bf16x8*)(kb + (16 * ((f) % KT16)) * KP + 64 * ((f) / KT16)))
    bf16x8 kf[2][CH];
#pragma unroll
    for (int i = 0; i < CH; ++i) kf[0][i] = KFRAG(i);
#pragma unroll
    for (int c = 0; c < NCH; ++c) {
        if (c + 1 < NCH) {
#pragma unroll
            for (int i = 0; i < CH; ++i) kf[(c + 1) & 1][i] = KFRAG((c + 1) * CH + i);
        }
        __builtin_amdgcn_sched_barrier(0);
#pragma unroll
        for (int i = 0; i < CH; ++i) { const int f = c * CH + i, kt = f % KT16, dk = f / KT16;
#pragma unroll
            for (int qi = 0; qi < QI; ++qi) s[qi][kt] = __builtin_amdgcn_mfma_f32_16x16x32_bf16(kf[c & 1][i], qf[qi][dk], s[qi][kt], 0, 0, 0); }
        __builtin_amdgcn_sched_barrier(0);
    }
#undef KFRAG
    constexpr int NV = (KT16 / 2) * (HD / 16), NVC = NV / CH;
    static_assert(NV % CH == 0, "V fragment chunking");
    const LAS unsigned char* vb = Vs + (4 * fq + (fr >> 2)) * KP + (4 * (fr & 3)) * 2;
#define VLO(g) tr_read(vb + (32 * ((g) / (HD / 16))) * KP + 32 * ((g) % (HD / 16)))
#define VHI(g) tr_read(vb + (32 * ((g) / (HD / 16)) + 16) * KP + 32 * ((g) % (HD / 16)))
    s16x4 vlo[2][CH], vhi[2][CH];
#pragma unroll
    for (int i = 0; i < CH; ++i) { vlo[0][i] = VLO(i); vhi[0][i] = VHI(i); }
    __builtin_amdgcn_sched_barrier(0);
    float mxs[QI]; bool need = false;
#pragma unroll
    for (int qi = 0; qi < QI; ++qi) {
        if (maskmode == 1) {
#pragma unroll
            for (int kt = 0; kt < KT16; ++kt)
#pragma unroll
                for (int r = 0; r < 4; ++r) if (kbase + 16 * kt + 4 * fq + r > qloc[qi]) s[qi][kt][r] = -INFINITY;
        }
        float mx = fmaxf(fmaxf(s[qi][0][0], s[qi][0][1]), fmaxf(s[qi][0][2], s[qi][0][3]));
#pragma unroll
        for (int kt = 1; kt < KT16; ++kt) { mx = fmaxf(fmaxf(mx, s[qi][kt][0]), s[qi][kt][1]); mx = fmaxf(fmaxf(mx, s[qi][kt][2]), s[qi][kt][3]); }
        mx = xmax32(xmax16(mx));
        mxs[qi] = mx * sc;
        need = need || (keep[qi] && mxs[qi] > m[qi] + 8.0f);
    }
    if (__ballot(need) != 0ull) {
#pragma unroll
        for (int qi = 0; qi < QI; ++qi) {
            const bool upd = keep[qi] && mxs[qi] > m[qi] + 8.0f;
            const float mn = upd ? mxs[qi] : m[qi];
            const float al = __builtin_amdgcn_exp2f(m[qi] - mn); m[qi] = mn; l[qi] *= al;
#pragma unroll
            for (int dt = 0; dt < HD / 16; ++dt) o[qi][dt] = o[qi][dt] * al;
        }
    }
    bf16x8 pf[QI][KT16 / 2];
#pragma unroll
    for (int qi = 0; qi < QI; ++qi) {
        const float moff = keep[qi] ? -m[qi] : -INFINITY;
        float rs = 0.f;
#pragma unroll
        for (int kt = 0; kt < KT16; ++kt)
#pragma unroll
            for (int r = 0; r < 4; ++r) { const float p = __builtin_amdgcn_exp2f(__builtin_fmaf(s[qi][kt][r], sc, moff)); s[qi][kt][r] = p; rs += p; }
        l[qi] += rs;
#pragma unroll
        for (int p2 = 0; p2 < KT16 / 2; ++p2) {
            u32x4 w; w.x = cvt_pk_bf16(s[qi][2 * p2][0], s[qi][2 * p2][1]); w.y = cvt_pk_bf16(s[qi][2 * p2][2], s[qi][2 * p2][3]);
            w.z = cvt_pk_bf16(s[qi][2 * p2 + 1][0], s[qi][2 * p2 + 1][1]); w.w = cvt_pk_bf16(s[qi][2 * p2 + 1][2], s[qi][2 * p2 + 1][3]);
            pf[qi][p2] = __builtin_bit_cast(bf16x8, w);
        }
    }
    __builtin_amdgcn_sched_barrier(0);
#pragma unroll
    for (int c = 0; c < NVC; ++c) {
        if (c + 1 < NVC) {
#pragma unroll
            for (int i = 0; i < CH; ++i) { vlo[(c + 1) & 1][i] = VLO((c + 1) * CH + i); vhi[(c + 1) & 1][i] = VHI((c + 1) * CH + i); }
        }
        __builtin_amdgcn_sched_barrier(0);
#pragma unroll
        for (int i = 0; i < CH; ++i) { const int g = c * CH + i, p2 = g / (HD / 16), dt = g % (HD / 16);
            const s16x4 lo = vlo[c & 1][i], hi = vhi[c & 1][i];
            const bf16x8 vf = (bf16x8){lo[0], lo[1], lo[2], lo[3], hi[0], hi[1], hi[2], hi[3]};
#pragma unroll
            for (int qi = 0; qi < QI; ++qi) o[qi][dt] = __builtin_amdgcn_mfma_f32_16x16x32_bf16(vf, pf[qi][p2], o[qi][dt], 0, 0, 0); }
        __builtin_amdgcn_sched_barrier(0);
    }
#undef VLO
#undef VHI
}

template <int HD> struct Stage { static constexpr int CH = HD / 8, NLD = 64 * CH / 512, KP = 2 * HD + 32, TILE_B = 64 * KP; u32x4 k[NLD], v[NLD]; };
template <int HD>
__device__ __forceinline__ void stage_load(Stage<HD>& st, const bf16_t* Kg, const bf16_t* Vg, int gp, int tid) {
#pragma unroll
    for (int i = 0; i < Stage<HD>::NLD; ++i) { const int idx = tid + 512 * i, row = idx / Stage<HD>::CH, ch = idx % Stage<HD>::CH;
        st.k[i] = *(const u32x4*)(Kg + (size_t)row * gp + ch * 8); st.v[i] = *(const u32x4*)(Vg + (size_t)row * gp + ch * 8); }
}
template <int HD>
__device__ __forceinline__ void stage_store(const Stage<HD>& st, LAS unsigned char* buf, int tid) {
#pragma unroll
    for (int i = 0; i < Stage<HD>::NLD; ++i) { const int idx = tid + 512 * i, row = idx / Stage<HD>::CH, ch = idx % Stage<HD>::CH;
        *(LAS u32x4*)(buf + row * Stage<HD>::KP + ch * 16) = st.k[i]; *(LAS u32x4*)(buf + Stage<HD>::TILE_B + row * Stage<HD>::KP + ch * 16) = st.v[i]; }
}

namespace moba {
constexpr int HD = 64, KP = 2 * HD + 32, BLKB = 256 * KP;
constexpr int L_K = 0, L_V = BLKB, L_O = 2 * BLKB, L_M = L_O + 256 * 128, L_L = L_M + 1024, L_LIST = L_L + 1024, L_CNT = L_LIST + 15 * 256, L_Q = L_CNT + 64, L_END = L_Q + 256 * 128;
struct BlkStage { u32x4 k[4], v[4]; };
__device__ __forceinline__ void blk_load(BlkStage& st, const bf16_t* Kg, const bf16_t* Vg, int tid) {
#pragma unroll
    for (int i = 0; i < 4; ++i) { const int idx = tid + 512 * i, row = idx >> 3, ch = idx & 7;
        st.k[i] = *(const u32x4*)(Kg + (size_t)row * INW + ch * 8); st.v[i] = *(const u32x4*)(Vg + (size_t)row * INW + ch * 8); }
}
__device__ __forceinline__ void blk_store(const BlkStage& st, LAS unsigned char* lds, int tid) {
#pragma unroll
    for (int i = 0; i < 4; ++i) { const int idx = tid + 512 * i, row = idx >> 3, ch = idx & 7;
        *(LAS u32x4*)(lds + L_K + row * KP + ch * 16) = st.k[i]; *(LAS u32x4*)(lds + L_V + row * KP + ch * 16) = st.v[i]; }
}
template <int QI>
__device__ __forceinline__ void past_tiles(LAS unsigned char* lds, const int (&rows)[QI], const bool (&valid)[QI], float sc, int fr, int fq) {
    bf16x8 qf[QI][2]; float m[QI], l[QI]; f32x4 o[QI][4]; int qloc[QI];
#pragma unroll
    for (int qi = 0; qi < QI; ++qi) {
#pragma unroll
        for (int dk = 0; dk < 2; ++dk) qf[qi][dk] = *(const LAS bf16x8*)(lds + L_Q + rows[qi] * 128 + (32 * dk + 8 * fq) * 2);
        m[qi] = *(const LAS float*)(lds + L_M + rows[qi] * 4);
        l[qi] = (fq == 0) ? *(const LAS float*)(lds + L_L + rows[qi] * 4) : 0.f;
        qloc[qi] = 0;
#pragma unroll
        for (int dt = 0; dt < 4; ++dt) { const u32x2 ov = *(const LAS u32x2*)(lds + L_O + rows[qi] * 128 + (16 * dt + 4 * fq) * 2);
            o[qi][dt] = (f32x4){__uint_as_float(ov.x << 16), __uint_as_float(ov.x & 0xffff0000u), __uint_as_float(ov.y << 16), __uint_as_float(ov.y & 0xffff0000u)}; }
    }
    if constexpr (QI == 1) attn_tile_pl<HD, 1, 16>(lds + L_K, lds + L_V, qf, m, l, o, sc, 0, qloc, 0, valid, fr, fq);
    else {
#pragma unroll 1
        for (int half = 0; half < 2; ++half)
            attn_tile<HD, QI, 8>(lds + L_K + half * 128 * KP, lds + L_V + half * 128 * KP, qf, m, l, o, sc, 0, qloc, 0, valid, fr, fq);
    }
#pragma unroll
    for (int qi = 0; qi < QI; ++qi) {
        const float lt = xsum32(xsum16(l[qi]));
        if (valid[qi]) {
            if (fq == 0) { *(LAS float*)(lds + L_M + rows[qi] * 4) = m[qi]; *(LAS float*)(lds + L_L + rows[qi] * 4) = lt; }
#pragma unroll
            for (int dt = 0; dt < 4; ++dt) { u32x2 ov; ov.x = cvt_pk_bf16(o[qi][dt][0], o[qi][dt][1]); ov.y = cvt_pk_bf16(o[qi][dt][2], o[qi][dt][3]);
                *(LAS u32x2*)(lds + L_O + rows[qi] * 128 + (16 * dt + 4 * fq) * 2) = ov; }
        }
    }
}
}

__device__ __forceinline__ void moba_unit(int b, int h, int blk, const bf16_t* Z, const float* KM, bf16_t* MIX, LAS unsigned char* lds) {
    using namespace moba;
    constexpr int QI = 2;
    const int tid = threadIdx.x, lane = tid & 63, w = __builtin_amdgcn_readfirstlane(tid >> 6), fr = lane & 15, fq = lane >> 4;
    const size_t rowb = (size_t)b * SEQ;
    const int q0 = 256 * blk + 32 * w;
    const bf16_t* Kh = Z + rowb * INW + 1024 + h * 64; const bf16_t* Vh = Z + rowb * INW + 1536 + h * 64;
    const bf16_t* Qblk = Z + (rowb + 256 * blk) * INW + 512 + h * 64;
    BlkStage st;
    blk_load(st, Kh + (size_t)(256 * blk) * INW, Vh + (size_t)(256 * blk) * INW, tid);
    bf16x8 qf[QI][2];
#pragma unroll
    for (int qi = 0; qi < QI; ++qi)
#pragma unroll
        for (int dk = 0; dk < 2; ++dk) qf[qi][dk] = *(const bf16x8*)(Qblk + (size_t)(32 * w + 16 * qi + fr) * INW + 32 * dk + 8 * fq);
    __syncthreads();
    if (tid < 16) *(LAS unsigned*)(lds + L_CNT + tid * 4) = 0u;
    if (blk > 0) {
#pragma unroll
        for (int i = 0; i < 4; ++i) { const int idx = tid + 512 * i, row = idx >> 3, ch = idx & 7;
            *(LAS u32x4*)(lds + L_Q + row * 128 + ch * 16) = *(const u32x4*)(Qblk + (size_t)row * INW + ch * 8); }
    }
    __syncthreads();
    {
        float v1[QI], v2[QI], v3[QI]; int i1[QI], i2[QI], i3[QI];
#pragma unroll
        for (int qi = 0; qi < QI; ++qi) { v1[qi] = v2[qi] = v3[qi] = -INFINITY; i1[qi] = i2[qi] = i3[qi] = -1; }
        const float* kmb = KM + (size_t)((b * 8 + h) * NBLK) * 64;
        for (int j = 0; j < blk; ++j) {
            f32x4 km[2][2];
#pragma unroll
            for (int dk = 0; dk < 2; ++dk) { km[dk][0] = *(const f32x4*)(kmb + j * 64 + 32 * dk + 8 * fq); km[dk][1] = *(const f32x4*)(kmb + j * 64 + 32 * dk + 8 * fq + 4); }
#pragma unroll
            for (int qi = 0; qi < QI; ++qi) {
                float g = 0.f;
#pragma unroll
                for (int dk = 0; dk < 2; ++dk)
#pragma unroll
                    for (int e = 0; e < 8; ++e) g += bf2f((unsigned short)qf[qi][dk][e]) * km[dk][e >> 2][e & 3];
                g = xsum32(xsum16(g));
                if (g > v1[qi]) { v3[qi] = v2[qi]; i3[qi] = i2[qi]; v2[qi] = v1[qi]; i2[qi] = i1[qi]; v1[qi] = g; i1[qi] = j; }
                else if (g > v2[qi]) { v3[qi] = v2[qi]; i3[qi] = i2[qi]; v2[qi] = g; i2[qi] = j; }
                else if (g > v3[qi]) { v3[qi] = g; i3[qi] = j; }
            }
        }
        if (fq == 0) {
#pragma unroll
            for (int qi = 0; qi < QI; ++qi) { const int row = 32 * w + 16 * qi + fr; const int ids[3] = {i1[qi], i2[qi], i3[qi]};
#pragma unroll
                for (int k3 = 0; k3 < 3; ++k3) if (ids[k3] >= 0) {
                    const unsigned pos = __hip_atomic_fetch_add((LAS unsigned*)(lds + L_CNT + ids[k3] * 4), 1u, __ATOMIC_RELAXED, __HIP_MEMORY_SCOPE_WORKGROUP);
                    *(LAS unsigned char*)(lds + L_LIST + ids[k3] * 256 + pos) = (unsigned char)row; } }
        }
    }
    blk_store(st, lds, tid);
    __syncthreads();
    { const int jn = blk > 0 ? 0 : blk; blk_load(st, Kh + (size_t)(256 * jn) * INW, Vh + (size_t)(256 * jn) * INW, tid); }
    const float sc = 0.125f * LOG2E;
    {
        float m[QI], l[QI]; f32x4 o[QI][4]; int qloc[QI]; bool keep[QI];
#pragma unroll
        for (int qi = 0; qi < QI; ++qi) { m[qi] = -1e30f; l[qi] = 0.f; qloc[qi] = 32 * w + 16 * qi + fr; keep[qi] = true;
#pragma unroll
            for (int dt = 0; dt < 4; ++dt) o[qi][dt] = (f32x4){0.f, 0.f, 0.f, 0.f}; }
#pragma unroll 1
        for (int half = 0; half < 2; ++half)
            if (128 * half <= 32 * w) attn_tile<HD, QI, 8>(lds + L_K + half * 128 * KP, lds + L_V + half * 128 * KP, qf, m, l, o, sc, 1, qloc, 128 * half, keep, fr, fq);
#pragma unroll
        for (int qi = 0; qi < QI; ++qi) {
            const float lt = xsum32(xsum16(l[qi])); const int row = 32 * w + 16 * qi + fr;
            if (blk == 0) {
                const float inv = 1.0f / lt; bf16_t* op = MIX + (rowb + q0 + 16 * qi + fr) * DM + 512 + h * 64 + 4 * fq;
#pragma unroll
                for (int dt = 0; dt < 4; ++dt) { const f32x4 v = o[qi][dt] * inv; u32x2 wv; wv.x = cvt_pk_bf16(v[0], v[1]); wv.y = cvt_pk_bf16(v[2], v[3]); *(u32x2*)(op + 16 * dt) = wv; }
            } else {
                if (fq == 0) { *(LAS float*)(lds + L_M + row * 4) = m[qi]; *(LAS float*)(lds + L_L + row * 4) = lt; }
#pragma unroll
                for (int dt = 0; dt < 4; ++dt) { u32x2 ov; ov.x = cvt_pk_bf16(o[qi][dt][0], o[qi][dt][1]); ov.y = cvt_pk_bf16(o[qi][dt][2], o[qi][dt][3]);
                    *(LAS u32x2*)(lds + L_O + row * 128 + (16 * dt + 4 * fq) * 2) = ov; }
            }
        }
    }
    for (int j = 0; j < blk; ++j) {
        __syncthreads();
        blk_store(st, lds, tid);
        __syncthreads();
        { const int jn = (j + 1 < blk) ? j + 1 : j; blk_load(st, Kh + (size_t)(256 * jn) * INW, Vh + (size_t)(256 * jn) * INW, tid); }
        const int n = (int)*(const LAS unsigned*)(lds + L_CNT + j * 4);
        const int tiles = (n + 15) >> 4;
        for (int tw = w; tw < tiles; tw += 8) {
            int rows[1]; bool valid[1];
            { const int idx = 16 * tw + fr; valid[0] = idx < n; rows[0] = *(const LAS unsigned char*)(lds + L_LIST + j * 256 + (valid[0] ? idx : 0)); }
            past_tiles<1>(lds, rows, valid, sc, fr, fq);
        }
    }
    if (blk > 0) {
        __syncthreads();
#pragma unroll
        for (int qi = 0; qi < QI; ++qi) {
            const int row = 32 * w + 16 * qi + fr;
            const float inv = 1.0f / *(const LAS float*)(lds + L_L + row * 4);
            bf16_t* op = MIX + (rowb + q0 + 16 * qi + fr) * DM + 512 + h * 64 + 4 * fq;
#pragma unroll
            for (int dt = 0; dt < 4; ++dt) { const u32x2 ov = *(const LAS u32x2*)(lds + L_O + row * 128 + (16 * dt + 4 * fq) * 2);
                const f32x4 v = (f32x4){__uint_as_float(ov.x << 16), __uint_as_float(ov.x & 0xffff0000u), __uint_as_float(ov.y << 16), __uint_as_float(ov.y & 0xffff0000u)} * inv;
                u32x2 wv; wv.x = cvt_pk_bf16(v[0], v[1]); wv.y = cvt_pk_bf16(v[2], v[3]); *(u32x2*)(op + 16 * dt) = wv; }
        }
    }
}

__device__ __forceinline__ void xattn_unit(int qt, int hd, const bf16_t* XQ, const bf16_t* MEMKV, bf16_t* XO, LAS unsigned char* lds) {
    constexpr int HD = 256, QI = 1, TB = Stage<HD>::TILE_B;
    const int tid = threadIdx.x, lane = tid & 63, w = __builtin_amdgcn_readfirstlane(tid >> 6), fr = lane & 15, fq = lane >> 4;
    const int b = qt >> 5;
    const size_t qrow = (size_t)qt * 128 + 16 * w + fr;
    bf16x8 qf[QI][HD / 32];
#pragma unroll
    for (int dk = 0; dk < HD / 32; ++dk) qf[0][dk] = *(const bf16x8*)(XQ + qrow * DM + hd * 256 + 32 * dk + 8 * fq);
    float m[QI] = {-1e30f}, l[QI] = {0.f}; f32x4 o[QI][HD / 16]; int qloc[QI] = {0}; bool keep[QI] = {true};
#pragma unroll
    for (int dt = 0; dt < HD / 16; ++dt) o[0][dt] = (f32x4){0.f, 0.f, 0.f, 0.f};
    const float sc = 0.0625f * LOG2E;
    const bf16_t* Kh = MEMKV + (size_t)b * MEMLEN * 2048 + hd * 256; const bf16_t* Vh = Kh + 1024;
    Stage<HD> st;
    __syncthreads();
    stage_load<HD>(st, Kh, Vh, 2048, tid);
    stage_store<HD>(st, lds, tid);
    __syncthreads();
    for (int t = 0; t < 4; ++t) {
        if (t + 1 < 4) stage_load<HD>(st, Kh + (size_t)(64 * (t + 1)) * 2048, Vh + (size_t)(64 * (t + 1)) * 2048, 2048, tid);
        const LAS unsigned char* buf = lds + (t & 1) * 2 * TB;
        attn_tile<HD, QI>(buf, buf + TB, qf, m, l, o, sc, 0, qloc, 0, keep, fr, fq);
        if (t + 1 < 4) stage_store<HD>(st, lds + ((t + 1) & 1) * 2 * TB, tid);
        __syncthreads();
    }
    float ls = xsum32(xsum16(l[0]));
    const float inv = 1.0f / ls;
    bf16_t* op = XO + qrow * DM + hd * 256 + 4 * fq;
#pragma unroll
    for (int dt = 0; dt < HD / 16; ++dt) { const f32x4 v = o[0][dt] * inv; u32x2 wv; wv.x = cvt_pk_bf16(v[0], v[1]); wv.y = cvt_pk_bf16(v[2], v[3]); *(u32x2*)(op + 16 * dt) = wv; }
}

__device__ __forceinline__ void p0_transpose_item(const float* W, int K, int N, bf16_t* WT, int mode, LAS float* scr, int item, int lane, const float* ks = nullptr) {
    const int nblk = N / 32, kb = item / nblk, nb = item % nblk, k0 = 64 * kb, n0 = 32 * nb;
    float wv[32];
#pragma unroll
    for (int i = 0; i < 32; ++i) wv[i] = W[(size_t)(k0 + 2 * i + (lane >> 5)) * N + n0 + (lane & 31)];
#pragma unroll
    for (int i = 0; i < 32; ++i) { const int kk = 2 * i + (lane >> 5); scr[kk * 33 + (lane & 31)] = ks ? wv[i] * ks[k0 + kk] : wv[i]; }
    asm volatile("s_waitcnt lgkmcnt(0)" ::: "memory");
    const int c = lane & 7;
#pragma unroll
    for (int j = 0; j < 4; ++j) { const int n = (lane >> 3) + 8 * j; const LAS float* s = scr + (8 * c) * 33 + n;
        u32x4 o; o.x = cvt_pk_bf16(s[0 * 33], s[1 * 33]); o.y = cvt_pk_bf16(s[2 * 33], s[3 * 33]); o.z = cvt_pk_bf16(s[4 * 33], s[5 * 33]); o.w = cvt_pk_bf16(s[6 * 33], s[7 * 33]);
        const int gn = n0 + n; const int row = (mode == 0) ? gn : (32 * (gn >> 4) + (gn & 15) + (mode == 2 ? 16 : 0));
        *(u32x4*)(WT + (size_t)row * K + k0 + 8 * c) = o; }
    asm volatile("s_waitcnt lgkmcnt(0)" ::: "memory");
}
__device__ __forceinline__ void cvt_rows_bf16(const float* src, bf16_t* dst, size_t n8, size_t gtid, size_t nthr) {
    size_t i = gtid;
    for (; i + 3 * nthr < n8; i += 4 * nthr) {
        f32x4 a[4], b[4];
#pragma unroll
        for (int q = 0; q < 4; ++q) { a[q] = *(const f32x4*)(src + (i + q * nthr) * 8); b[q] = *(const f32x4*)(src + (i + q * nthr) * 8 + 4); }
#pragma unroll
        for (int q = 0; q < 4; ++q) { u32x4 o; o.x = cvt_pk_bf16(a[q][0], a[q][1]); o.y = cvt_pk_bf16(a[q][2], a[q][3]); o.z = cvt_pk_bf16(b[q][0], b[q][1]); o.w = cvt_pk_bf16(b[q][2], b[q][3]); *(u32x4*)(dst + (i + q * nthr) * 8) = o; }
    }
    for (; i < n8; i += nthr) { const f32x4 a = *(const f32x4*)(src + i * 8), b = *(const f32x4*)(src + i * 8 + 4);
        u32x4 o; o.x = cvt_pk_bf16(a[0], a[1]); o.y = cvt_pk_bf16(a[2], a[3]); o.z = cvt_pk_bf16(b[0], b[1]); o.w = cvt_pk_bf16(b[2], b[3]); *(u32x4*)(dst + i * 8) = o; }
}
__device__ __forceinline__ void ln_row(const float* yrow, const float* g, const float* bta, float* hrow, bf16_t* brow, int lane) {
    f32x4 v[4]; float s = 0.f;
#pragma unroll
    for (int j = 0; j < 4; ++j) { v[j] = *((const f32x4*)yrow + lane + 64 * j); s += (v[j][0] + v[j][1]) + (v[j][2] + v[j][3]); }
    const float mean = wave_sum(s) * (1.f / DM); float s2 = 0.f;
#pragma unroll
    for (int j = 0; j < 4; ++j) { v[j] = v[j] - mean; s2 += (v[j][0] * v[j][0] + v[j][1] * v[j][1]) + (v[j][2] * v[j][2] + v[j][3] * v[j][3]); }
    const float rstd = 1.f / sqrtf(wave_sum(s2) * (1.f / DM) + LN_EPS);
#pragma unroll
    for (int j = 0; j < 4; ++j) { const f32x4 gg = *((const f32x4*)g + lane + 64 * j), bb = *((const f32x4*)bta + lane + 64 * j);
        const f32x4 r = v[j] * rstd * gg + bb; *((f32x4*)hrow + lane + 64 * j) = r;
        if (brow) { u32x2 wv; wv.x = cvt_pk_bf16(r[0], r[1]); wv.y = cvt_pk_bf16(r[2], r[3]); *((u32x2*)brow + lane + 64 * j) = wv; } }
}

__device__ __forceinline__ void ln_row_bf16in(const bf16_t* yrow, const float* g, const float* bta, float* orow, int lane) {
    f32x4 v[4]; float s = 0.f;
#pragma unroll
    for (int j = 0; j < 2; ++j) { const u32x4 rr = *((const u32x4*)yrow + lane + 64 * j);
        v[2 * j] = (f32x4){__uint_as_float(rr.x << 16), __uint_as_float(rr.x & 0xffff0000u), __uint_as_float(rr.y << 16), __uint_as_float(rr.y & 0xffff0000u)};
        v[2 * j + 1] = (f32x4){__uint_as_float(rr.z << 16), __uint_as_float(rr.z & 0xffff0000u), __uint_as_float(rr.w << 16), __uint_as_float(rr.w & 0xffff0000u)};
        s += ((v[2 * j][0] + v[2 * j][1]) + (v[2 * j][2] + v[2 * j][3])) + ((v[2 * j + 1][0] + v[2 * j + 1][1]) + (v[2 * j + 1][2] + v[2 * j + 1][3])); }
    const float mean = wave_sum(s) * (1.f / DM); float s2 = 0.f;
#pragma unroll
    for (int j = 0; j < 4; ++j) { v[j] = v[j] - mean; s2 += (v[j][0] * v[j][0] + v[j][1] * v[j][1]) + (v[j][2] * v[j][2] + v[j][3] * v[j][3]); }
    const float rstd = 1.f / sqrtf(wave_sum(s2) * (1.f / DM) + LN_EPS);
#pragma unroll
    for (int q = 0; q < 4; ++q) { const int ci = 512 * (q >> 1) + 8 * lane + 4 * (q & 1);
        const f32x4 gg = *(const f32x4*)(g + ci), bb = *(const f32x4*)(bta + ci);
        *(f32x4*)(orow + ci) = v[q] * rstd * gg + bb; }
}

__device__ __forceinline__ void ln_rows4_bf16in(const bf16_t* y, const float* g, const float* bta, float* o, int ld, int lane) {
    u32x4 rr[4][2];
#pragma unroll
    for (int q = 0; q < 4; ++q)
#pragma unroll
        for (int j = 0; j < 2; ++j) rr[q][j] = *((const u32x4*)(y + (size_t)q * ld) + lane + 64 * j);
    f32x4 gg[4], bb[4];
#pragma unroll
    for (int c4 = 0; c4 < 4; ++c4) { const int ci = 512 * (c4 >> 1) + 8 * lane + 4 * (c4 & 1); gg[c4] = *(const f32x4*)(g + ci); bb[c4] = *(const f32x4*)(bta + ci); }
#pragma unroll
    for (int q = 0; q < 4; ++q) {
        f32x4 v[4]; float s = 0.f;
#pragma unroll
        for (int j = 0; j < 2; ++j) { const u32x4 w = rr[q][j];
            v[2 * j] = (f32x4){__uint_as_float(w.x << 16), __uint_as_float(w.x & 0xffff0000u), __uint_as_float(w.y << 16), __uint_as_float(w.y & 0xffff0000u)};
            v[2 * j + 1] = (f32x4){__uint_as_float(w.z << 16), __uint_as_float(w.z & 0xffff0000u), __uint_as_float(w.w << 16), __uint_as_float(w.w & 0xffff0000u)}; }
#pragma unroll
        for (int c4 = 0; c4 < 4; ++c4) s += (v[c4][0] + v[c4][1]) + (v[c4][2] + v[c4][3]);
        const float mean = wave_sum(s) * (1.f / DM); float s2 = 0.f;
#pragma unroll
        for (int c4 = 0; c4 < 4; ++c4) { v[c4] = v[c4] - mean; s2 += (v[c4][0] * v[c4][0] + v[c4][1] * v[c4][1]) + (v[c4][2] * v[c4][2] + v[c4][3] * v[c4][3]); }
        const float rstd = 1.f / sqrtf(wave_sum(s2) * (1.f / DM) + LN_EPS);
#pragma unroll
        for (int c4 = 0; c4 < 4; ++c4) { const int ci = 512 * (c4 >> 1) + 8 * lane + 4 * (c4 & 1); *(f32x4*)(o + (size_t)q * ld + ci) = v[c4] * rstd * gg[c4] + bb[c4]; }
    }
}

#define XB_TMO      128
#define XB_XCNT(j)  (256  + 64 * (j))
#define XB_XSUB(j)  (1280 + 64 * (j))
#define XB_XGEN(j)  (2304 + 64 * (j))
#define XB_TOP      3328
#define XB_TOPGEN   3392
#define XCD_BAR_WORDS 3456
#define XB_SPIN_CAP (1u << 20)
__device__ __forceinline__ unsigned xb_ld(unsigned* p)              { return __hip_atomic_load(p, __ATOMIC_RELAXED, __HIP_MEMORY_SCOPE_AGENT); }
__device__ __forceinline__ unsigned xb_add(unsigned* p, unsigned v) { return __hip_atomic_fetch_add(p, v, __ATOMIC_RELAXED, __HIP_MEMORY_SCOPE_AGENT); }
__device__ __forceinline__ unsigned xb_xcc_id() { return (unsigned)__builtin_amdgcn_s_getreg((3 << 11) | 20) & 0xFu; }
#define XB_SPIN(cond, bar) do { unsigned _sp = 0; while (cond) { __builtin_amdgcn_s_sleep(1); \
    if ((++_sp & 255u) == 0u) { if (xb_ld(&(bar)[XB_TMO])) break; if (_sp > XB_SPIN_CAP) { atomicAdd(&(bar)[XB_TMO], 1u); break; } } } } while (0)
struct XcdBarrier { unsigned* bar; unsigned x; volatile LAS unsigned* st; };
__device__ __forceinline__ XcdBarrier xcd_barrier_post(unsigned* bar, volatile LAS unsigned* st) {
    XcdBarrier b; b.bar = bar; b.x = xb_xcc_id(); b.st = st;
    if (threadIdx.x == 0) (void)xb_add(&bar[XB_XCNT(b.x)], 1u);
    return b;
}
__device__ __forceinline__ void xcd_barrier_complete(unsigned* bar, unsigned x, unsigned& nloc, unsigned& nx) {
    const unsigned G = gridDim.x * gridDim.y * gridDim.z;
    unsigned sum, cnt, mine, sp = 0u;
    for (;;) {
        sum = 0u; cnt = 0u; mine = 0u;
#pragma unroll
        for (unsigned j = 0; j < 16; ++j) { const unsigned c = xb_ld(&bar[XB_XCNT(j)]); sum += c; cnt += (c > 0u) ? 1u : 0u; mine = (j == x) ? c : mine; }
        if (sum == G) break;
        __builtin_amdgcn_s_sleep(1);
        if ((++sp & 255u) == 0u) { if (xb_ld(&bar[XB_TMO])) break; if (sp > XB_SPIN_CAP) { atomicAdd(&bar[XB_TMO], 1u); break; } }
    }
    nloc = mine > 0u ? mine : 1u; nx = cnt > 0u ? cnt : 1u;
}
__device__ __forceinline__ void xcd_barrier(const XcdBarrier& b) {
    asm volatile("s_waitcnt vmcnt(0)" ::: "memory");
    __syncthreads();
    if (threadIdx.x == 0) {
        unsigned* bar = b.bar;
        __builtin_amdgcn_s_waitcnt(0);
        unsigned nloc = b.st[0], nx = b.st[1];
        if (nloc == 0u) { xcd_barrier_complete(bar, b.x, nloc, nx); b.st[0] = nloc; b.st[1] = nx; }
        const unsigned old = xb_add(&bar[XB_XSUB(b.x)], 1u);
        const unsigned gen = old / nloc;
        if (old + 1u == (gen + 1u) * nloc) {
            __builtin_amdgcn_fence(__ATOMIC_RELEASE, "agent");
            asm volatile("s_waitcnt vmcnt(0)" ::: "memory");
            const unsigned og = xb_add(&bar[XB_TOP], 1u);
            const unsigned tg = og / nx;
            if (og + 1u == (tg + 1u) * nx) xb_add(&bar[XB_TOPGEN], 1u);
            else XB_SPIN(xb_ld(&bar[XB_TOPGEN]) == tg, bar);
            __builtin_amdgcn_fence(__ATOMIC_ACQUIRE, "agent");
            xb_add(&bar[XB_XGEN(b.x)], 1u);
            asm volatile("s_waitcnt vmcnt(0)" ::: "memory");
        } else {
            XB_SPIN(xb_ld(&bar[XB_XGEN(b.x)]) == gen, bar);
            __builtin_amdgcn_fence(__ATOMIC_ACQUIRE, "agent");
            asm volatile("s_waitcnt vmcnt(0)" ::: "memory");
        }
    }
    __syncthreads();
}

#ifndef PROBE_PHASE
#define PROBE_PHASE -1
#endif
constexpr int LDS_BYTES = 159744;
constexpr int LDS_MISC = 159744 - 256;
struct Args { const float* in[18]; float* out; unsigned char* ws; int ph_lo, ph_hi; };
enum { I_X = 0, I_MEM, I_WIN, I_WPOOL, I_PSCALE, I_WOUT, I_LN1G, I_LN1B, I_WXQ, I_WXKV, I_WXO, I_LN2G, I_LN2B, I_WGATE, I_WUP, I_WDOWN, I_LN3G, I_LN3B };
constexpr int N_PHASES = 13;

struct Ctx {
    const float* const* in; LAS unsigned char* lds; unsigned char* ws; float* H;
    int tid, lane, wave, G, bx, vcu, gw, NGW;
};
#define WSP(T, off) ((T*)(c.ws + (off)))

template <int PH> __device__ __forceinline__ void run_phase(const Ctx& c) {
    const int lane = c.lane, wave = c.wave, G = c.G, bx = c.bx, vcu = c.vcu, gw = c.gw, NGW = c.NGW, tid = c.tid;
    LAS unsigned char* lds = c.lds;
    float* KM = WSP(float, WS_KM);
    bf16_t* Win_t = WSP(bf16_t, WS_WIN); bf16_t* Wout_t = WSP(bf16_t, WS_WOUT); bf16_t* Wxq_t = WSP(bf16_t, WS_WXQ); bf16_t* Wxkv_t = WSP(bf16_t, WS_WXKV);
    bf16_t* Wxo_t = WSP(bf16_t, WS_WXO); bf16_t* Wgu_t = WSP(bf16_t, WS_WGU); bf16_t* Wdn_t = WSP(bf16_t, WS_WDN); bf16_t* Wpool_t = WSP(bf16_t, WS_WPOOL);
    bf16_t* MEMB = WSP(bf16_t, WS_MEMB); bf16_t* MEMKV = WSP(bf16_t, WS_MEMKV);
    bf16_t* XB = WSP(bf16_t, WS_XB); bf16_t* Z = WSP(bf16_t, WS_Z); bf16_t* MIX = WSP(bf16_t, WS_MIX); bf16_t* HF = WSP(bf16_t, WS_HF);
    bf16_t* XQ = MIX; bf16_t* XO = Z;
    float* H = c.H; float* PST1 = WSP(float, WS_PST1); float* PST2 = WSP(float, WS_PST2);
    if constexpr (PH == 0) {
        if (bx < 208) {
            const float* W; int N, n0, mode; const float* gg; const float* bb; float* cd; int cdn;
            if (bx < 32) { W = c.in[I_WXQ]; N = DM; n0 = 32 * bx; mode = 0; gg = c.in[I_LN1G]; bb = c.in[I_LN1B]; cd = WSP(float, WS_CDX); cdn = DM; }
            else if (bx < 120) { W = c.in[I_WGATE]; N = DFF; n0 = 32 * (bx - 32); mode = 1; gg = c.in[I_LN2G]; bb = c.in[I_LN2B]; cd = WSP(float, WS_CDG); cdn = 2 * DFF; }
            else { W = c.in[I_WUP]; N = DFF; n0 = 32 * (bx - 120); mode = 2; gg = c.in[I_LN2G]; bb = c.in[I_LN2B]; cd = WSP(float, WS_CDG); cdn = 2 * DFF; }
            const int col = n0 + (lane & 31), kbeg = wave * 128 + (lane >> 5) * 64;
            float cs = 0.f, ds = 0.f;
#pragma unroll 8
            for (int k = kbeg; k < kbeg + 64; ++k) { const float wv = W[(size_t)k * N + col]; cs += gg[k] * wv; ds += bb[k] * wv; }
            cs += __shfl_xor(cs, 32); ds += __shfl_xor(ds, 32);
            LAS float* red = (LAS float*)(lds + 131072);
            if (lane < 32) { red[(wave * 32 + lane) * 2] = cs; red[(wave * 32 + lane) * 2 + 1] = ds; }
            __syncthreads();
            if (tid < 32) { float ct = 0.f, dt = 0.f;
#pragma unroll
                for (int w8 = 0; w8 < 8; ++w8) { ct += red[(w8 * 32 + tid) * 2]; dt += red[(w8 * 32 + tid) * 2 + 1]; }
                const int oi = (mode == 0) ? col : (32 * (col >> 4) + (col & 15) + (mode == 2 ? 16 : 0));
                cd[oi] = ct; cd[cdn + oi] = dt; }
        }
        LAS float* scr = (LAS float*)(lds + wave * 16384);
        constexpr int I_IN = (DM / 64) * (INW / 32), I_SQ = (DM / 64) * (DM / 32), I_KV = (DM / 64) * (2048 / 32), I_GU = (DM / 64) * (DFF / 32), I_DN = (DFF / 64) * (DM / 32), I_PL = 2 * 4;
        constexpr int NITEMS = I_IN + 3 * I_SQ + I_KV + 2 * I_GU + I_DN + 4 * I_PL;
        for (int it = gw; it < NITEMS; it += NGW) {
            int r = it;
            if (r < I_IN) { p0_transpose_item(c.in[I_WIN], DM, INW, Win_t, 0, scr, r, lane); continue; } r -= I_IN;
            if (r < I_SQ) { if (r >= 8 * (DM / 32)) p0_transpose_item(c.in[I_WOUT], DM, DM, Wout_t, 0, scr, r, lane); continue; } r -= I_SQ;
            if (r < I_SQ) { continue; } r -= I_SQ;
            if (r < I_SQ) { p0_transpose_item(c.in[I_WXO], DM, DM, Wxo_t, 0, scr, r, lane); continue; } r -= I_SQ;
            if (r < I_KV) { p0_transpose_item(c.in[I_WXKV], DM, 2048, Wxkv_t, 0, scr, r, lane); continue; } r -= I_KV;
            if (r < I_GU) { p0_transpose_item(c.in[I_WGATE], DM, DFF, Wgu_t, 1, scr, r, lane, c.in[I_LN2G]); continue; } r -= I_GU;
            if (r < I_GU) { p0_transpose_item(c.in[I_WUP], DM, DFF, Wgu_t, 2, scr, r, lane, c.in[I_LN2G]); continue; } r -= I_GU;
            if (r < I_DN) { p0_transpose_item(c.in[I_WDOWN], DFF, DM, Wdn_t, 0, scr, r, lane); continue; } r -= I_DN;
            { const int gidx = r / I_PL; p0_transpose_item(c.in[I_WPOOL] + gidx * 16384, 128, 128, Wpool_t + gidx * 16384, 0, scr, r % I_PL, lane); }
        }
        const size_t gtid = (size_t)vcu * 512 + tid, nthr = (size_t)G * 512;
        for (size_t idx = gtid; idx < (size_t)512 * DM; idx += nthr) {
            const int n = (int)(idx & (DM - 1)), k = (int)(idx >> 10), gidx = k >> 7;
            const float* wp = c.in[I_WPOOL] + (size_t)k * 128;
            const float* ps = c.in[I_PSCALE] + gidx * 128;
            const float* wo = c.in[I_WOUT] + (size_t)(gidx * 128) * DM + n;
            float a = 0.f;
#pragma unroll 8
            for (int d = 0; d < 128; ++d) a += wp[d] * ps[d] * wo[(size_t)d * DM];
            const unsigned pk = cvt_pk_bf16(a, 0.f);
            Wout_t[(size_t)n * DM + k] = (bf16_t)(pk & 0xffffu);
        }
        for (size_t i8 = gtid; i8 < (size_t)DM * DM / 8; i8 += nthr) {
            const float gsc = c.in[I_LN1G][(i8 * 8) >> 10]; const f32x4 a = *(const f32x4*)(c.in[I_WXQ] + i8 * 8) * gsc, b4 = *(const f32x4*)(c.in[I_WXQ] + i8 * 8 + 4) * gsc;
            u32x4 o; o.x = cvt_pk_bf16(a[0], a[1]); o.y = cvt_pk_bf16(a[2], a[3]); o.z = cvt_pk_bf16(b4[0], b4[1]); o.w = cvt_pk_bf16(b4[2], b4[3]); *(u32x4*)(Wxq_t + i8 * 8) = o; }
        cvt_rows_bf16(c.in[I_X], XB, (size_t)TOK * DM / 8, gtid, nthr);
        cvt_rows_bf16(c.in[I_MEM], MEMB, (size_t)MEMROWS * DM / 8, gtid, nthr);
    }
    if constexpr (PH == 1) {
        { pg8::Gemm g{XB, Win_t, TOK, INW, DM}; pg8::StaticOrder S; S.init(TOK, INW, G, bx, 2); pg8::EpiBf16 E{Z, INW}; pg8::gemm_phase(lds, g, S, E); }
        { pg8::Gemm g{MEMB, Wxkv_t, MEMROWS, 2048, DM}; pg8::StaticOrder S; S.init(MEMROWS, 2048, G, bx); pg8::EpiBf16 E{MEMKV, 2048}; pg8::gemm_phase(lds, g, S, E); }
    }
    if constexpr (PH == 2) {
        for (int u = gw; u < BATCH * 8 * NBLK; u += NGW) {
            const int blk = u & 15, h = (u >> 4) & 7, b = u >> 7;
            const bf16_t* kp = Z + ((size_t)b * SEQ + 256 * blk + (lane >> 3)) * INW + 1024 + h * 64 + (lane & 7) * 8;
            float a[8] = {0.f, 0.f, 0.f, 0.f, 0.f, 0.f, 0.f, 0.f};
#pragma unroll 1
            for (int it = 0; it < 32; it += 8) { bf16x8 kv[8];
#pragma unroll
                for (int q = 0; q < 8; ++q) kv[q] = *(const bf16x8*)(kp + (size_t)(it + q) * 8 * INW);
#pragma unroll
                for (int q = 0; q < 8; ++q)
#pragma unroll
                    for (int e = 0; e < 8; ++e) a[e] += bf2f((unsigned short)kv[q][e]); }
#pragma unroll
            for (int e = 0; e < 8; ++e) { a[e] += __shfl_xor(a[e], 8); a[e] += __shfl_xor(a[e], 16); a[e] += __shfl_xor(a[e], 32); }
            if (lane < 8) { float* o = KM + (size_t)u * 64 + lane * 8;
#pragma unroll
                for (int e = 0; e < 8; ++e) o[e] = a[e] * (1.0f / 256.0f); }
        }
        for (int run = gw; run < TOK / 32; run += NGW) {
            const int wdw = 2 << (lane >> 4);
            const size_t t0 = (size_t)run * 32; const int tpos0 = (int)(t0 & (SEQ - 1));
            const bf16_t* up = Z + t0 * INW + lane * 8;
            bf16_t* op = MIX + t0 * DM + lane * 8;
            float sacc[8] = {0.f, 0.f, 0.f, 0.f, 0.f, 0.f, 0.f, 0.f};
#pragma unroll 1
            for (int ib = 1; ib <= 16; ib += 8) { bf16x8 ui[8]; bool ok[8];
#pragma unroll
                for (int q = 0; q < 8; ++q) { const int i = ib + q; ok[q] = (i <= wdw && tpos0 - i >= 0); ui[q] = *(const bf16x8*)(up - (size_t)(ok[q] ? i : 0) * INW); }
#pragma unroll
                for (int q = 0; q < 8; ++q) if (ok[q]) {
#pragma unroll
                    for (int e8 = 0; e8 < 8; ++e8) sacc[e8] += bf2f((unsigned short)ui[q][e8]); } }
#pragma unroll 1
            for (int tb = 0; tb < 32; tb += 8) {
                bf16x8 un[8], uo[8];
#pragma unroll
                for (int i = 0; i < 8; ++i) { un[i] = *(const bf16x8*)(up + (size_t)(tb + i) * INW);
                    const int told = tpos0 + tb + i - wdw; uo[i] = *(const bf16x8*)(up + (size_t)(tb + i - (told >= 0 ? wdw : 0)) * INW); }
#pragma unroll
                for (int i = 0; i < 8; ++i) { const int tpos = tpos0 + tb + i; const bool sub = tpos - wdw >= 0;
                    const float rc = 1.0f / (float)((tpos + 1 < wdw) ? tpos + 1 : wdw); float p[8];
#pragma unroll
                    for (int e8 = 0; e8 < 8; ++e8) { const float uv = bf2f((unsigned short)un[i][e8]); sacc[e8] += uv; if (sub) sacc[e8] -= bf2f((unsigned short)uo[i][e8]); p[e8] = sacc[e8] * rc - uv; }
                    u32x4 pw; pw.x = cvt_pk_bf16(p[0], p[1]); pw.y = cvt_pk_bf16(p[2], p[3]); pw.z = cvt_pk_bf16(p[4], p[5]); pw.w = cvt_pk_bf16(p[6], p[7]);
                    *(u32x4*)(op + (size_t)(tb + i) * DM) = pw; }
            }
        }
    }
    if constexpr (PH == 2) {
        bf16_t* BtM = WSP(bf16_t, WS_BTM); bf16_t* BtN = WSP(bf16_t, WS_BTN); float* CB = WSP(float, WS_CDB); float* DB = CB + 16 * 1024;
        { pg8::Gemm g{MEMKV, Wxq_t, 64 * 256, 1024, 256, 2048, 1024, 2}; pg8::StaticOrder S; S.init(64 * 256, 1024, G, bx); pg8::EpiPrep E{BtM, 0.0625f, 0}; pg8::gemm_phase(lds, g, S, E); }
        { pg8::Gemm g{Wxo_t, MEMKV + 1024, 64 * 256, 1024, 256, 1024, 2048, 3}; pg8::StaticOrder S; S.init(64 * 256, 1024, G, bx); pg8::EpiPrep E{BtN, 1.0f, 1}; pg8::gemm_phase(lds, g, S, E); }
        const float* cx = WSP(float, WS_CDX); const float* dx = cx + DM;
        for (int o8 = vcu * 512 + tid; o8 < 16 * 1024 * 8; o8 += G * 512) {
            const int o = o8 >> 3, part = o8 & 7;
            const int bt = o >> 10, hm = o & 1023, hh = hm >> 8, mm = hm & 255;
            const bf16_t* kr = MEMKV + (size_t)(bt * 256 + mm) * 2048 + hh * 256; float ca = 0.f, da = 0.f;
#pragma unroll
            for (int it = 0; it < 4; ++it) { const int d8 = part + 8 * it; const bf16x8 kv = *(const bf16x8*)(kr + d8 * 8);
                const f32x4 c0 = *(const f32x4*)(cx + hh * 256 + d8 * 8), c1 = *(const f32x4*)(cx + hh * 256 + d8 * 8 + 4), d0 = *(const f32x4*)(dx + hh * 256 + d8 * 8), d1 = *(const f32x4*)(dx + hh * 256 + d8 * 8 + 4);
#pragma unroll
                for (int e8 = 0; e8 < 8; ++e8) { const float kf = bf2f((unsigned short)kv[e8]); ca += (e8 < 4 ? c0[e8 & 3] : c1[e8 & 3]) * kf; da += (e8 < 4 ? d0[e8 & 3] : d1[e8 & 3]) * kf; } }
            ca += __shfl_xor(ca, 1); ca += __shfl_xor(ca, 2); ca += __shfl_xor(ca, 4); da += __shfl_xor(da, 1); da += __shfl_xor(da, 2); da += __shfl_xor(da, 4);
            if (part == 0) { CB[o] = ca * 0.0625f; DB[o] = da * 0.0625f; }
        }
    }
    if constexpr (PH == 3) {
        for (int it = 0; it * G < BATCH * 8 * NBLK; ++it) {
            const int u = it * G + vcu; if (u >= BATCH * 8 * NBLK) break;
            int bh = u >> 4, blk = u & 15;
            if (G == 256) { bh = it * 16 + (vcu >> 4); blk = ((vcu & 15) + 2 * it) & 15; }
            moba_unit(bh >> 3, bh & 7, blk, Z, KM, MIX, lds);
        }
    }
    if constexpr (PH == 4) { pg8::Gemm g{MIX, Wout_t, TOK, DM, DM}; pg8::StaticOrder S; S.init(TOK, DM, G, bx); pg8::EpiResStat<false, true> E{XB, XB, DM, ALPHA, nullptr, nullptr, nullptr, PST1}; pg8::gemm_phase(lds, g, S, E); }
    if constexpr (PH == 5) { }
    if constexpr (PH == 6) { pg8::Gemm g{XB, WSP(bf16_t, WS_BTM), TOK, DM, DM, 0, 0, 1, (size_t)DM * DM * 2}; pg8::StaticOrder S; S.init(TOK, DM, G, bx); pg8::EpiSoftmaxP E{XQ, PST1, WSP(float, WS_CDB), WSP(float, WS_CDB) + 16 * 1024, (LAS float*)(lds + 131072)}; pg8::gemm_phase(lds, g, S, E); }
    if constexpr (PH == 7) { for (int u = vcu; u < (TOK / 128) * 4; u += G) xattn_unit(u >> 2, u & 3, XQ, MEMKV, XO, lds); }
    if constexpr (PH == 8) { pg8::Gemm g{XQ, WSP(bf16_t, WS_BTN), TOK, DM, DM, 0, 0, 1, (size_t)DM * DM * 2}; pg8::StaticOrder S; S.init(TOK, DM, G, bx); pg8::EpiResStat<true, true> E{XB, XB, DM, ALPHA, PST1, c.in[I_LN1G], c.in[I_LN1B], PST2}; pg8::gemm_phase(lds, g, S, E); }
    if constexpr (PH == 9) { }
    if constexpr (PH == 10) { pg8::Gemm g{XB, Wgu_t, TOK, 2 * DFF, DM}; pg8::StaticOrder S; S.init(TOK, 2 * DFF, G, bx); pg8::EpiLnSwiGLU E{HF, DFF, PST2, WSP(float, WS_CDG), WSP(float, WS_CDG) + 2 * DFF}; pg8::gemm_phase(lds, g, S, E); }
    if constexpr (PH == 11) { pg8::Gemm g{HF, Wdn_t, TOK, DM, DFF}; pg8::StaticOrder S; S.init(TOK, DM, G, bx); pg8::EpiResStat<true, false> E{XB, XB, DM, ALPHA, PST2, c.in[I_LN2G], c.in[I_LN2B], nullptr}; pg8::gemm_phase(lds, g, S, E); }
    if constexpr (PH == 12) { for (int r = gw * 4; r < TOK; r += NGW * 4) ln_rows4_bf16in(XB + (size_t)r * DM, c.in[I_LN3G], c.in[I_LN3B], H + (size_t)r * DM, DM, lane); }
}

__global__ void __launch_bounds__(512, 2) fwd_kernel(Args args) {
    extern __shared__ __attribute__((aligned(16))) unsigned char lds_raw[];
    Ctx c;
    c.in = args.in; c.lds = (LAS unsigned char*)lds_raw; c.ws = args.ws; c.H = args.out;
    c.tid = threadIdx.x; c.lane = c.tid & 63; c.wave = __builtin_amdgcn_readfirstlane(c.tid >> 6);
    c.G = gridDim.x; c.bx = blockIdx.x;
    c.vcu = (c.G % 8 == 0) ? (c.bx % 8) * (c.G / 8) + c.bx / 8 : c.bx;
    c.gw = c.vcu * 8 + c.wave; c.NGW = c.G * 8;
    const int lo = args.ph_lo, hi = args.ph_hi;
    volatile LAS unsigned* MISC = (volatile LAS unsigned*)(c.lds + LDS_MISC);
    if (c.tid < 2) MISC[c.tid] = 0u;
    __syncthreads();
    XcdBarrier bar; bar.bar = (unsigned*)(args.ws + WS_CTL); bar.x = 0; bar.st = MISC;
    if (hi - lo > 1) bar = xcd_barrier_post((unsigned*)(args.ws + WS_CTL), MISC);
    if (hi < 0) cg::this_grid().sync();
#define IN(k) (lo <= (k) && (k) < hi)
#define PHASE(k) do { if (IN(k)) { run_phase<k>(c); if (PROBE_PHASE == (k)) { xcd_barrier(bar); run_phase<k>(c); } } \
        if (IN(k) && IN((k) + 1)) { xcd_barrier(bar); } } while (0)
    PHASE(0); PHASE(1); PHASE(2); PHASE(3); PHASE(4); PHASE(6); PHASE(8); PHASE(10); PHASE(11); PHASE(12);
#undef IN
#undef PHASE
}

extern "C" void kernel_launch(void* const* d_in, const int* in_sizes, int n_in, void* d_out, int out_size, void* d_ws, size_t ws_size, hipStream_t stream) {
    static int grid = 0;
    if (grid == 0) {
        if (n_in != 18 || out_size != TOK * DM || ws_size < WS_END) { fprintf(stderr, "kernel_launch: unexpected shapes (n_in %d, out %d, ws %zu)\n", n_in, out_size, ws_size); grid = -1; return; }
        int dev = 0, cus = 0, per_cu = 0;
        (void)hipGetDevice(&dev); (void)hipDeviceGetAttribute(&cus, hipDeviceAttributeMultiprocessorCount, dev);
        if (hipFuncSetAttribute((const void*)fwd_kernel, hipFuncAttributeMaxDynamicSharedMemorySize, LDS_BYTES) != hipSuccess) { fprintf(stderr, "kernel_launch: hipFuncSetAttribute failed\n"); grid = -1; return; }
        if (hipOccupancyMaxActiveBlocksPerMultiprocessor(&per_cu, (const void*)fwd_kernel, 512, LDS_BYTES) != hipSuccess || per_cu < 1) { fprintf(stderr, "kernel_launch: occupancy query says %d\n", per_cu); per_cu = 1; }
        (void)hipGetLastError();
        grid = cus * 1;
        if (grid <= 0) grid = 256;
    }
    if (grid < 0) return;
    Args a{};
    for (int i = 0; i < 18; ++i) a.in[i] = (const float*)d_in[i];
    a.out = (float*)d_out; a.ws = (unsigned char*)d_ws;
#if N_LAUNCH_MODE == 1
    for (int p = 0; p < N_PHASES; ++p) { a.ph_lo = p; a.ph_hi = p + 1; hipLaunchKernelGGL(fwd_kernel, dim3(grid), dim3(512), LDS_BYTES, stream, a); }
#else
    a.ph_lo = 0; a.ph_hi = N_PHASES;
    (void)hipMemsetAsync((unsigned char*)d_ws + WS_CTL, 0, CTL_BYTES, stream);
    void* kargs[] = {&a};
    hipError_t e = hipLaunchCooperativeKernel((const void*)fwd_kernel, dim3(grid), dim3(512), kargs, LDS_BYTES, stream);
    if (e != hipSuccess) fprintf(stderr, "kernel_launch: cooperative launch failed: %s (grid %d)\n", hipGetErrorString(e), grid);
#endif
}
```

```cpp
#include <hip/hip_runtime.h>
#include <hip/hip_cooperative_groups.h>
#include <cstdio>
#include <cstdint>
namespace cg = cooperative_groups;

#ifndef N_LAUNCH_MODE
#define N_LAUNCH_MODE 0
#endif

#define LAS __attribute__((address_space(3)))
typedef unsigned short bf16_t;
typedef short bf16x8 __attribute__((ext_vector_type(8)));
typedef short s16x4 __attribute__((ext_vector_type(4)));
typedef float f32x4 __attribute__((ext_vector_type(4)));
typedef float f32x2 __attribute__((ext_vector_type(2)));
typedef unsigned u32x4 __attribute__((ext_vector_type(4)));
typedef unsigned u32x2 __attribute__((ext_vector_type(2)));

constexpr int BATCH = 16, SEQ = 4096, DM = 1024, TOK = BATCH * SEQ;
constexpr int MEMLEN = 256, MEMROWS = BATCH * MEMLEN;
constexpr int INW = 2048, DFF = 2816, NBLK = SEQ / 256;
constexpr float ALPHA = 1.189207115002721f;
constexpr float LN_EPS = 1e-5f;
constexpr float LOG2E = 1.4426950408889634f;

constexpr size_t MiB = 1u << 20;
constexpr size_t WS_KM = 0;
constexpr size_t WS_CTL = 1 * MiB, CTL_BYTES = 16384;
constexpr size_t WS_WIN = 2 * MiB, WS_WOUT = 6 * MiB, WS_WXQ = 8 * MiB, WS_WXKV = 10 * MiB, WS_WXO = 14 * MiB, WS_WGU = 16 * MiB, WS_WDN = 27 * MiB, WS_WPOOL = 33 * MiB;
constexpr size_t WS_MEMB = 34 * MiB, WS_MEMKV = 42 * MiB;
constexpr size_t WS_XB = 64 * MiB;
constexpr size_t WS_Z = 192 * MiB;
constexpr size_t WS_MIX = 448 * MiB;
constexpr size_t WS_HF = 192 * MiB;
constexpr size_t WS_PST1 = 576 * MiB, WS_PST2 = 584 * MiB;
constexpr size_t WS_CDX = 60 * MiB, WS_CDG = 60 * MiB + 65536;
constexpr size_t WS_CDB = 60 * MiB + 131072;
constexpr size_t WS_BTM = 592 * MiB, WS_BTN = 624 * MiB;
constexpr size_t WS_END = 656 * MiB;

typedef __bf16 bf16x2_t __attribute__((ext_vector_type(2)));
__device__ __forceinline__ unsigned cvt_pk_bf16(float lo, float hi) { f32x2 v = {lo, hi}; bf16x2_t b = __builtin_convertvector(v, bf16x2_t); return __builtin_bit_cast(unsigned, b); }
__device__ __forceinline__ float xmax16(float v) { auto r = __builtin_amdgcn_permlane16_swap(__float_as_uint(v), __float_as_uint(v), false, false); return fmaxf(__uint_as_float(r[0]), __uint_as_float(r[1])); }
__device__ __forceinline__ float xmax32(float v) { auto r = __builtin_amdgcn_permlane32_swap(__float_as_uint(v), __float_as_uint(v), false, false); return fmaxf(__uint_as_float(r[0]), __uint_as_float(r[1])); }
__device__ __forceinline__ float xsum16(float v) { auto r = __builtin_amdgcn_permlane16_swap(__float_as_uint(v), __float_as_uint(v), false, false); return __uint_as_float(r[0]) + __uint_as_float(r[1]); }
__device__ __forceinline__ float xsum32(float v) { auto r = __builtin_amdgcn_permlane32_swap(__float_as_uint(v), __float_as_uint(v), false, false); return __uint_as_float(r[0]) + __uint_as_float(r[1]); }
__device__ __forceinline__ float bf2f(unsigned short b) { return __uint_as_float(((unsigned)b) << 16); }
__device__ __forceinline__ float wave_sum(float v) {
#pragma unroll
    for (int o = 1; o < 64; o <<= 1) v += __shfl_xor(v, o);
    return v;
}

namespace pg8 {
constexpr int BM = 256, BK = 64, HALF = 128, HTB = HALF * BK * 2, STAGE_BYTES = 8 * HTB, NXCD = 8, WGM = 4;
__host__ __device__ __forceinline__ int lds_byte(int r, int c) { const int st = (r >> 4) * 2 + (c >> 5), rr = r & 15, cc = c & 31, ob = rr * 64 + cc * 2; return st * 1024 + (ob ^ (((ob >> 9) & 1) << 5)); }
__host__ __device__ __forceinline__ void stage_rc(int b, int& R, int& C) { const int st = b / 1024, sb = b % 1024, swz = sb ^ (((sb >> 9) & 1) << 5); R = (st >> 1) * 16 + swz / 64; C = (st & 1) * 32 + (swz % 64) / 2; }
__host__ __device__ __forceinline__ int perm32(int rho) { const int n = rho >> 4, i = rho & 15; return 8 * (i >> 2) + 4 * n + (i & 3); }

struct Unit { int pm, pn; };
struct Gemm { const bf16_t* A; const bf16_t* Bt; int M, N, K; int lda = 0, ldb = 0, mode = 0; size_t s1 = 0; };
__device__ __forceinline__ void unit_ptrs(const Gemm& g, const Unit& u, const char*& cA, const char*& cB) {
    const int lda = g.lda ? g.lda : g.K, ldb = g.ldb ? g.ldb : g.K;
    if (g.mode <= 1) { cA = (const char*)g.A + (size_t)u.pm * BM * lda * 2; cB = (const char*)g.Bt + (size_t)u.pn * BM * ldb * 2 + (g.mode == 1 ? (size_t)(u.pm >> 4) * g.s1 : 0); }
    else if (g.mode == 2) { cA = (const char*)g.A + (size_t)(u.pm >> 2) * 256 * lda * 2 + (size_t)(u.pm & 3) * 512; cB = (const char*)g.Bt + (size_t)u.pn * BM * ldb * 2 + (size_t)(u.pm & 3) * 512; }
    else { cA = (const char*)g.A + (size_t)u.pn * BM * lda * 2 + (size_t)(u.pm & 3) * 512; cB = (const char*)g.Bt + (size_t)(u.pm >> 2) * 256 * ldb * 2 + (size_t)(u.pm & 3) * 512; }
}

struct StaticOrder {
    int nM, nN, nwg, G, c;
    __device__ void init(int M, int N, int G_, int c_) { nM = M / BM; nN = N / BM; nwg = nM * nN; G = G_; c = c_; }
    __device__ bool next(int i, Unit& u) const {
        const long L = (long)i * G + c; if (L >= nwg) return false;
        int wgid = (int)L; { const int q = nwg / NXCD, r = nwg % NXCD, xcd = wgid % NXCD, off = wgid / NXCD; wgid = (xcd < r ? xcd * (q + 1) : r * (q + 1) + (xcd - r) * q) + off; }
        const int nig = WGM * nN, gid = wgid / nig, fm = gid * WGM, gsz = (nM - fm) < WGM ? (nM - fm) : WGM;
        u.pm = fm + ((wgid % nig) % gsz); u.pn = (wgid % nig) / gsz; return true;
    }
};

struct EpiBf16 {
    static constexpr bool PERM = true;
    bf16_t* O; int ldc; float* km = nullptr;
    __device__ __forceinline__ void operator()(const f32x4 (&acc)[2][2][4][2], const Unit& u, int wr, int wc, int fr, int fq) const {
        const int row0 = u.pm * BM + wr * 64 + fr; const int col0 = u.pn * BM + wc * 32 + 8 * fq;
#pragma unroll
        for (int ai = 0; ai < 2; ++ai)
#pragma unroll
            for (int m = 0; m < 4; ++m) { bf16_t* rowp = O + (size_t)(row0 + ai * HALF + m * 16) * ldc + col0;
#pragma unroll
                for (int bj = 0; bj < 2; ++bj) { const f32x4 v0 = acc[ai][bj][m][0], v1 = acc[ai][bj][m][1];
                    u32x4 w; w.x = cvt_pk_bf16(v0[0], v0[1]); w.y = cvt_pk_bf16(v0[2], v0[3]); w.z = cvt_pk_bf16(v1[0], v1[1]); w.w = cvt_pk_bf16(v1[2], v1[3]);
                    *(u32x4*)(rowp + bj * HALF) = w; } }
        if (km && (u.pn == 4 || u.pn == 5)) {
#pragma unroll
            for (int bj = 0; bj < 2; ++bj)
#pragma unroll
                for (int n = 0; n < 2; ++n) { f32x4 cs = (f32x4){0.f, 0.f, 0.f, 0.f};
#pragma unroll
                    for (int ai = 0; ai < 2; ++ai)
#pragma unroll
                        for (int m = 0; m < 4; ++m) cs = cs + acc[ai][bj][m][n];
#pragma unroll
                    for (int j = 0; j < 4; ++j) { float v = cs[j]; v += __shfl_xor(v, 1); v += __shfl_xor(v, 2); v += __shfl_xor(v, 4); v += __shfl_xor(v, 8);
                        if (fr == 0) { const int kc = (u.pn - 4) * 256 + bj * HALF + wc * 32 + 8 * fq + 4 * n + j;
                            __hip_atomic_fetch_add(km + (size_t)(((u.pm >> 4) * 8 + (kc >> 6)) * 16 + (u.pm & 15)) * 64 + (kc & 63), v * (1.0f / 256.0f), __ATOMIC_RELAXED, __HIP_MEMORY_SCOPE_AGENT); } } }
        }
    }
};
__device__ __forceinline__ void row_stats(const float* pst, int row, int fq, float& mu, float& rstd) {
    const f32x4 a = *(const f32x4*)(pst + (size_t)row * 32 + 8 * fq), b = *(const f32x4*)(pst + (size_t)row * 32 + 8 * fq + 4);
    float s1 = (a[0] + a[2]) + (b[0] + b[2]), s2 = (a[1] + a[3]) + (b[1] + b[3]);
    s1 = xsum32(xsum16(s1)); s2 = xsum32(xsum16(s2));
    mu = s1 * (1.0f / 1024.0f); const float var = s2 * (1.0f / 1024.0f) - mu * mu; rstd = 1.0f / sqrtf(var + LN_EPS);
}
template <bool HAS_LN, bool HAS_OUT> struct EpiResStat {
    static constexpr bool PERM = true;
    const bf16_t* R; bf16_t* YB; int ldc; float alpha; const float* st_in; const float* g; const float* b; float* st_out;
    __device__ __forceinline__ void operator()(const f32x4 (&acc)[2][2][4][2], const Unit& u, int wr, int wc, int fr, int fq) const {
        const int row0 = u.pm * BM + wr * 64 + fr; const int col0 = u.pn * BM + wc * 32 + 8 * fq;
        f32x4 gv[2][2], bv[2][2];
        if (HAS_LN) {
#pragma unroll
            for (int bj = 0; bj < 2; ++bj)
#pragma unroll
                for (int n = 0; n < 2; ++n) { gv[bj][n] = *(const f32x4*)(g + col0 + bj * HALF + 4 * n); bv[bj][n] = *(const f32x4*)(b + col0 + bj * HALF + 4 * n); }
        }
#pragma unroll
        for (int ai = 0; ai < 2; ++ai)
#pragma unroll
            for (int m = 0; m < 4; ++m) { const int row = row0 + ai * HALF + m * 16; const size_t off = (size_t)row * ldc + col0;
                float mu = 0.f, rs = 1.f; if (HAS_LN) row_stats(st_in, row, fq, mu, rs);
                float s1 = 0.f, s2 = 0.f;
#pragma unroll
                for (int bj = 0; bj < 2; ++bj) { const u32x4 rr = *(const u32x4*)(R + off + bj * HALF);
                    f32x4 v0 = (f32x4){__uint_as_float(rr.x << 16), __uint_as_float(rr.x & 0xffff0000u), __uint_as_float(rr.y << 16), __uint_as_float(rr.y & 0xffff0000u)};
                    f32x4 v1 = (f32x4){__uint_as_float(rr.z << 16), __uint_as_float(rr.z & 0xffff0000u), __uint_as_float(rr.w << 16), __uint_as_float(rr.w & 0xffff0000u)};
                    if (HAS_LN) { v0 = (v0 - mu) * rs * gv[bj][0] + bv[bj][0]; v1 = (v1 - mu) * rs * gv[bj][1] + bv[bj][1]; }
                    const f32x4 y0 = v0 * alpha + acc[ai][bj][m][0], y1 = v1 * alpha + acc[ai][bj][m][1];
                    u32x4 w; w.x = cvt_pk_bf16(y0[0], y0[1]); w.y = cvt_pk_bf16(y0[2], y0[3]); w.z = cvt_pk_bf16(y1[0], y1[1]); w.w = cvt_pk_bf16(y1[2], y1[3]);
                    *(u32x4*)(YB + off + bj * HALF) = w;
                    s1 += ((y0[0] + y0[1]) + (y0[2] + y0[3])) + ((y1[0] + y1[1]) + (y1[2] + y1[3]));
                    s2 += ((y0[0] * y0[0] + y0[1] * y0[1]) + (y0[2] * y0[2] + y0[3] * y0[3])) + ((y1[0] * y1[0] + y1[1] * y1[1]) + (y1[2] * y1[2] + y1[3] * y1[3])); }
                if (HAS_OUT) { s1 = xsum32(xsum16(s1)); s2 = xsum32(xsum16(s2));
                    if (fq == 0) *(f32x2*)(st_out + (size_t)row * 32 + (u.pn * 4 + wc) * 2) = (f32x2){s1, s2}; } }
    }
};
struct EpiLnBf16 {
    static constexpr bool PERM = true;
    bf16_t* O; int ldc; const float* st_in; const float* cvec; const float* dvec;
    __device__ __forceinline__ void operator()(const f32x4 (&acc)[2][2][4][2], const Unit& u, int wr, int wc, int fr, int fq) const {
        const int row0 = u.pm * BM + wr * 64 + fr; const int col0 = u.pn * BM + wc * 32 + 8 * fq;
        f32x4 cv[2][2], dv[2][2];
#pragma unroll
        for (int bj = 0; bj < 2; ++bj)
#pragma unroll
            for (int n = 0; n < 2; ++n) { cv[bj][n] = *(const f32x4*)(cvec + col0 + bj * HALF + 4 * n); dv[bj][n] = *(const f32x4*)(dvec + col0 + bj * HALF + 4 * n); }
#pragma unroll
        for (int ai = 0; ai < 2; ++ai)
#pragma unroll
            for (int m = 0; m < 4; ++m) { const int row = row0 + ai * HALF + m * 16; bf16_t* rowp = O + (size_t)row * ldc + col0;
                float mu, rs; row_stats(st_in, row, fq, mu, rs);
#pragma unroll
                for (int bj = 0; bj < 2; ++bj) { const f32x4 v0 = (acc[ai][bj][m][0] - cv[bj][0] * mu) * rs + dv[bj][0], v1 = (acc[ai][bj][m][1] - cv[bj][1] * mu) * rs + dv[bj][1];
                    u32x4 w; w.x = cvt_pk_bf16(v0[0], v0[1]); w.y = cvt_pk_bf16(v0[2], v0[3]); w.z = cvt_pk_bf16(v1[0], v1[1]); w.w = cvt_pk_bf16(v1[2], v1[3]);
                    *(u32x4*)(rowp + bj * HALF) = w; } }
    }
};
struct EpiLnSwiGLU {
    static constexpr bool PERM = false;
    bf16_t* O; int ldc; const float* st_in; const float* cvec; const float* dvec;
    __device__ __forceinline__ void operator()(const f32x4 (&acc)[2][2][4][2], const Unit& u, int wr, int wc, int fr, int fq) const {
        const int row0 = u.pm * BM + wr * 64 + fr; const int col0 = u.pn * HALF + wc * 16 + 4 * fq; const int gcol0 = u.pn * BM + wc * 32 + 4 * fq;
        f32x4 cv[2][2], dv[2][2];
#pragma unroll
        for (int bj = 0; bj < 2; ++bj)
#pragma unroll
            for (int n = 0; n < 2; ++n) { cv[bj][n] = *(const f32x4*)(cvec + gcol0 + bj * HALF + 16 * n); dv[bj][n] = *(const f32x4*)(dvec + gcol0 + bj * HALF + 16 * n); }
#pragma unroll
        for (int ai = 0; ai < 2; ++ai)
#pragma unroll
            for (int m = 0; m < 4; ++m) { const int row = row0 + ai * HALF + m * 16; bf16_t* rowp = O + (size_t)row * ldc + col0;
                float mu, rs; row_stats(st_in, row, fq, mu, rs);
#pragma unroll
                for (int bj = 0; bj < 2; ++bj) { const f32x4 g = (acc[ai][bj][m][0] - cv[bj][0] * mu) * rs + dv[bj][0], up = (acc[ai][bj][m][1] - cv[bj][1] * mu) * rs + dv[bj][1]; float h[4];
#pragma unroll
                    for (int j = 0; j < 4; ++j) { const float s = g[j] * __builtin_amdgcn_rcpf(1.0f + __builtin_amdgcn_exp2f(-g[j] * LOG2E)); h[j] = s * up[j]; }
                    u32x2 w; w.x = cvt_pk_bf16(h[0], h[1]); w.y = cvt_pk_bf16(h[2], h[3]);
                    *(u32x2*)(rowp + bj * 64) = w; } }
    }
};

struct EpiPrep {
    static constexpr bool PERM = true;
    bf16_t* O; float scale; int omode;
    __device__ __forceinline__ void operator()(const f32x4 (&acc)[2][2][4][2], const Unit& u, int wr, int wc, int fr, int fq) const {
        bf16_t* base = (omode == 0) ? O + (size_t)u.pm * 256 * 1024 + u.pn * 256 : O + (size_t)(u.pm >> 2) * 1048576 + (size_t)u.pn * 256 * 1024 + (u.pm & 3) * 256;
        base += (size_t)(wr * 64 + fr) * 1024 + wc * 32 + 8 * fq;
#pragma unroll
        for (int ai = 0; ai < 2; ++ai)
#pragma unroll
            for (int m = 0; m < 4; ++m) { bf16_t* rowp = base + (size_t)(ai * HALF + m * 16) * 1024;
#pragma unroll
                for (int bj = 0; bj < 2; ++bj) { const f32x4 v0 = acc[ai][bj][m][0] * scale, v1 = acc[ai][bj][m][1] * scale;
                    u32x4 w; w.x = cvt_pk_bf16(v0[0], v0[1]); w.y = cvt_pk_bf16(v0[2], v0[3]); w.z = cvt_pk_bf16(v1[0], v1[1]); w.w = cvt_pk_bf16(v1[2], v1[3]);
                    *(u32x4*)(rowp + bj * HALF) = w; } }
    }
};
struct EpiSoftmaxP {
    static constexpr bool PERM = true;
    bf16_t* P; const float* st_in; const float* cb; const float* db; LAS float* xb;
    __device__ __forceinline__ void operator()(f32x4 (&acc)[2][2][4][2], const Unit& u, int wr, int wc, int fr, int fq) const {
        const int rl0 = wr * 64 + fr; const int col0 = u.pn * BM + wc * 32 + 8 * fq; const int bt = u.pm >> 4;
        {
            f32x4 cv[2][2], dv[2][2];
#pragma unroll
            for (int bj = 0; bj < 2; ++bj)
#pragma unroll
                for (int n = 0; n < 2; ++n) { cv[bj][n] = *(const f32x4*)(cb + bt * 1024 + col0 + bj * HALF + 4 * n); dv[bj][n] = *(const f32x4*)(db + bt * 1024 + col0 + bj * HALF + 4 * n); }
#pragma unroll
            for (int ai = 0; ai < 2; ++ai)
#pragma unroll
                for (int m = 0; m < 4; ++m) { const int rl = rl0 + ai * HALF + m * 16;
                    float mu, rs; row_stats(st_in, u.pm * BM + rl, fq, mu, rs);
                    float mx = -INFINITY;
#pragma unroll
                    for (int bj = 0; bj < 2; ++bj)
#pragma unroll
                        for (int n = 0; n < 2; ++n) { const f32x4 s = (acc[ai][bj][m][n] - cv[bj][n] * mu) * rs + dv[bj][n]; acc[ai][bj][m][n] = s;
                            mx = fmaxf(fmaxf(mx, s[0]), fmaxf(s[1], fmaxf(s[2], s[3]))); }
                    mx = xmax32(xmax16(mx));
                    if (fq == 0) xb[rl * 4 + wc] = mx; }
        }
        asm volatile("s_waitcnt lgkmcnt(0)" ::: "memory"); __builtin_amdgcn_s_barrier(); asm volatile("" ::: "memory");
#pragma unroll
        for (int ai = 0; ai < 2; ++ai)
#pragma unroll
            for (int m = 0; m < 4; ++m) { const int rl = rl0 + ai * HALF + m * 16;
                const f32x4 mm = *(const LAS f32x4*)(xb + rl * 4); const float rmax = fmaxf(fmaxf(mm[0], mm[1]), fmaxf(mm[2], mm[3])) * LOG2E;
                float sm = 0.f;
#pragma unroll
                for (int bj = 0; bj < 2; ++bj)
#pragma unroll
                    for (int n = 0; n < 2; ++n) { f32x4 p;
#pragma unroll
                        for (int j = 0; j < 4; ++j) p[j] = __builtin_amdgcn_exp2f(__builtin_fmaf(acc[ai][bj][m][n][j], LOG2E, -rmax));
                        acc[ai][bj][m][n] = p; sm += (p[0] + p[1]) + (p[2] + p[3]); }
                sm = xsum32(xsum16(sm));
                if (fq == 0) xb[1024 + rl * 4 + wc] = sm; }
        asm volatile("s_waitcnt lgkmcnt(0)" ::: "memory"); __builtin_amdgcn_s_barrier(); asm volatile("" ::: "memory");
#pragma unroll
        for (int ai = 0; ai < 2; ++ai)
#pragma unroll
            for (int m = 0; m < 4; ++m) { const int rl = rl0 + ai * HALF + m * 16;
                const f32x4 ss = *(const LAS f32x4*)(xb + 1024 + rl * 4); const float inv = 1.0f / ((ss[0] + ss[1]) + (ss[2] + ss[3]));
                bf16_t* rowp = P + (size_t)(u.pm * BM + rl) * 1024 + col0;
#pragma unroll
                for (int bj = 0; bj < 2; ++bj) { const f32x4 v0 = acc[ai][bj][m][0] * inv, v1 = acc[ai][bj][m][1] * inv;
                    u32x4 w; w.x = cvt_pk_bf16(v0[0], v0[1]); w.y = cvt_pk_bf16(v0[2], v0[3]); w.z = cvt_pk_bf16(v1[0], v1[1]); w.w = cvt_pk_bf16(v1[2], v1[3]);
                    *(u32x4*)(rowp + bj * HALF) = w; } }
    }
};

template <class Epi, class Sched>
__device__ __forceinline__ void gemm_phase(LAS unsigned char* lds, const Gemm g, const Sched S, const Epi E) {
    const int tid = threadIdx.x, wid = __builtin_amdgcn_readfirstlane(tid >> 6), lane = tid & 63, wr = wid >> 2, wc = wid & 3, fr = lane & 15, fq = lane >> 4;
    const int K = g.K, nt = K / BK;
    const int lda = g.lda ? g.lda : K, ldb = g.ldb ? g.ldb : K;
    unsigned voffA[2], voffB[2];
#pragma unroll
    for (int i = 0; i < 2; ++i) { int R, C; stage_rc(tid * 16 + i * 8192, R, C); const int Rb = Epi::PERM ? ((R & ~31) + perm32(R & 31)) : R;
        voffA[i] = (unsigned)(R * lda + C) * 2u; voffB[i] = (unsigned)(Rb * ldb + C) * 2u; }
    const size_t kstep = (size_t)(BK * 2);
    const size_t hstepA = (size_t)HALF * lda * 2, hstepB = (size_t)HALF * ldb * 2;
    const unsigned ldsw = (unsigned)wid * 1024u;
    const int aoff = lds_byte(wr * 64 + fr, fq * 8), boff = lds_byte(wc * 32 + fr, fq * 8);
#define PG8_SA(b, h) (((b) * 2 + (h)) * HTB)
#define PG8_SB(b, h) ((4 + (b) * 2 + (h)) * HTB)
#define PG8_STAGE(bufoff, gbase, voff) do { _Pragma("unroll") for (int _i = 0; _i < 2; ++_i) \
        __builtin_amdgcn_global_load_lds((const unsigned*)((const char*)(gbase) + (voff)[_i]), (LAS unsigned*)(lds + (bufoff) + ldsw + _i * 8192), 16, 0, 0); } while (0)
#define PG8_LDA(dst, b, h) do { _Pragma("unroll") for (int m = 0; m < 4; ++m) _Pragma("unroll") for (int k = 0; k < 2; ++k) dst[m][k] = *(const LAS bf16x8*)(lds + PG8_SA(b, h) + aoff + m * 2048 + k * 1024); } while (0)
#define PG8_LDB(dst, b, h) do { _Pragma("unroll") for (int n = 0; n < 2; ++n) _Pragma("unroll") for (int k = 0; k < 2; ++k) dst[n][k] = *(const LAS bf16x8*)(lds + PG8_SB(b, h) + boff + n * 2048 + k * 1024); } while (0)
#define PG8_MMA(ai, bj, At, Bt) do { __builtin_amdgcn_s_setprio(1); _Pragma("unroll") for (int m = 0; m < 4; ++m) _Pragma("unroll") for (int n = 0; n < 2; ++n) _Pragma("unroll") for (int k = 0; k < 2; ++k) \
        acc[ai][bj][m][n] = __builtin_amdgcn_mfma_f32_16x16x32_bf16(Bt[n][k], At[m][k], acc[ai][bj][m][n], 0, 0, 0); __builtin_amdgcn_s_setprio(0); } while (0)
#define PG8_WAIT_V(n) asm volatile("s_waitcnt vmcnt(" #n ")" ::: "memory")
#define PG8_WAIT_L(n) asm volatile("s_waitcnt lgkmcnt(" #n ")" ::: "memory")
#define PG8_BAR __builtin_amdgcn_s_barrier()
#define PG8_SCHED __builtin_amdgcn_sched_barrier(0)
    Unit cur, nxt; int ui = 0;
    if (!S.next(0, cur)) return;
    f32x4 acc[2][2][4][2];
#pragma unroll
    for (int a = 0; a < 2; ++a)
#pragma unroll
        for (int b = 0; b < 2; ++b)
#pragma unroll
            for (int m = 0; m < 4; ++m)
#pragma unroll
                for (int n = 0; n < 2; ++n) acc[a][b][m][n] = (f32x4){0.f, 0.f, 0.f, 0.f};
    bf16x8 At[4][2], B0[2][2], B1[2][2];
    const char* cA; const char* cB; unit_ptrs(g, cur, cA, cB);
    PG8_STAGE(PG8_SB(0, 0), cB, voffB); PG8_STAGE(PG8_SB(0, 1), cB + hstepB, voffB); PG8_STAGE(PG8_SA(0, 0), cA, voffA); PG8_STAGE(PG8_SA(0, 1), cA + hstepA, voffA);
    if (wr == 1) PG8_BAR;
    PG8_WAIT_V(2); PG8_BAR;
    PG8_STAGE(PG8_SB(1, 0), cB + kstep, voffB); PG8_STAGE(PG8_SA(1, 0), cA + kstep, voffA); PG8_STAGE(PG8_SB(1, 1), cB + hstepB + kstep, voffB);
    PG8_WAIT_V(6); PG8_BAR;
    for (;;) {
        const bool has_next = S.next(ui + 1, nxt);
        const char* nA = cA; const char* nB = cB; if (has_next) unit_ptrs(g, nxt, nA, nB);
#pragma unroll 1
        for (int t = 0; t < nt; t += 2) {
            const bool last = (t == nt - 2);
            const char* a1 = cA + (size_t)(t + 1) * kstep;
            const char* a2 = last ? nA : cA + (size_t)(t + 2) * kstep; const char* b2 = last ? nB : cB + (size_t)(t + 2) * kstep;
            const char* a3 = a2 + kstep; const char* b3 = b2 + kstep;
            PG8_LDB(B0, 0, 0); PG8_LDB(B1, 0, 1); PG8_SCHED; PG8_LDA(At, 0, 0); PG8_STAGE(PG8_SA(1, 1), a1 + hstepA, voffA);
            PG8_WAIT_V(8); PG8_WAIT_L(0); PG8_BAR; PG8_MMA(0, 0, At, B0); PG8_MMA(0, 1, At, B1); PG8_BAR; PG8_SCHED;
            PG8_LDA(At, 0, 1); PG8_STAGE(PG8_SB(0, 0), b2, voffB); PG8_STAGE(PG8_SB(0, 1), b2 + hstepB, voffB); PG8_STAGE(PG8_SA(0, 0), a2, voffA);
            PG8_WAIT_V(8); PG8_WAIT_L(0); PG8_BAR; PG8_MMA(1, 0, At, B0); PG8_MMA(1, 1, At, B1); PG8_BAR; PG8_SCHED;
            PG8_LDB(B0, 1, 0); PG8_LDB(B1, 1, 1); PG8_SCHED; PG8_LDA(At, 1, 0); PG8_STAGE(PG8_SA(0, 1), a2 + hstepA, voffA);
            PG8_WAIT_V(8); PG8_WAIT_L(0); PG8_BAR; PG8_MMA(0, 0, At, B0); PG8_MMA(0, 1, At, B1); PG8_BAR; PG8_SCHED;
            PG8_LDA(At, 1, 1); PG8_STAGE(PG8_SB(1, 0), b3, voffB); PG8_STAGE(PG8_SB(1, 1), b3 + hstepB, voffB); PG8_STAGE(PG8_SA(1, 0), a3, voffA);
            PG8_WAIT_V(8); PG8_WAIT_L(0); PG8_BAR; PG8_MMA(1, 0, At, B0); PG8_MMA(1, 1, At, B1); PG8_BAR; PG8_SCHED;
        }
        if (wr == 0) PG8_BAR;
        E(acc, cur, wr, wc, fr, fq);
        if (!has_next) break;
#pragma unroll
        for (int a = 0; a < 2; ++a)
#pragma unroll
            for (int b = 0; b < 2; ++b)
#pragma unroll
                for (int m = 0; m < 4; ++m)
#pragma unroll
                    for (int n = 0; n < 2; ++n) acc[a][b][m][n] = (f32x4){0.f, 0.f, 0.f, 0.f};
        cur = nxt; cA = nA; cB = nB; ++ui;
        if (wr == 1) PG8_BAR;
    }
    PG8_WAIT_V(0);
    PG8_BAR;
#undef PG8_SA
#undef PG8_SB
#undef PG8_STAGE
#undef PG8_LDA
#undef PG8_LDB
#undef PG8_MMA
#undef PG8_WAIT_V
#undef PG8_WAIT_L
#undef PG8_BAR
#undef PG8_SCHED
}
}

__device__ __forceinline__ s16x4 tr_read(const LAS unsigned char* p) { return __builtin_bit_cast(s16x4, __builtin_amdgcn_ds_read_tr16_b64_v4i16((LAS s16x4*)p)); }

template <int HD, int QI, int KT16 = 4>
__device__ __forceinline__ void attn_tile(const LAS unsigned char* Ks, const LAS unsigned char* Vs, const bf16x8 (&qf)[QI][HD / 32],
                                          float (&m)[QI], float (&l)[QI], f32x4 (&o)[QI][HD / 16], float sc,
                                          int maskmode, const int (&qloc)[QI], int kbase, const bool (&keep)[QI], int fr, int fq) {
    constexpr int KP = 2 * HD + 32;
    f32x4 s[QI][KT16];
#pragma unroll
    for (int qi = 0; qi < QI; ++qi)
#pragma unroll
        for (int kt = 0; kt < KT16; ++kt) s[qi][kt] = (f32x4){0.f, 0.f, 0.f, 0.f};
#pragma unroll
    for (int kt = 0; kt < KT16; ++kt)
#pragma unroll
        for (int dk = 0; dk < HD / 32; ++dk) {
            const bf16x8 kf = *(const LAS bf16x8*)(Ks + (16 * kt + fr) * KP + (32 * dk + 8 * fq) * 2);
#pragma unroll
            for (int qi = 0; qi < QI; ++qi) s[qi][kt] = __builtin_amdgcn_mfma_f32_16x16x32_bf16(kf, qf[qi][dk], s[qi][kt], 0, 0, 0);
        }
    float mxs[QI]; bool need = false;
#pragma unroll
    for (int qi = 0; qi < QI; ++qi) {
        if (maskmode == 1) {
#pragma unroll
            for (int kt = 0; kt < KT16; ++kt)
#pragma unroll
                for (int r = 0; r < 4; ++r) if (kbase + 16 * kt + 4 * fq + r > qloc[qi]) s[qi][kt][r] = -INFINITY;
        }
        float mx = fmaxf(fmaxf(s[qi][0][0], s[qi][0][1]), fmaxf(s[qi][0][2], s[qi][0][3]));
#pragma unroll
        for (int kt = 1; kt < KT16; ++kt) { mx = fmaxf(fmaxf(mx, s[qi][kt][0]), s[qi][kt][1]); mx = fmaxf(fmaxf(mx, s[qi][kt][2]), s[qi][kt][3]); }
        mx = xmax32(xmax16(mx));
        mxs[qi] = mx * sc;
        need = need || (keep[qi] && mxs[qi] > m[qi] + 8.0f);
    }
    if (__ballot(need) != 0ull) {
#pragma unroll
        for (int qi = 0; qi < QI; ++qi) {
            const bool upd = keep[qi] && mxs[qi] > m[qi] + 8.0f;
            const float mn = upd ? mxs[qi] : m[qi];
            const float al = __builtin_amdgcn_exp2f(m[qi] - mn); m[qi] = mn; l[qi] *= al;
#pragma unroll
            for (int dt = 0; dt < HD / 16; ++dt) o[qi][dt] = o[qi][dt] * al;
        }
    }
    bf16x8 pf[QI][KT16 / 2];
#pragma unroll
    for (int qi = 0; qi < QI; ++qi) {
        const float moff = keep[qi] ? -m[qi] : -INFINITY;
        float rs = 0.f;
#pragma unroll
        for (int kt = 0; kt < KT16; ++kt)
#pragma unroll
            for (int r = 0; r < 4; ++r) { const float p = __builtin_amdgcn_exp2f(__builtin_fmaf(s[qi][kt][r], sc, moff)); s[qi][kt][r] = p; rs += p; }
        l[qi] += rs;
#pragma unroll
        for (int p2 = 0; p2 < KT16 / 2; ++p2) {
            u32x4 w; w.x = cvt_pk_bf16(s[qi][2 * p2][0], s[qi][2 * p2][1]); w.y = cvt_pk_bf16(s[qi][2 * p2][2], s[qi][2 * p2][3]);
            w.z = cvt_pk_bf16(s[qi][2 * p2 + 1][0], s[qi][2 * p2 + 1][1]); w.w = cvt_pk_bf16(s[qi][2 * p2 + 1][2], s[qi][2 * p2 + 1][3]);
            pf[qi][p2] = __builtin_bit_cast(bf16x8, w);
        }
    }
    const LAS unsigned char* vb = Vs + (4 * fq + (fr >> 2)) * KP + (4 * (fr & 3)) * 2;
#pragma unroll
    for (int dt = 0; dt < HD / 16; ++dt)
#pragma unroll
        for (int p2 = 0; p2 < KT16 / 2; ++p2) {
            const s16x4 lo = tr_read(vb + (32 * p2) * KP + 32 * dt);
            const s16x4 hi = tr_read(vb + (32 * p2 + 16) * KP + 32 * dt);
            const bf16x8 vf = (bf16x8){lo[0], lo[1], lo[2], lo[3], hi[0], hi[1], hi[2], hi[3]};
#pragma unroll
            for (int qi = 0; qi < QI; ++qi) o[qi][dt] = __builtin_amdgcn_mfma_f32_16x16x32_bf16(vf, pf[qi][p2], o[qi][dt], 0, 0, 0);
        }
}

template <int HD, int QI, int KT16 = 4>
__device__ __forceinline__ void attn_tile_pl(const LAS unsigned char* Ks, const LAS unsigned char* Vs, const bf16x8 (&qf)[QI][HD / 32],
                                          float (&m)[QI], float (&l)[QI], f32x4 (&o)[QI][HD / 16], float sc,
                                          int maskmode, const int (&qloc)[QI], int kbase, const bool (&keep)[QI], int fr, int fq) {
    constexpr int KP = 2 * HD + 32;
    constexpr int NF = (HD / 32) * KT16, CH = 4, NCH = NF / CH;
    static_assert(NF % CH == 0, "fragment chunking");
    f32x4 s[QI][KT16];
#pragma unroll
    for (int qi = 0; qi < QI; ++qi)
#pragma unroll
        for (int kt = 0; kt < KT16; ++kt) s[qi][kt] = (f32x4){0.f, 0.f, 0.f, 0.f};
    const LAS unsigned char* kb = Ks + fr * KP + 16 * fq;
#define KFRAG(f) (*(const LAS bf16x8*)(kb + (16 * ((f) % KT16)) * KP + 64 * ((f) / KT16)))
    bf16x8 kf[2][CH];
#pragma unroll
    for (int i = 0; i < CH; ++i) kf[0][i] = KFRAG(i);
#pragma unroll
    for (int c = 0; c < NCH; ++c) {
        if (c + 1 < NCH) {
#pragma unroll
            for (int i = 0; i < CH; ++i) kf[(c + 1) & 1][i] = KFRAG((c + 1) * CH + i);
        }
        __builtin_amdgcn_sched_barrier(0);
#pragma unroll
        for (int i = 0; i < CH; ++i) { const int f = c * CH + i, kt = f % KT16, dk = f / KT16;
#pragma unroll
            for (int qi = 0; qi < QI; ++qi) s[qi][kt] = __builtin_amdgcn_mfma_f32_16x16x32_bf16(kf[c & 1][i], qf[qi][dk], s[qi][kt], 0, 0, 0); }
        __builtin_amdgcn_sched_barrier(0);
    }
#undef KFRAG
    constexpr int NV = (KT16 / 2) * (HD / 16), NVC = NV / CH;
    static_assert(NV % CH == 0, "V fragment chunking");
    const LAS unsigned char* vb = Vs + (4 * fq + (fr >> 2)) * KP + (4 * (fr & 3)) * 2;
#define VLO(g) tr_read(vb + (32 * ((g) / (HD / 16))) * KP + 32 * ((g) % (HD / 16)))
#define VHI(g) tr_read(vb + (32 * ((g) / (HD / 16)) + 16) * KP + 32 * ((g) % (HD / 16)))
    s16x4 vlo[2][CH], vhi[2][CH];
#pragma unroll
    for (int i = 0; i < CH; ++i) { vlo[0][i] = VLO(i); vhi[0][i] = VHI(i); }
    __builtin_amdgcn_sched_barrier(0);
    float mxs[QI]; bool need = false;
#pragma unroll
    for (int qi = 0; qi < QI; ++qi) {
        if (maskmode == 1) {
#pragma unroll
            for (int kt = 0; kt < KT16; ++kt)
#pragma unroll
                for (int r = 0; r < 4; ++r) if (kbase + 16 * kt + 4 * fq + r > qloc[qi]) s[qi][kt][r] = -INFINITY;
        }
        float mx = fmaxf(fmaxf(s[qi][0][0], s[qi][0][1]), fmaxf(s[qi][0][2], s[qi][0][3]));
#pragma unroll
        for (int kt = 1; kt < KT16; ++kt) { mx = fmaxf(fmaxf(mx, s[qi][kt][0]), s[qi][kt][1]); mx = fmaxf(fmaxf(mx, s[qi][kt][2]), s[qi][kt][3]); }
        mx = xmax32(xmax16(mx));
        mxs[qi] = mx * sc;
        need = need || (keep[qi] && mxs[qi] > m[qi] + 8.0f);
    }
    if (__ballot(need) != 0ull) {
#pragma unroll
        for (int qi = 0; qi < QI; ++qi) {
            const bool upd = keep[qi] && mxs[qi] > m[qi] + 8.0f;
            const float mn = upd ? mxs[qi] : m[qi];
            const float al = __builtin_amdgcn_exp2f(m[qi] - mn); m[qi] = mn; l[qi] *= al;
#pragma unroll
            for (int dt = 0; dt < HD / 16; ++dt) o[qi][dt] = o[qi][dt] * al;
        }
    }
    bf16x8 pf[QI][KT16 / 2];
#pragma unroll
    for (int qi = 0; qi < QI; ++qi) {
        const float moff = keep[qi] ? -m[qi] : -INFINITY;
        float rs = 0.f;
#pragma unroll
        for (int kt = 0; kt < KT16; ++kt)
#pragma unroll
            for (int r = 0; r < 4; ++r) { const float p = __builtin_amdgcn_exp2f(__builtin_fmaf(s[qi][kt][r], sc, moff)); s[qi][kt][r] = p; rs += p; }
        l[qi] += rs;
#pragma unroll
        for (int p2 = 0; p2 < KT16 / 2; ++p2) {
            u32x4 w; w.x = cvt_pk_bf16(s[qi][2 * p2][0], s[qi][2 * p2][1]); w.y = cvt_pk_bf16(s[qi][2 * p2][2], s[qi][2 * p2][3]);
            w.z = cvt_pk_bf16(s[qi][2 * p2 + 1][0], s[qi][2 * p2 + 1][1]); w.w = cvt_pk_bf16(s[qi][2 * p2 + 1][2], s[qi][2 * p2 + 1][3]);
            pf[qi][p2] = __builtin_bit_cast(bf16x8, w);
        }
    }
    __builtin_amdgcn_sched_barrier(0);
#pragma unroll
    for (int c = 0; c < NVC; ++c) {
        if (c + 1 < NVC) {
#pragma unroll
            for (int i = 0; i < CH; ++i) { vlo[(c + 1) & 1][i] = VLO((c + 1) * CH + i); vhi[(c + 1) & 1][i] = VHI((c + 1) * CH + i); }
        }
        __builtin_amdgcn_sched_barrier(0);
#pragma unroll
        for (int i = 0; i < CH; ++i) { const int g = c * CH + i, p2 = g / (HD / 16), dt = g % (HD / 16);
            const s16x4 lo = vlo[c & 1][i], hi = vhi[c & 1][i];
            const bf16x8 vf = (bf16x8){lo[0], lo[1], lo[2], lo[3], hi[0], hi[1], hi[2], hi[3]};
#pragma unroll
            for (int qi = 0; qi < QI; ++qi) o[qi][dt] = __builtin_amdgcn_mfma_f32_16x16x32_bf16(vf, pf[qi][p2], o[qi][dt], 0, 0, 0); }
        __builtin_amdgcn_sched_barrier(0);
    }
#undef VLO
#undef VHI
}

template <int HD> struct Stage { static constexpr int CH = HD / 8, NLD = 64 * CH / 512, KP = 2 * HD + 32, TILE_B = 64 * KP; u32x4 k[NLD], v[NLD]; };
template <int HD>
__device__ __forceinline__ void stage_load(Stage<HD>& st, const bf16_t* Kg, const bf16_t* Vg, int gp, int tid) {
#pragma unroll
    for (int i = 0; i < Stage<HD>::NLD; ++i) { const int idx = tid + 512 * i, row = idx / Stage<HD>::CH, ch = idx % Stage<HD>::CH;
        st.k[i] = *(const u32x4*)(Kg + (size_t)row * gp + ch * 8); st.v[i] = *(const u32x4*)(Vg + (size_t)row * gp + ch * 8); }
}
template <int HD>
__device__ __forceinline__ void stage_store(const Stage<HD>& st, LAS unsigned char* buf, int tid) {
#pragma unroll
    for (int i = 0; i < Stage<HD>::NLD; ++i) { const int idx = tid + 512 * i, row = idx / Stage<HD>::CH, ch = idx % Stage<HD>::CH;
        *(LAS u32x4*)(buf + row * Stage<HD>::KP + ch * 16) = st.k[i]; *(LAS u32x4*)(buf + Stage<HD>::TILE_B + row * Stage<HD>::KP + ch * 16) = st.v[i]; }
}

namespace moba {
constexpr int HD = 64, KP = 2 * HD + 32, BLKB = 256 * KP;
constexpr int L_K = 0, L_V = BLKB, L_O = 2 * BLKB, L_M = L_O + 256 * 128, L_L = L_M + 1024, L_LIST = L_L + 1024, L_CNT = L_LIST + 15 * 256, L_Q = L_CNT + 64, L_END = L_Q + 256 * 128;
struct BlkStage { u32x4 k[4], v[4]; };
__device__ __forceinline__ void blk_load(BlkStage& st, const bf16_t* Kg, const bf16_t* Vg, int tid) {
#pragma unroll
    for (int i = 0; i < 4; ++i) { const int idx = tid + 512 * i, row = idx >> 3, ch = idx & 7;
        st.k[i] = *(const u32x4*)(Kg + (size_t)row * INW + ch * 8); st.v[i] = *(const u32x4*)(Vg + (size_t)row * INW + ch * 8); }
}
__device__ __forceinline__ void blk_store(const BlkStage& st, LAS unsigned char* lds, int tid) {
#pragma unroll
    for (int i = 0; i < 4; ++i) { const int idx = tid + 512 * i, row = idx >> 3, ch = idx & 7;
        *(LAS u32x4*)(lds + L_K + row * KP + ch * 16) = st.k[i]; *(LAS u32x4*)(lds + L_V + row * KP + ch * 16) = st.v[i]; }
}
template <int QI>
__device__ __forceinline__ void past_tiles(LAS unsigned char* lds, const int (&rows)[QI], const bool (&valid)[QI], float sc, int fr, int fq) {
    bf16x8 qf[QI][2]; float m[QI], l[QI]; f32x4 o[QI][4]; int qloc[QI];
#pragma unroll
    for (int qi = 0; qi < QI; ++qi) {
#pragma unroll
        for (int dk = 0; dk < 2; ++dk) qf[qi][dk] = *(const LAS bf16x8*)(lds + L_Q + rows[qi] * 128 + (32 * dk + 8 * fq) * 2);
        m[qi] = *(const LAS float*)(lds + L_M + rows[qi] * 4);
        l[qi] = (fq == 0) ? *(const LAS float*)(lds + L_L + rows[qi] * 4) : 0.f;
        qloc[qi] = 0;
#pragma unroll
        for (int dt = 0; dt < 4; ++dt) { const u32x2 ov = *(const LAS u32x2*)(lds + L_O + rows[qi] * 128 + (16 * dt + 4 * fq) * 2);
            o[qi][dt] = (f32x4){__uint_as_float(ov.x << 16), __uint_as_float(ov.x & 0xffff0000u), __uint_as_float(ov.y << 16), __uint_as_float(ov.y & 0xffff0000u)}; }
    }
    if constexpr (QI == 1) attn_tile_pl<HD, 1, 16>(lds + L_K, lds + L_V, qf, m, l, o, sc, 0, qloc, 0, valid, fr, fq);
    else {
#pragma unroll 1
        for (int half = 0; half < 2; ++half)
            attn_tile<HD, QI, 8>(lds + L_K + half * 128 * KP, lds + L_V + half * 128 * KP, qf, m, l, o, sc, 0, qloc, 0, valid, fr, fq);
    }
#pragma unroll
    for (int qi = 0; qi < QI; ++qi) {
        const float lt = xsum32(xsum16(l[qi]));
        if (valid[qi]) {
            if (fq == 0) { *(LAS float*)(lds + L_M + rows[qi] * 4) = m[qi]; *(LAS float*)(lds + L_L + rows[qi] * 4) = lt; }
#pragma unroll
            for (int dt = 0; dt < 4; ++dt) { u32x2 ov; ov.x = cvt_pk_bf16(o[qi][dt][0], o[qi][dt][1]); ov.y = cvt_pk_bf16(o[qi][dt][2], o[qi][dt][3]);
                *(LAS u32x2*)(lds + L_O + rows[qi] * 128 + (16 * dt + 4 * fq) * 2) = ov; }
        }
    }
}
}

__device__ __forceinline__ void moba_unit(int b, int h, int blk, const bf16_t* Z, const float* KM, bf16_t* MIX, LAS unsigned char* lds) {
    using namespace moba;
    constexpr int QI = 2;
    const int tid = threadIdx.x, lane = tid & 63, w = __builtin_amdgcn_readfirstlane(tid >> 6), fr = lane & 15, fq = lane >> 4;
    const size_t rowb = (size_t)b * SEQ;
    const int q0 = 256 * blk + 32 * w;
    const bf16_t* Kh = Z + rowb * INW + 1024 + h * 64; const bf16_t* Vh = Z + rowb * INW + 1536 + h * 64;
    const bf16_t* Qblk = Z + (rowb + 256 * blk) * INW + 512 + h * 64;
    BlkStage st;
    blk_load(st, Kh + (size_t)(256 * blk) * INW, Vh + (size_t)(256 * blk) * INW, tid);
    bf16x8 qf[QI][2];
#pragma unroll
    for (int qi = 0; qi < QI; ++qi)
#pragma unroll
        for (int dk = 0; dk < 2; ++dk) qf[qi][dk] = *(const bf16x8*)(Qblk + (size_t)(32 * w + 16 * qi + fr) * INW + 32 * dk + 8 * fq);
    __syncthreads();
    if (tid < 16) *(LAS unsigned*)(lds + L_CNT + tid * 4) = 0u;
    if (blk > 0) {
#pragma unroll
        for (int i = 0; i < 4; ++i) { const int idx = tid + 512 * i, row = idx >> 3, ch = idx & 7;
            *(LAS u32x4*)(lds + L_Q + row * 128 + ch * 16) = *(const u32x4*)(Qblk + (size_t)row * INW + ch * 8); }
    }
    __syncthreads();
    {
        float v1[QI], v2[QI], v3[QI]; int i1[QI], i2[QI], i3[QI];
#pragma unroll
        for (int qi = 0; qi < QI; ++qi) { v1[qi] = v2[qi] = v3[qi] = -INFINITY; i1[qi] = i2[qi] = i3[qi] = -1; }
        const float* kmb = KM + (size_t)((b * 8 + h) * NBLK) * 64;
        for (int j = 0; j < blk; ++j) {
            f32x4 km[2][2];
#pragma unroll
            for (int dk = 0; dk < 2; ++dk) { km[dk][0] = *(const f32x4*)(kmb + j * 64 + 32 * dk + 8 * fq); km[dk][1] = *(const f32x4*)(kmb + j * 64 + 32 * dk + 8 * fq + 4); }
#pragma unroll
            for (int qi = 0; qi < QI; ++qi) {
                float g = 0.f;
#pragma unroll
                for (int dk = 0; dk < 2; ++dk)
#pragma unroll
                    for (int e = 0; e < 8; ++e) g += bf2f((unsigned short)qf[qi][dk][e]) * km[dk][e >> 2][e & 3];
                g = xsum32(xsum16(g));
                if (g > v1[qi]) { v3[qi] = v2[qi]; i3[qi] = i2[qi]; v2[qi] = v1[qi]; i2[qi] = i1[qi]; v1[qi] = g; i1[qi] = j; }
                else if (g > v2[qi]) { v3[qi] = v2[qi]; i3[qi] = i2[qi]; v2[qi] = g; i2[qi] = j; }
                else if (g > v3[qi]) { v3[qi] = g; i3[qi] = j; }
            }
        }
        if (fq == 0) {
#pragma unroll
            for (int qi = 0; qi < QI; ++qi) { const int row = 32 * w + 16 * qi + fr; const int ids[3] = {i1[qi], i2[qi], i3[qi]};
#pragma unroll
                for (int k3 = 0; k3 < 3; ++k3) if (ids[k3] >= 0) {
                    const unsigned pos = __hip_atomic_fetch_add((LAS unsigned*)(lds + L_CNT + ids[k3] * 4), 1u, __ATOMIC_RELAXED, __HIP_MEMORY_SCOPE_WORKGROUP);
                    *(LAS unsigned char*)(lds + L_LIST + ids[k3] * 256 + pos) = (unsigned char)row; } }
        }
    }
    blk_store(st, lds, tid);
    __syncthreads();
    { const int jn = blk > 0 ? 0 : blk; blk_load(st, Kh + (size_t)(256 * jn) * INW, Vh + (size_t)(256 * jn) * INW, tid); }
    const float sc = 0.125f * LOG2E;
    {
        float m[QI], l[QI]; f32x4 o[QI][4]; int qloc[QI]; bool keep[QI];
#pragma unroll
        for (int qi = 0; qi < QI; ++qi) { m[qi] = -1e30f; l[qi] = 0.f; qloc[qi] = 32 * w + 16 * qi + fr; keep[qi] = true;
#pragma unroll
            for (int dt = 0; dt < 4; ++dt) o[qi][dt] = (f32x4){0.f, 0.f, 0.f, 0.f}; }
#pragma unroll 1
        for (int half = 0; half < 2; ++half)
            if (128 * half <= 32 * w) attn_tile<HD, QI, 8>(lds + L_K + half * 128 * KP, lds + L_V + half * 128 * KP, qf, m, l, o, sc, 1, qloc, 128 * half, keep, fr, fq);
#pragma unroll
        for (int qi = 0; qi < QI; ++qi) {
            const float lt = xsum32(xsum16(l[qi])); const int row = 32 * w + 16 * qi + fr;
            if (blk == 0) {
                const float inv = 1.0f / lt; bf16_t* op = MIX + (rowb + q0 + 16 * qi + fr) * DM + 512 + h * 64 + 4 * fq;
#pragma unroll
                for (int dt = 0; dt < 4; ++dt) { const f32x4 v = o[qi][dt] * inv; u32x2 wv; wv.x = cvt_pk_bf16(v[0], v[1]); wv.y = cvt_pk_bf16(v[2], v[3]); *(u32x2*)(op + 16 * dt) = wv; }
            } else {
                if (fq == 0) { *(LAS float*)(lds + L_M + row * 4) = m[qi]; *(LAS float*)(lds + L_L + row * 4) = lt; }
#pragma unroll
                for (int dt = 0; dt < 4; ++dt) { u32x2 ov; ov.x = cvt_pk_bf16(o[qi][dt][0], o[qi][dt][1]); ov.y = cvt_pk_bf16(o[qi][dt][2], o[qi][dt][3]);
                    *(LAS u32x2*)(lds + L_O + row * 128 + (16 * dt + 4 * fq) * 2) = ov; }
            }
        }
    }
    for (int j = 0; j < blk; ++j) {
        __syncthreads();
        blk_store(st, lds, tid);
        __syncthreads();
        { const int jn = (j + 1 < blk) ? j + 1 : j; blk_load(st, Kh + (size_t)(256 * jn) * INW, Vh + (size_t)(256 * jn) * INW, tid); }
        const int n = (int)*(const LAS unsigned*)(lds + L_CNT + j * 4);
        const int tiles = (n + 15) >> 4;
        for (int tw = w; tw < tiles; tw += 8) {
            int rows[1]; bool valid[1];
            { const int idx = 16 * tw + fr; valid[0] = idx < n; rows[0] = *(const LAS unsigned char*)(lds + L_LIST + j * 256 + (valid[0] ? idx : 0)); }
            past_tiles<1>(lds, rows, valid, sc, fr, fq);
        }
    }
    if (blk > 0) {
        __syncthreads();
#pragma unroll
        for (int qi = 0; qi < QI; ++qi) {
            const int row = 32 * w + 16 * qi + fr;
            const float inv = 1.0f / *(const LAS float*)(lds + L_L + row * 4);
            bf16_t* op = MIX + (rowb + q0 + 16 * qi + fr) * DM + 512 + h * 64 + 4 * fq;
#pragma unroll
            for (int dt = 0; dt < 4; ++dt) { const u32x2 ov = *(const LAS u32x2*)(lds + L_O + row * 128 + (16 * dt + 4 * fq) * 2);
                const f32x4 v = (f32x4){__uint_as_float(ov.x << 16), __uint_as_float(ov.x & 0xffff0000u), __uint_as_float(ov.y << 16), __uint_as_float(ov.y & 0xffff0000u)} * inv;
                u32x2 wv; wv.x = cvt_pk_bf16(v[0], v[1]); wv.y = cvt_pk_bf16(v[2], v[3]); *(u32x2*)(op + 16 * dt) = wv; }
        }
    }
}

__device__ __forceinline__ void xattn_unit(int qt, int hd, const bf16_t* XQ, const bf16_t* MEMKV, bf16_t* XO, LAS unsigned char* lds) {
    constexpr int HD = 256, QI = 1, TB = Stage<HD>::TILE_B;
    const int tid = threadIdx.x, lane = tid & 63, w = __builtin_amdgcn_readfirstlane(tid >> 6), fr = lane & 15, fq = lane >> 4;
    const int b = qt >> 5;
    const size_t qrow = (size_t)qt * 128 + 16 * w + fr;
    bf16x8 qf[QI][HD / 32];
#pragma unroll
    for (int dk = 0; dk < HD / 32; ++dk) qf[0][dk] = *(const bf16x8*)(XQ + qrow * DM + hd * 256 + 32 * dk + 8 * fq);
    float m[QI] = {-1e30f}, l[QI] = {0.f}; f32x4 o[QI][HD / 16]; int qloc[QI] = {0}; bool keep[QI] = {true};
#pragma unroll
    for (int dt = 0; dt < HD / 16; ++dt) o[0][dt] = (f32x4){0.f, 0.f, 0.f, 0.f};
    const float sc = 0.0625f * LOG2E;
    const bf16_t* Kh = MEMKV + (size_t)b * MEMLEN * 2048 + hd * 256; const bf16_t* Vh = Kh + 1024;
    Stage<HD> st;
    __syncthreads();
    stage_load<HD>(st, Kh, Vh, 2048, tid);
    stage_store<HD>(st, lds, tid);
    __syncthreads();
    for (int t = 0; t < 4; ++t) {
        if (t + 1 < 4) stage_load<HD>(st, Kh + (size_t)(64 * (t + 1)) * 2048, Vh + (size_t)(64 * (t + 1)) * 2048, 2048, tid);
        const LAS unsigned char* buf = lds + (t & 1) * 2 * TB;
        attn_tile<HD, QI>(buf, buf + TB, qf, m, l, o, sc, 0, qloc, 0, keep, fr, fq);
        if (t + 1 < 4) stage_store<HD>(st, lds + ((t + 1) & 1) * 2 * TB, tid);
        __syncthreads();
    }
    float ls = xsum32(xsum16(l[0]));
    const float inv = 1.0f / ls;
    bf16_t* op = XO + qrow * DM + hd * 256 + 4 * fq;
#pragma unroll
    for (int dt = 0; dt < HD / 16; ++dt) { const f32x4 v = o[0][dt] * inv; u32x2 wv; wv.x = cvt_pk_bf16(v[0], v[1]); wv.y = cvt_pk_bf16(v[2], v[3]); *(u32x2*)(op + 16 * dt) = wv; }
}

__device__ __forceinline__ void p0_transpose_item(const float* W, int K, int N, bf16_t* WT, int mode, LAS float* scr, int item, int lane, const float* ks = nullptr) {
    const int nblk = N / 32, kb = item / nblk, nb = item % nblk, k0 = 64 * kb, n0 = 32 * nb;
    float wv[32];
#pragma unroll
    for (int i = 0; i < 32; ++i) wv[i] = W[(size_t)(k0 + 2 * i + (lane >> 5)) * N + n0 + (lane & 31)];
#pragma unroll
    for (int i = 0; i < 32; ++i) { const int kk = 2 * i + (lane >> 5); scr[kk * 33 + (lane & 31)] = ks ? wv[i] * ks[k0 + kk] : wv[i]; }
    asm volatile("s_waitcnt lgkmcnt(0)" ::: "memory");
    const int c = lane & 7;
#pragma unroll
    for (int j = 0; j < 4; ++j) { const int n = (lane >> 3) + 8 * j; const LAS float* s = scr + (8 * c) * 33 + n;
        u32x4 o; o.x = cvt_pk_bf16(s[0 * 33], s[1 * 33]); o.y = cvt_pk_bf16(s[2 * 33], s[3 * 33]); o.z = cvt_pk_bf16(s[4 * 33], s[5 * 33]); o.w = cvt_pk_bf16(s[6 * 33], s[7 * 33]);
        const int gn = n0 + n; const int row = (mode == 0) ? gn : (32 * (gn >> 4) + (gn & 15) + (mode == 2 ? 16 : 0));
        *(u32x4*)(WT + (size_t)row * K + k0 + 8 * c) = o; }
    asm volatile("s_waitcnt lgkmcnt(0)" ::: "memory");
}
__device__ __forceinline__ void cvt_rows_bf16(const float* src, bf16_t* dst, size_t n8, size_t gtid, size_t nthr) {
    size_t i = gtid;
    for (; i + 3 * nthr < n8; i += 4 * nthr) {
        f32x4 a[4], b[4];
#pragma unroll
        for (int q = 0; q < 4; ++q) { a[q] = *(const f32x4*)(src + (i + q * nthr) * 8); b[q] = *(const f32x4*)(src + (i + q * nthr) * 8 + 4); }
#pragma unroll
        for (int q = 0; q < 4; ++q) { u32x4 o; o.x = cvt_pk_bf16(a[q][0], a[q][1]); o.y = cvt_pk_bf16(a[q][2], a[q][3]); o.z = cvt_pk_bf16(b[q][0], b[q][1]); o.w = cvt_pk_bf16(b[q][2], b[q][3]); *(u32x4*)(dst + (i + q * nthr) * 8) = o; }
    }
    for (; i < n8; i += nthr) { const f32x4 a = *(const f32x4*)(src + i * 8), b = *(const f32x4*)(src + i * 8 + 4);
        u32x4 o; o.x = cvt_pk_bf16(a[0], a[1]); o.y = cvt_pk_bf16(a[2], a[3]); o.z = cvt_pk_bf16(b[0], b[1]); o.w = cvt_pk_bf16(b[2], b[3]); *(u32x4*)(dst + i * 8) = o; }
}
__device__ __forceinline__ void ln_row(const float* yrow, const float* g, const float* bta, float* hrow, bf16_t* brow, int lane) {
    f32x4 v[4]; float s = 0.f;
#pragma unroll
    for (int j = 0; j < 4; ++j) { v[j] = *((const f32x4*)yrow + lane + 64 * j); s += (v[j][0] + v[j][1]) + (v[j][2] + v[j][3]); }
    const float mean = wave_sum(s) * (1.f / DM); float s2 = 0.f;
#pragma unroll
    for (int j = 0; j < 4; ++j) { v[j] = v[j] - mean; s2 += (v[j][0] * v[j][0] + v[j][1] * v[j][1]) + (v[j][2] * v[j][2] + v[j][3] * v[j][3]); }
    const float rstd = 1.f / sqrtf(wave_sum(s2) * (1.f / DM) + LN_EPS);
#pragma unroll
    for (int j = 0; j < 4; ++j) { const f32x4 gg = *((const f32x4*)g + lane + 64 * j), bb = *((const f32x4*)bta + lane + 64 * j);
        const f32x4 r = v[j] * rstd * gg + bb; *((f32x4*)hrow + lane + 64 * j) = r;
        if (brow) { u32x2 wv; wv.x = cvt_pk_bf16(r[0], r[1]); wv.y = cvt_pk_bf16(r[2], r[3]); *((u32x2*)brow + lane + 64 * j) = wv; } }
}

__device__ __forceinline__ void ln_row_bf16in(const bf16_t* yrow, const float* g, const float* bta, float* orow, int lane) {
    f32x4 v[4]; float s = 0.f;
#pragma unroll
    for (int j = 0; j < 2; ++j) { const u32x4 rr = *((const u32x4*)yrow + lane + 64 * j);
        v[2 * j] = (f32x4){__uint_as_float(rr.x << 16), __uint_as_float(rr.x & 0xffff0000u), __uint_as_float(rr.y << 16), __uint_as_float(rr.y & 0xffff0000u)};
        v[2 * j + 1] = (f32x4){__uint_as_float(rr.z << 16), __uint_as_float(rr.z & 0xffff0000u), __uint_as_float(rr.w << 16), __uint_as_float(rr.w & 0xffff0000u)};
        s += ((v[2 * j][0] + v[2 * j][1]) + (v[2 * j][2] + v[2 * j][3])) + ((v[2 * j + 1][0] + v[2 * j + 1][1]) + (v[2 * j + 1][2] + v[2 * j + 1][3])); }
    const float mean = wave_sum(s) * (1.f / DM); float s2 = 0.f;
#pragma unroll
    for (int j = 0; j < 4; ++j) { v[j] = v[j] - mean; s2 += (v[j][0] * v[j][0] + v[j][1] * v[j][1]) + (v[j][2] * v[j][2] + v[j][3] * v[j][3]); }
    const float rstd = 1.f / sqrtf(wave_sum(s2) * (1.f / DM) + LN_EPS);
#pragma unroll
    for (int q = 0; q < 4; ++q) { const int ci = 512 * (q >> 1) + 8 * lane + 4 * (q & 1);
        const f32x4 gg = *(const f32x4*)(g + ci), bb = *(const f32x4*)(bta + ci);
        *(f32x4*)(orow + ci) = v[q] * rstd * gg + bb; }
}

__device__ __forceinline__ void ln_rows4_bf16in(const bf16_t* y, const float* g, const float* bta, float* o, int ld, int lane) {
    u32x4 rr[4][2];
#pragma unroll
    for (int q = 0; q < 4; ++q)
#pragma unroll
        for (int j = 0; j < 2; ++j) rr[q][j] = *((const u32x4*)(y + (size_t)q * ld) + lane + 64 * j);
    f32x4 gg[4], bb[4];
#pragma unroll
    for (int c4 = 0; c4 < 4; ++c4) { const int ci = 512 * (c4 >> 1) + 8 * lane + 4 * (c4 & 1); gg[c4] = *(const f32x4*)(g + ci); bb[c4] = *(const f32x4*)(bta + ci); }
#pragma unroll
    for (int q = 0; q < 4; ++q) {
        f32x4 v[4]; float s = 0.f;
#pragma unroll
        for (int j = 0; j < 2; ++j) { const u32x4 w = rr[q][j];
            v[2 * j] = (f32x4){__uint_as_float(w.x << 16), __uint_as_float(w.x & 0xffff0000u), __uint_as_float(w.y << 16), __uint_as_float(w.y & 0xffff0000u)};
            v[2 * j + 1] = (f32x4){__uint_as_float(w.z << 16), __uint_as_float(w.z & 0xffff0000u), __uint_as_float(w.w << 16), __uint_as_float(w.w & 0xffff0000u)}; }
#pragma unroll
        for (int c4 = 0; c4 < 4; ++c4) s += (v[c4][0] + v[c4][1]) + (v[c4][2] + v[c4][3]);
        const float mean = wave_sum(s) * (1.f / DM); float s2 = 0.f;
#pragma unroll
        for (int c4 = 0; c4 < 4; ++c4) { v[c4] = v[c4] - mean; s2 += (v[c4][0] * v[c4][0] + v[c4][1] * v[c4][1]) + (v[c4][2] * v[c4][2] + v[c4][3] * v[c4][3]); }
        const float rstd = 1.f / sqrtf(wave_sum(s2) * (1.f / DM) + LN_EPS);
#pragma unroll
        for (int c4 = 0; c4 < 4; ++c4) { const int ci = 512 * (c4 >> 1) + 8 * lane + 4 * (c4 & 1); *(f32x4*)(o + (size_t)q * ld + ci) = v[c4] * rstd * gg[c4] + bb[c4]; }
    }
}

#define XB_TMO      128
#define XB_XCNT(j)  (256  + 64 * (j))
#define XB_XSUB(j)  (1280 + 64 * (j))
#define XB_XGEN(j)  (2304 + 64 * (j))
#define XB_TOP      3328
#define XB_TOPGEN   3392
#define XCD_BAR_WORDS 3456
#define XB_SPIN_CAP (1u << 20)
__device__ __forceinline__ unsigned xb_ld(unsigned* p)              { return __hip_atomic_load(p, __ATOMIC_RELAXED, __HIP_MEMORY_SCOPE_AGENT); }
__device__ __forceinline__ unsigned xb_add(unsigned* p, unsigned v) { return __hip_atomic_fetch_add(p, v, __ATOMIC_RELAXED, __HIP_MEMORY_SCOPE_AGENT); }
__device__ __forceinline__ unsigned xb_xcc_id() { return (unsigned)__builtin_amdgcn_s_getreg((3 << 11) | 20) & 0xFu; }
#define XB_SPIN(cond, bar) do { unsigned _sp = 0; while (cond) { __builtin_amdgcn_s_sleep(1); \
    if ((++_sp & 255u) == 0u) { if (xb_ld(&(bar)[XB_TMO])) break; if (_sp > XB_SPIN_CAP) { atomicAdd(&(bar)[XB_TMO], 1u); break; } } } } while (0)
struct XcdBarrier { unsigned* bar; unsigned x; volatile LAS unsigned* st; };
__device__ __forceinline__ XcdBarrier xcd_barrier_post(unsigned* bar, volatile LAS unsigned* st) {
    XcdBarrier b; b.bar = bar; b.x = xb_xcc_id(); b.st = st;
    if (threadIdx.x == 0) (void)xb_add(&bar[XB_XCNT(b.x)], 1u);
    return b;
}
__device__ __forceinline__ void xcd_barrier_complete(unsigned* bar, unsigned x, unsigned& nloc, unsigned& nx) {
    const unsigned G = gridDim.x * gridDim.y * gridDim.z;
    unsigned sum, cnt, mine, sp = 0u;
    for (;;) {
        sum = 0u; cnt = 0u; mine = 0u;
#pragma unroll
        for (unsigned j = 0; j < 16; ++j) { const unsigned c = xb_ld(&bar[XB_XCNT(j)]); sum += c; cnt += (c > 0u) ? 1u : 0u; mine = (j == x) ? c : mine; }
        if (sum == G) break;
        __builtin_amdgcn_s_sleep(1);
        if ((++sp & 255u) == 0u) { if (xb_ld(&bar[XB_TMO])) break; if (sp > XB_SPIN_CAP) { atomicAdd(&bar[XB_TMO], 1u); break; } }
    }
    nloc = mine > 0u ? mine : 1u; nx = cnt > 0u ? cnt : 1u;
}
__device__ __forceinline__ void xcd_barrier(const XcdBarrier& b) {
    asm volatile("s_waitcnt vmcnt(0)" ::: "memory");
    __syncthreads();
    if (threadIdx.x == 0) {
        unsigned* bar = b.bar;
        __builtin_amdgcn_s_waitcnt(0);
        unsigned nloc = b.st[0], nx = b.st[1];
        if (nloc == 0u) { xcd_barrier_complete(bar, b.x, nloc, nx); b.st[0] = nloc; b.st[1] = nx; }
        const unsigned old = xb_add(&bar[XB_XSUB(b.x)], 1u);
        const unsigned gen = old / nloc;
        if (old + 1u == (gen + 1u) * nloc) {
            __builtin_amdgcn_fence(__ATOMIC_RELEASE, "agent");
            asm volatile("s_waitcnt vmcnt(0)" ::: "memory");
            const unsigned og = xb_add(&bar[XB_TOP], 1u);
            const unsigned tg = og / nx;
            if (og + 1u == (tg + 1u) * nx) xb_add(&bar[XB_TOPGEN], 1u);
            else XB_SPIN(xb_ld(&bar[XB_TOPGEN]) == tg, bar);
            __builtin_amdgcn_fence(__ATOMIC_ACQUIRE, "agent");
            xb_add(&bar[XB_XGEN(b.x)], 1u);
            asm volatile("s_waitcnt vmcnt(0)" ::: "memory");
        } else {
            XB_SPIN(xb_ld(&bar[XB_XGEN(b.x)]) == gen, bar);
            __builtin_amdgcn_fence(__ATOMIC_ACQUIRE, "agent");
            asm volatile("s_waitcnt vmcnt(0)" ::: "memory");
        }
    }
    __syncthreads();
}

#ifndef PROBE_PHASE
#define PROBE_PHASE -1
#endif
constexpr int LDS_BYTES = 159744;
constexpr int LDS_MISC = 159744 - 256;
struct Args { const float* in[18]; float* out; unsigned char* ws; int ph_lo, ph_hi; };
enum { I_X = 0, I_MEM, I_WIN, I_WPOOL, I_PSCALE, I_WOUT, I_LN1G, I_LN1B, I_WXQ, I_WXKV, I_WXO, I_LN2G, I_LN2B, I_WGATE, I_WUP, I_WDOWN, I_LN3G, I_LN3B };
constexpr int N_PHASES = 13;

struct Ctx {
    const float* const* in; LAS unsigned char* lds; unsigned char* ws; float* H;
    int tid, lane, wave, G, bx, vcu, gw, NGW;
};
#define WSP(T, off) ((T*)(c.ws + (off)))

template <int PH> __device__ __forceinline__ void run_phase(const Ctx& c) {
    const int lane = c.lane, wave = c.wave, G = c.G, bx = c.bx, vcu = c.vcu, gw = c.gw, NGW = c.NGW, tid = c.tid;
    LAS unsigned char* lds = c.lds;
    float* KM = WSP(float, WS_KM);
    bf16_t* Win_t = WSP(bf16_t, WS_WIN); bf16_t* Wout_t = WSP(bf16_t, WS_WOUT); bf16_t* Wxq_t = WSP(bf16_t, WS_WXQ); bf16_t* Wxkv_t = WSP(bf16_t, WS_WXKV);
    bf16_t* Wxo_t = WSP(bf16_t, WS_WXO); bf16_t* Wgu_t = WSP(bf16_t, WS_WGU); bf16_t* Wdn_t = WSP(bf16_t, WS_WDN); bf16_t* Wpool_t = WSP(bf16_t, WS_WPOOL);
    bf16_t* MEMB = WSP(bf16_t, WS_MEMB); bf16_t* MEMKV = WSP(bf16_t, WS_MEMKV);
    bf16_t* XB = WSP(bf16_t, WS_XB); bf16_t* Z = WSP(bf16_t, WS_Z); bf16_t* MIX = WSP(bf16_t, WS_MIX); bf16_t* HF = WSP(bf16_t, WS_HF);
    bf16_t* XQ = MIX; bf16_t* XO = Z;
    float* H = c.H; float* PST1 = WSP(float, WS_PST1); float* PST2 = WSP(float, WS_PST2);
    if constexpr (PH == 0) {
        if (bx < 208) {
            const float* W; int N, n0, mode; const float* gg; const float* bb; float* cd; int cdn;
            if (bx < 32) { W = c.in[I_WXQ]; N = DM; n0 = 32 * bx; mode = 0; gg = c.in[I_LN1G]; bb = c.in[I_LN1B]; cd = WSP(float, WS_CDX); cdn = DM; }
            else if (bx < 120) { W = c.in[I_WGATE]; N = DFF; n0 = 32 * (bx - 32); mode = 1; gg = c.in[I_LN2G]; bb = c.in[I_LN2B]; cd = WSP(float, WS_CDG); cdn = 2 * DFF; }
            else { W = c.in[I_WUP]; N = DFF; n0 = 32 * (bx - 120); mode = 2; gg = c.in[I_LN2G]; bb = c.in[I_LN2B]; cd = WSP(float, WS_CDG); cdn = 2 * DFF; }
            const int col = n0 + (lane & 31), kbeg = wave * 128 + (lane >> 5) * 64;
            float cs = 0.f, ds = 0.f;
#pragma unroll 8
            for (int k = kbeg; k < kbeg + 64; ++k) { const float wv = W[(size_t)k * N + col]; cs += gg[k] * wv; ds += bb[k] * wv; }
            cs += __shfl_xor(cs, 32); ds += __shfl_xor(ds, 32);
            LAS float* red = (LAS float*)(lds + 131072);
            if (lane < 32) { red[(wave * 32 + lane) * 2] = cs; red[(wave * 32 + lane) * 2 + 1] = ds; }
            __syncthreads();
            if (tid < 32) { float ct = 0.f, dt = 0.f;
#pragma unroll
                for (int w8 = 0; w8 < 8; ++w8) { ct += red[(w8 * 32 + tid) * 2]; dt += red[(w8 * 32 + tid) * 2 + 1]; }
                const int oi = (mode == 0) ? col : (32 * (col >> 4) + (col & 15) + (mode == 2 ? 16 : 0));
                cd[oi] = ct; cd[cdn + oi] = dt; }
        }
        LAS float* scr = (LAS float*)(lds + wave * 16384);
        constexpr int I_IN = (DM / 64) * (INW / 32), I_SQ = (DM / 64) * (DM / 32), I_KV = (DM / 64) * (2048 / 32), I_GU = (DM / 64) * (DFF / 32), I_DN = (DFF / 64) * (DM / 32), I_PL = 2 * 4;
        constexpr int NITEMS = I_IN + 3 * I_SQ + I_KV + 2 * I_GU + I_DN + 4 * I_PL;
        for (int it = gw; it < NITEMS; it += NGW) {
            int r = it;
            if (r < I_IN) { p0_transpose_item(c.in[I_WIN], DM, INW, Win_t, 0, scr, r, lane); continue; } r -= I_IN;
            if (r < I_SQ) { if (r >= 8 * (DM / 32)) p0_transpose_item(c.in[I_WOUT], DM, DM, Wout_t, 0, scr, r, lane); continue; } r -= I_SQ;
            if (r < I_SQ) { continue; } r -= I_SQ;
            if (r < I_SQ) { p0_transpose_item(c.in[I_WXO], DM, DM, Wxo_t, 0, scr, r, lane); continue; } r -= I_SQ;
            if (r < I_KV) { p0_transpose_item(c.in[I_WXKV], DM, 2048, Wxkv_t, 0, scr, r, lane); continue; } r -= I_KV;
            if (r < I_GU) { p0_transpose_item(c.in[I_WGATE], DM, DFF, Wgu_t, 1, scr, r, lane, c.in[I_LN2G]); continue; } r -= I_GU;
            if (r < I_GU) { p0_transpose_item(c.in[I_WUP], DM, DFF, Wgu_t, 2, scr, r, lane, c.in[I_LN2G]); continue; } r -= I_GU;
            if (r < I_DN) { p0_transpose_item(c.in[I_WDOWN], DFF, DM, Wdn_t, 0, scr, r, lane); continue; } r -= I_DN;
            { const int gidx = r / I_PL; p0_transpose_item(c.in[I_WPOOL] + gidx * 16384, 128, 128, Wpool_t + gidx * 16384, 0, scr, r % I_PL, lane); }
        }
        const size_t gtid = (size_t)vcu * 512 + tid, nthr = (size_t)G * 512;
        for (size_t idx = gtid; idx < (size_t)512 * DM; idx += nthr) {
            const int n = (int)(idx & (DM - 1)), k = (int)(idx >> 10), gidx = k >> 7;
            const float* wp = c.in[I_WPOOL] + (size_t)k * 128;
            const float* ps = c.in[I_PSCALE] + gidx * 128;
            const float* wo = c.in[I_WOUT] + (size_t)(gidx * 128) * DM + n;
            float a = 0.f;
#pragma unroll 8
            for (int d = 0; d < 128; ++d) a += wp[d] * ps[d] * wo[(size_t)d * DM];
            const unsigned pk = cvt_pk_bf16(a, 0.f);
            Wout_t[(size_t)n * DM + k] = (bf16_t)(pk & 0xffffu);
        }
        for (size_t i8 = gtid; i8 < (size_t)DM * DM / 8; i8 += nthr) {
            const float gsc = c.in[I_LN1G][(i8 * 8) >> 10]; const f32x4 a = *(const f32x4*)(c.in[I_WXQ] + i8 * 8) * gsc, b4 = *(const f32x4*)(c.in[I_WXQ] + i8 * 8 + 4) * gsc;
            u32x4 o; o.x = cvt_pk_bf16(a[0], a[1]); o.y = cvt_pk_bf16(a[2], a[3]); o.z = cvt_pk_bf16(b4[0], b4[1]); o.w = cvt_pk_bf16(b4[2], b4[3]); *(u32x4*)(Wxq_t + i8 * 8) = o; }
        for (size_t i4 = gtid; i4 < (size_t)BATCH * 8 * NBLK * 64 / 4; i4 += nthr) *((f32x4*)KM + i4) = (f32x4){0.f, 0.f, 0.f, 0.f};
        cvt_rows_bf16(c.in[I_X], XB, (size_t)TOK * DM / 8, gtid, nthr);
        cvt_rows_bf16(c.in[I_MEM], MEMB, (size_t)MEMROWS * DM / 8, gtid, nthr);
    }
    if constexpr (PH == 1) {
        { pg8::Gemm g{XB, Win_t, TOK, INW, DM}; pg8::StaticOrder S; S.init(TOK, INW, G, bx); pg8::EpiBf16 E{Z, INW, KM}; pg8::gemm_phase(lds, g, S, E); }
        { pg8::Gemm g{MEMB, Wxkv_t, MEMROWS, 2048, DM}; pg8::StaticOrder S; S.init(MEMROWS, 2048, G, bx); pg8::EpiBf16 E{MEMKV, 2048}; pg8::gemm_phase(lds, g, S, E); }
    }
    if constexpr (PH == 2) {
        for (int run = gw; run < TOK / 32; run += NGW) {
            const int wdw = 2 << (lane >> 4);
            const size_t t0 = (size_t)run * 32; const int tpos0 = (int)(t0 & (SEQ - 1));
            const bf16_t* up = Z + t0 * INW + lane * 8;
            bf16_t* op = MIX + t0 * DM + lane * 8;
            float sacc[8] = {0.f, 0.f, 0.f, 0.f, 0.f, 0.f, 0.f, 0.f};
#pragma unroll 1
            for (int ib = 1; ib <= 16; ib += 8) { bf16x8 ui[8]; bool ok[8];
#pragma unroll
                for (int q = 0; q < 8; ++q) { const int i = ib + q; ok[q] = (i <= wdw && tpos0 - i >= 0); ui[q] = *(const bf16x8*)(up - (size_t)(ok[q] ? i : 0) * INW); }
#pragma unroll
                for (int q = 0; q < 8; ++q) if (ok[q]) {
#pragma unroll
                    for (int e8 = 0; e8 < 8; ++e8) sacc[e8] += bf2f((unsigned short)ui[q][e8]); } }
#pragma unroll 1
            for (int tb = 0; tb < 32; tb += 8) {
                bf16x8 un[8], uo[8];
#pragma unroll
                for (int i = 0; i < 8; ++i) { un[i] = *(const bf16x8*)(up + (size_t)(tb + i) * INW);
                    const int told = tpos0 + tb + i - wdw; uo[i] = *(const bf16x8*)(up + (size_t)(tb + i - (told >= 0 ? wdw : 0)) * INW); }
#pragma unroll
                for (int i = 0; i < 8; ++i) { const int tpos = tpos0 + tb + i; const bool sub = tpos - wdw >= 0;
                    const float rc = 1.0f / (float)((tpos + 1 < wdw) ? tpos + 1 : wdw); float p[8];
#pragma unroll
                    for (int e8 = 0; e8 < 8; ++e8) { const float uv = bf2f((unsigned short)un[i][e8]); sacc[e8] += uv; if (sub) sacc[e8] -= bf2f((unsigned short)uo[i][e8]); p[e8] = sacc[e8] * rc - uv; }
                    u32x4 pw; pw.x = cvt_pk_bf16(p[0], p[1]); pw.y = cvt_pk_bf16(p[2], p[3]); pw.z = cvt_pk_bf16(p[4], p[5]); pw.w = cvt_pk_bf16(p[6], p[7]);
                    *(u32x4*)(op + (size_t)(tb + i) * DM) = pw; }
            }
        }
    }
    if constexpr (PH == 2) {
        bf16_t* BtM = WSP(bf16_t, WS_BTM); bf16_t* BtN = WSP(bf16_t, WS_BTN); float* CB = WSP(float, WS_CDB); float* DB = CB + 16 * 1024;
        { pg8::Gemm g{MEMKV, Wxq_t, 64 * 256, 1024, 256, 2048, 1024, 2}; pg8::StaticOrder S; S.init(64 * 256, 1024, G, bx); pg8::EpiPrep E{BtM, 0.0625f, 0}; pg8::gemm_phase(lds, g, S, E); }
        { pg8::Gemm g{Wxo_t, MEMKV + 1024, 64 * 256, 1024, 256, 1024, 2048, 3}; pg8::StaticOrder S; S.init(64 * 256, 1024, G, bx); pg8::EpiPrep E{BtN, 1.0f, 1}; pg8::gemm_phase(lds, g, S, E); }
        const float* cx = WSP(float, WS_CDX); const float* dx = cx + DM;
        for (int o8 = vcu * 512 + tid; o8 < 16 * 1024 * 8; o8 += G * 512) {
            const int o = o8 >> 3, part = o8 & 7;
            const int bt = o >> 10, hm = o & 1023, hh = hm >> 8, mm = hm & 255;
            const bf16_t* kr = MEMKV + (size_t)(bt * 256 + mm) * 2048 + hh * 256; float ca = 0.f, da = 0.f;
#pragma unroll
            for (int it = 0; it < 4; ++it) { const int d8 = part + 8 * it; const bf16x8 kv = *(const bf16x8*)(kr + d8 * 8);
                const f32x4 c0 = *(const f32x4*)(cx + hh * 256 + d8 * 8), c1 = *(const f32x4*)(cx + hh * 256 + d8 * 8 + 4), d0 = *(const f32x4*)(dx + hh * 256 + d8 * 8), d1 = *(const f32x4*)(dx + hh * 256 + d8 * 8 + 4);
#pragma unroll
                for (int e8 = 0; e8 < 8; ++e8) { const float kf = bf2f((unsigned short)kv[e8]); ca += (e8 < 4 ? c0[e8 & 3] : c1[e8 & 3]) * kf; da += (e8 < 4 ? d0[e8 & 3] : d1[e8 & 3]) * kf; } }
            ca += __shfl_xor(ca, 1); ca += __shfl_xor(ca, 2); ca += __shfl_xor(ca, 4); da += __shfl_xor(da, 1); da += __shfl_xor(da, 2); da += __shfl_xor(da, 4);
            if (part == 0) { CB[o] = ca * 0.0625f; DB[o] = da * 0.0625f; }
        }
    }
    if constexpr (PH == 3) {
        for (int it = 0; it * G < BATCH * 8 * NBLK; ++it) {
            const int u = it * G + vcu; if (u >= BATCH * 8 * NBLK) break;
            int bh = u >> 4, blk = u & 15;
            if (G == 256) { bh = it * 16 + (vcu >> 4); blk = ((vcu & 15) + 2 * it) & 15; }
            moba_unit(bh >> 3, bh & 7, blk, Z, KM, MIX, lds);
        }
    }
    if constexpr (PH == 4) { pg8::Gemm g{MIX, Wout_t, TOK, DM, DM}; pg8::StaticOrder S; S.init(TOK, DM, G, bx); pg8::EpiResStat<false, true> E{XB, XB, DM, ALPHA, nullptr, nullptr, nullptr, PST1}; pg8::gemm_phase(lds, g, S, E); }
    if constexpr (PH == 5) { }
    if constexpr (PH == 6) { pg8::Gemm g{XB, WSP(bf16_t, WS_BTM), TOK, DM, DM, 0, 0, 1, (size_t)DM * DM * 2}; pg8::StaticOrder S; S.init(TOK, DM, G, bx); pg8::EpiSoftmaxP E{XQ, PST1, WSP(float, WS_CDB), WSP(float, WS_CDB) + 16 * 1024, (LAS float*)(lds + 131072)}; pg8::gemm_phase(lds, g, S, E); }
    if constexpr (PH == 7) { for (int u = vcu; u < (TOK / 128) * 4; u += G) xattn_unit(u >> 2, u & 3, XQ, MEMKV, XO, lds); }
    if constexpr (PH == 8) { pg8::Gemm g{XQ, WSP(bf16_t, WS_BTN), TOK, DM, DM, 0, 0, 1, (size_t)DM * DM * 2}; pg8::StaticOrder S; S.init(TOK, DM, G, bx); pg8::EpiResStat<true, true> E{XB, XB, DM, ALPHA, PST1, c.in[I_LN1G], c.in[I_LN1B], PST2}; pg8::gemm_phase(lds, g, S, E); }
    if constexpr (PH == 9) { }
    if constexpr (PH == 10) { pg8::Gemm g{XB, Wgu_t, TOK, 2 * DFF, DM}; pg8::StaticOrder S; S.init(TOK, 2 * DFF, G, bx); pg8::EpiLnSwiGLU E{HF, DFF, PST2, WSP(float, WS_CDG), WSP(float, WS_CDG) + 2 * DFF}; pg8::gemm_phase(lds, g, S, E); }
    if constexpr (PH == 11) { pg8::Gemm g{HF, Wdn_t, TOK, DM, DFF}; pg8::StaticOrder S; S.init(TOK, DM, G, bx); pg8::EpiResStat<true, false> E{XB, XB, DM, ALPHA, PST2, c.in[I_LN2G], c.in[I_LN2B], nullptr}; pg8::gemm_phase(lds, g, S, E); }
    if constexpr (PH == 12) { for (int r = gw * 4; r < TOK; r += NGW * 4) ln_rows4_bf16in(XB + (size_t)r * DM, c.in[I_LN3G], c.in[I_LN3B], H + (size_t)r * DM, DM, lane); }
}

__global__ void __launch_bounds__(512, 2) fwd_kernel(Args args) {
    extern __shared__ __attribute__((aligned(16))) unsigned char lds_raw[];
    Ctx c;
    c.in = args.in; c.lds = (LAS unsigned char*)lds_raw; c.ws = args.ws; c.H = args.out;
    c.tid = threadIdx.x; c.lane = c.tid & 63; c.wave = __builtin_amdgcn_readfirstlane(c.tid >> 6);
    c.G = gridDim.x; c.bx = blockIdx.x;
    c.vcu = (c.G % 8 == 0) ? (c.bx % 8) * (c.G / 8) + c.bx / 8 : c.bx;
    c.gw = c.vcu * 8 + c.wave; c.NGW = c.G * 8;
    const int lo = args.ph_lo, hi = args.ph_hi;
    volatile LAS unsigned* MISC = (volatile LAS unsigned*)(c.lds + LDS_MISC);
    if (c.tid < 2) MISC[c.tid] = 0u;
    __syncthreads();
    XcdBarrier bar; bar.bar = (unsigned*)(args.ws + WS_CTL); bar.x = 0; bar.st = MISC;
    if (hi - lo > 1) bar = xcd_barrier_post((unsigned*)(args.ws + WS_CTL), MISC);
    if (hi < 0) cg::this_grid().sync();
#define IN(k) (lo <= (k) && (k) < hi)
#define PHASE(k) do { if (IN(k)) { run_phase<k>(c); if (PROBE_PHASE == (k)) { xcd_barrier(bar); run_phase<k>(c); } } \
        if (IN(k) && IN((k) + 1)) { xcd_barrier(bar); } } while (0)
    PHASE(0); PHASE(1); PHASE(2); PHASE(3); PHASE(4); PHASE(6); PHASE(8); PHASE(10); PHASE(11); PHASE(12);
#undef IN
#undef PHASE
}

extern "C" void kernel_launch(void* const* d_in, const int* in_sizes, int n_in, void* d_out, int out_size, void* d_ws, size_t ws_size, hipStream_t stream) {
    static int grid = 0;
    if (grid == 0) {
        if (n_in != 18 || out_size != TOK * DM || ws_size < WS_END) { fprintf(stderr, "kernel_launch: unexpected shapes (n_in %d, out %d, ws %zu)\n", n_in, out_size, ws_size); grid = -1; return; }
        int dev = 0, cus = 0, per_cu = 0;
        (void)hipGetDevice(&dev); (void)hipDeviceGetAttribute(&cus, hipDeviceAttributeMultiprocessorCount, dev);
        if (hipFuncSetAttribute((const void*)fwd_kernel, hipFuncAttributeMaxDynamicSharedMemorySize, LDS_BYTES) != hipSuccess) { fprintf(stderr, "kernel_launch: hipFuncSetAttribute failed\n"); grid = -1; return; }
        if (hipOccupancyMaxActiveBlocksPerMultiprocessor(&per_cu, (const void*)fwd_kernel, 512, LDS_BYTES) != hipSuccess || per_cu < 1) { fprintf(stderr, "kernel_launch: occupancy query says %d\n", per_cu); per_cu = 1; }
        (void)hipGetLastError();
        grid = cus * 1;
        if (grid <= 0) grid = 256;
    }
    if (grid < 0) return;
    Args a{};
    for (int i = 0; i < 18; ++i) a.in[i] = (const float*)d_in[i];
    a.out = (float*)d_out; a.ws = (unsigned char*)d_ws;
#if N_LAUNCH_MODE == 1
    for (int p = 0; p < N_PHASES; ++p) { a.ph_lo = p; a.ph_hi = p + 1; hipLaunchKernelGGL(fwd_kernel, dim3(grid), dim3(512), LDS_BYTES, stream, a); }
#else
    a.ph_lo = 0; a.ph_hi = N_PHASES;
    (void)hipMemsetAsync((unsigned char*)d_ws + WS_CTL, 0, CTL_BYTES, stream);
    void* kargs[] = {&a};
    hipError_t e = hipLaunchCooperativeKernel((const void*)fwd_kernel, dim3(grid), dim3(512), kargs, LDS_BYTES, stream);
    if (e != hipSuccess) fprintf(stderr, "kernel_launch: cooperative launch failed: %s (grid %d)\n", hipGetErrorString(e), grid);
#endif
}
```

```cpp
#include <hip/hip_runtime.h>
#include <hip/hip_cooperative_groups.h>
#include <cstdio>
#include <cstdint>
namespace cg = cooperative_groups;

#ifndef N_LAUNCH_MODE
#define N_LAUNCH_MODE 0
#endif

#define LAS __attribute__((address_space(3)))
typedef unsigned short bf16_t;
typedef short bf16x8 __attribute__((ext_vector_type(8)));
typedef short s16x4 __attribute__((ext_vector_type(4)));
typedef float f32x4 __attribute__((ext_vector_type(4)));
typedef float f32x2 __attribute__((ext_vector_type(2)));
typedef unsigned u32x4 __attribute__((ext_vector_type(4)));
typedef unsigned u32x2 __attribute__((ext_vector_type(2)));

constexpr int BATCH = 16, SEQ = 4096, DM = 1024, TOK = BATCH * SEQ;
constexpr int MEMLEN = 256, MEMROWS = BATCH * MEMLEN;
constexpr int INW = 2048, DFF = 2816, NBLK = SEQ / 256;
constexpr float ALPHA = 1.189207115002721f;
constexpr float LN_EPS = 1e-5f;
constexpr float LOG2E = 1.4426950408889634f;

constexpr size_t MiB = 1u << 20;
constexpr size_t WS_KM = 0;
constexpr size_t WS_CTL = 1 * MiB, CTL_BYTES = 16384;
constexpr size_t WS_WIN = 2 * MiB, WS_WOUT = 6 * MiB, WS_WXQ = 8 * MiB, WS_WXKV = 10 * MiB, WS_WXO = 14 * MiB, WS_WGU = 16 * MiB, WS_WDN = 27 * MiB, WS_WPOOL = 33 * MiB;
constexpr size_t WS_MEMB = 34 * MiB, WS_MEMKV = 42 * MiB;
constexpr size_t WS_XB = 64 * MiB;
constexpr size_t WS_Z = 192 * MiB;
constexpr size_t WS_MIX = 448 * MiB;
constexpr size_t WS_HF = 192 * MiB;
constexpr size_t WS_PST1 = 576 * MiB, WS_PST2 = 584 * MiB;
constexpr size_t WS_CDX = 60 * MiB, WS_CDG = 60 * MiB + 65536;
constexpr size_t WS_CDB = 60 * MiB + 131072;
constexpr size_t WS_BTM = 592 * MiB, WS_BTN = 624 * MiB;
constexpr size_t WS_END = 656 * MiB;

typedef __bf16 bf16x2_t __attribute__((ext_vector_type(2)));
__device__ __forceinline__ unsigned cvt_pk_bf16(float lo, float hi) { f32x2 v = {lo, hi}; bf16x2_t b = __builtin_convertvector(v, bf16x2_t); return __builtin_bit_cast(unsigned, b); }
__device__ __forceinline__ float xmax16(float v) { auto r = __builtin_amdgcn_permlane16_swap(__float_as_uint(v), __float_as_uint(v), false, false); return fmaxf(__uint_as_float(r[0]), __uint_as_float(r[1])); }
__device__ __forceinline__ float xmax32(float v) { auto r = __builtin_amdgcn_permlane32_swap(__float_as_uint(v), __float_as_uint(v), false, false); return fmaxf(__uint_as_float(r[0]), __uint_as_float(r[1])); }
__device__ __forceinline__ float xsum16(float v) { auto r = __builtin_amdgcn_permlane16_swap(__float_as_uint(v), __float_as_uint(v), false, false); return __uint_as_float(r[0]) + __uint_as_float(r[1]); }
__device__ __forceinline__ float xsum32(float v) { auto r = __builtin_amdgcn_permlane32_swap(__float_as_uint(v), __float_as_uint(v), false, false); return __uint_as_float(r[0]) + __uint_as_float(r[1]); }
__device__ __forceinline__ float bf2f(unsigned short b) { return __uint_as_float(((unsigned)b) << 16); }
__device__ __forceinline__ float wave_sum(float v) {
#pragma unroll
    for (int o = 1; o < 64; o <<= 1) v += __shfl_xor(v, o);
    return v;
}

namespace pg8 {
constexpr int BM = 256, BK = 64, HALF = 128, HTB = HALF * BK * 2, STAGE_BYTES = 8 * HTB, NXCD = 8, WGM = 4;
__host__ __device__ __forceinline__ int lds_byte(int r, int c) { const int st = (r >> 4) * 2 + (c >> 5), rr = r & 15, cc = c & 31, ob = rr * 64 + cc * 2; return st * 1024 + (ob ^ (((ob >> 9) & 1) << 5)); }
__host__ __device__ __forceinline__ void stage_rc(int b, int& R, int& C) { const int st = b / 1024, sb = b % 1024, swz = sb ^ (((sb >> 9) & 1) << 5); R = (st >> 1) * 16 + swz / 64; C = (st & 1) * 32 + (swz % 64) / 2; }
__host__ __device__ __forceinline__ int perm32(int rho) { const int n = rho >> 4, i = rho & 15; return 8 * (i >> 2) + 4 * n + (i & 3); }

struct Unit { int pm, pn; };
struct Gemm { const bf16_t* A; const bf16_t* Bt; int M, N, K; int lda = 0, ldb = 0, mode = 0; size_t s1 = 0; };
__device__ __forceinline__ void unit_ptrs(const Gemm& g, const Unit& u, const char*& cA, const char*& cB) {
    const int lda = g.lda ? g.lda : g.K, ldb = g.ldb ? g.ldb : g.K;
    if (g.mode <= 1) { cA = (const char*)g.A + (size_t)u.pm * BM * lda * 2; cB = (const char*)g.Bt + (size_t)u.pn * BM * ldb * 2 + (g.mode == 1 ? (size_t)(u.pm >> 4) * g.s1 : 0); }
    else if (g.mode == 2) { cA = (const char*)g.A + (size_t)(u.pm >> 2) * 256 * lda * 2 + (size_t)(u.pm & 3) * 512; cB = (const char*)g.Bt + (size_t)u.pn * BM * ldb * 2 + (size_t)(u.pm & 3) * 512; }
    else { cA = (const char*)g.A + (size_t)u.pn * BM * lda * 2 + (size_t)(u.pm & 3) * 512; cB = (const char*)g.Bt + (size_t)(u.pm >> 2) * 256 * ldb * 2 + (size_t)(u.pm & 3) * 512; }
}

struct StaticOrder {
    int nM, nN, nwg, G, c;
    __device__ void init(int M, int N, int G_, int c_) { nM = M / BM; nN = N / BM; nwg = nM * nN; G = G_; c = c_; }
    __device__ bool next(int i, Unit& u) const {
        const long L = (long)i * G + c; if (L >= nwg) return false;
        int wgid = (int)L; { const int q = nwg / NXCD, r = nwg % NXCD, xcd = wgid % NXCD, off = wgid / NXCD; wgid = (xcd < r ? xcd * (q + 1) : r * (q + 1) + (xcd - r) * q) + off; }
        const int nig = WGM * nN, gid = wgid / nig, fm = gid * WGM, gsz = (nM - fm) < WGM ? (nM - fm) : WGM;
        u.pm = fm + ((wgid % nig) % gsz); u.pn = (wgid % nig) / gsz; return true;
    }
};

struct EpiBf16 {
    static constexpr bool PERM = true;
    bf16_t* O; int ldc; float* km = nullptr;
    __device__ __forceinline__ void operator()(const f32x4 (&acc)[2][2][4][2], const Unit& u, int wr, int wc, int fr, int fq) const {
        const int row0 = u.pm * BM + wr * 64 + fr; const int col0 = u.pn * BM + wc * 32 + 8 * fq;
#pragma unroll
        for (int ai = 0; ai < 2; ++ai)
#pragma unroll
            for (int m = 0; m < 4; ++m) { bf16_t* rowp = O + (size_t)(row0 + ai * HALF + m * 16) * ldc + col0;
#pragma unroll
                for (int bj = 0; bj < 2; ++bj) { const f32x4 v0 = acc[ai][bj][m][0], v1 = acc[ai][bj][m][1];
                    u32x4 w; w.x = cvt_pk_bf16(v0[0], v0[1]); w.y = cvt_pk_bf16(v0[2], v0[3]); w.z = cvt_pk_bf16(v1[0], v1[1]); w.w = cvt_pk_bf16(v1[2], v1[3]);
                    *(u32x4*)(rowp + bj * HALF) = w; } }
        if (km && (u.pn == 4 || u.pn == 5)) {
#pragma unroll
            for (int bj = 0; bj < 2; ++bj)
#pragma unroll
                for (int n = 0; n < 2; ++n) { f32x4 cs = (f32x4){0.f, 0.f, 0.f, 0.f};
#pragma unroll
                    for (int ai = 0; ai < 2; ++ai)
#pragma unroll
                        for (int m = 0; m < 4; ++m) cs = cs + acc[ai][bj][m][n];
#pragma unroll
                    for (int j = 0; j < 4; ++j) { float v = cs[j]; v += __shfl_xor(v, 1); v += __shfl_xor(v, 2); v += __shfl_xor(v, 4); v += __shfl_xor(v, 8);
                        if (fr == 0) { const int kc = (u.pn - 4) * 256 + bj * HALF + wc * 32 + 8 * fq + 4 * n + j;
                            __hip_atomic_fetch_add(km + (size_t)(((u.pm >> 4) * 8 + (kc >> 6)) * 16 + (u.pm & 15)) * 64 + (kc & 63), v * (1.0f / 256.0f), __ATOMIC_RELAXED, __HIP_MEMORY_SCOPE_AGENT); } } }
        }
    }
};
__device__ __forceinline__ void row_stats(const float* pst, int row, int fq, float& mu, float& rstd) {
    const f32x4 a = *(const f32x4*)(pst + (size_t)row * 32 + 8 * fq), b = *(const f32x4*)(pst + (size_t)row * 32 + 8 * fq + 4);
    float s1 = (a[0] + a[2]) + (b[0] + b[2]), s2 = (a[1] + a[3]) + (b[1] + b[3]);
    s1 = xsum32(xsum16(s1)); s2 = xsum32(xsum16(s2));
    mu = s1 * (1.0f / 1024.0f); const float var = s2 * (1.0f / 1024.0f) - mu * mu; rstd = 1.0f / sqrtf(var + LN_EPS);
}
template <bool HAS_LN, bool HAS_OUT> struct EpiResStat {
    static constexpr bool PERM = true;
    const bf16_t* R; bf16_t* YB; int ldc; float alpha; const float* st_in; const float* g; const float* b; float* st_out;
    __device__ __forceinline__ void operator()(const f32x4 (&acc)[2][2][4][2], const Unit& u, int wr, int wc, int fr, int fq) const {
        const int row0 = u.pm * BM + wr * 64 + fr; const int col0 = u.pn * BM + wc * 32 + 8 * fq;
        f32x4 gv[2][2], bv[2][2];
        if (HAS_LN) {
#pragma unroll
            for (int bj = 0; bj < 2; ++bj)
#pragma unroll
                for (int n = 0; n < 2; ++n) { gv[bj][n] = *(const f32x4*)(g + col0 + bj * HALF + 4 * n); bv[bj][n] = *(const f32x4*)(b + col0 + bj * HALF + 4 * n); }
        }
#pragma unroll
        for (int ai = 0; ai < 2; ++ai)
#pragma unroll
            for (int m = 0; m < 4; ++m) { const int row = row0 + ai * HALF + m * 16; const size_t off = (size_t)row * ldc + col0;
                float mu = 0.f, rs = 1.f; if (HAS_LN) row_stats(st_in, row, fq, mu, rs);
                float s1 = 0.f, s2 = 0.f;
#pragma unroll
                for (int bj = 0; bj < 2; ++bj) { const u32x4 rr = *(const u32x4*)(R + off + bj * HALF);
                    f32x4 v0 = (f32x4){__uint_as_float(rr.x << 16), __uint_as_float(rr.x & 0xffff0000u), __uint_as_float(rr.y << 16), __uint_as_float(rr.y & 0xffff0000u)};
                    f32x4 v1 = (f32x4){__uint_as_float(rr.z << 16), __uint_as_float(rr.z & 0xffff0000u), __uint_as_float(rr.w << 16), __uint_as_float(rr.w & 0xffff0000u)};
                    if (HAS_LN) { v0 = (v0 - mu) * rs * gv[bj][0] + bv[bj][0]; v1 = (v1 - mu) * rs * gv[bj][1] + bv[bj][1]; }
                    const f32x4 y0 = v0 * alpha + acc[ai][bj][m][0], y1 = v1 * alpha + acc[ai][bj][m][1];
                    u32x4 w; w.x = cvt_pk_bf16(y0[0], y0[1]); w.y = cvt_pk_bf16(y0[2], y0[3]); w.z = cvt_pk_bf16(y1[0], y1[1]); w.w = cvt_pk_bf16(y1[2], y1[3]);
                    *(u32x4*)(YB + off + bj * HALF) = w;
                    s1 += ((y0[0] + y0[1]) + (y0[2] + y0[3])) + ((y1[0] + y1[1]) + (y1[2] + y1[3]));
                    s2 += ((y0[0] * y0[0] + y0[1] * y0[1]) + (y0[2] * y0[2] + y0[3] * y0[3])) + ((y1[0] * y1[0] + y1[1] * y1[1]) + (y1[2] * y1[2] + y1[3] * y1[3])); }
                if (HAS_OUT) { s1 = xsum32(xsum16(s1)); s2 = xsum32(xsum16(s2));
                    if (fq == 0) *(f32x2*)(st_out + (size_t)row * 32 + (u.pn * 4 + wc) * 2) = (f32x2){s1, s2}; } }
    }
};
struct EpiLnBf16 {
    static constexpr bool PERM = true;
    bf16_t* O; int ldc; const float* st_in; const float* cvec; const float* dvec;
    __device__ __forceinline__ void operator()(const f32x4 (&acc)[2][2][4][2], const Unit& u, int wr, int wc, int fr, int fq) const {
        const int row0 = u.pm * BM + wr * 64 + fr; const int col0 = u.pn * BM + wc * 32 + 8 * fq;
        f32x4 cv[2][2], dv[2][2];
#pragma unroll
        for (int bj = 0; bj < 2; ++bj)
#pragma unroll
            for (int n = 0; n < 2; ++n) { cv[bj][n] = *(const f32x4*)(cvec + col0 + bj * HALF + 4 * n); dv[bj][n] = *(const f32x4*)(dvec + col0 + bj * HALF + 4 * n); }
#pragma unroll
        for (int ai = 0; ai < 2; ++ai)
#pragma unroll
            for (int m = 0; m < 4; ++m) { const int row = row0 + ai * HALF + m * 16; bf16_t* rowp = O + (size_t)row * ldc + col0;
                float mu, rs; row_stats(st_in, row, fq, mu, rs);
#pragma unroll
                for (int bj = 0; bj < 2; ++bj) { const f32x4 v0 = (acc[ai][bj][m][0] - cv[bj][0] * mu) * rs + dv[bj][0], v1 = (acc[ai][bj][m][1] - cv[bj][1] * mu) * rs + dv[bj][1];
                    u32x4 w; w.x = cvt_pk_bf16(v0[0], v0[1]); w.y = cvt_pk_bf16(v0[2], v0[3]); w.z = cvt_pk_bf16(v1[0], v1[1]); w.w = cvt_pk_bf16(v1[2], v1[3]);
                    *(u32x4*)(rowp + bj * HALF) = w; } }
    }
};
struct EpiLnSwiGLU {
    static constexpr bool PERM = false;
    bf16_t* O; int ldc; const float* st_in; const float* cvec; const float* dvec;
    __device__ __forceinline__ void operator()(const f32x4 (&acc)[2][2][4][2], const Unit& u, int wr, int wc, int fr, int fq) const {
        const int row0 = u.pm * BM + wr * 64 + fr; const int col0 = u.pn * HALF + wc * 16 + 4 * fq; const int gcol0 = u.pn * BM + wc * 32 + 4 * fq;
        f32x4 cv[2][2], dv[2][2];
#pragma unroll
        for (int bj = 0; bj < 2; ++bj)
#pragma unroll
            for (int n = 0; n < 2; ++n) { cv[bj][n] = *(const f32x4*)(cvec + gcol0 + bj * HALF + 16 * n); dv[bj][n] = *(const f32x4*)(dvec + gcol0 + bj * HALF + 16 * n); }
#pragma unroll
        for (int ai = 0; ai < 2; ++ai)
#pragma unroll
            for (int m = 0; m < 4; ++m) { const int row = row0 + ai * HALF + m * 16; bf16_t* rowp = O + (size_t)row * ldc + col0;
                float mu, rs; row_stats(st_in, row, fq, mu, rs);
#pragma unroll
                for (int bj = 0; bj < 2; ++bj) { const f32x4 g = (acc[ai][bj][m][0] - cv[bj][0] * mu) * rs + dv[bj][0], up = (acc[ai][bj][m][1] - cv[bj][1] * mu) * rs + dv[bj][1]; float h[4];
#pragma unroll
                    for (int j = 0; j < 4; ++j) { const float s = g[j] * __builtin_amdgcn_rcpf(1.0f + __builtin_amdgcn_exp2f(-g[j] * LOG2E)); h[j] = s * up[j]; }
                    u32x2 w; w.x = cvt_pk_bf16(h[0], h[1]); w.y = cvt_pk_bf16(h[2], h[3]);
                    *(u32x2*)(rowp + bj * 64) = w; } }
    }
};

struct EpiPrep {
    static constexpr bool PERM = true;
    bf16_t* O; float scale; int omode;
    __device__ __forceinline__ void operator()(const f32x4 (&acc)[2][2][4][2], const Unit& u, int wr, int wc, int fr, int fq) const {
        bf16_t* base = (omode == 0) ? O + (size_t)u.pm * 256 * 1024 + u.pn * 256 : O + (size_t)(u.pm >> 2) * 1048576 + (size_t)u.pn * 256 * 1024 + (u.pm & 3) * 256;
        base += (size_t)(wr * 64 + fr) * 1024 + wc * 32 + 8 * fq;
#pragma unroll
        for (int ai = 0; ai < 2; ++ai)
#pragma unroll
            for (int m = 0; m < 4; ++m) { bf16_t* rowp = base + (size_t)(ai * HALF + m * 16) * 1024;
#pragma unroll
                for (int bj = 0; bj < 2; ++bj) { const f32x4 v0 = acc[ai][bj][m][0] * scale, v1 = acc[ai][bj][m][1] * scale;
                    u32x4 w; w.x = cvt_pk_bf16(v0[0], v0[1]); w.y = cvt_pk_bf16(v0[2], v0[3]); w.z = cvt_pk_bf16(v1[0], v1[1]); w.w = cvt_pk_bf16(v1[2], v1[3]);
                    *(u32x4*)(rowp + bj * HALF) = w; } }
    }
};
struct EpiSoftmaxP {
    static constexpr bool PERM = true;
    bf16_t* P; const float* st_in; const float* cb; const float* db; LAS float* xb;
    __device__ __forceinline__ void operator()(f32x4 (&acc)[2][2][4][2], const Unit& u, int wr, int wc, int fr, int fq) const {
        const int rl0 = wr * 64 + fr; const int col0 = u.pn * BM + wc * 32 + 8 * fq; const int bt = u.pm >> 4;
        {
            f32x4 cv[2][2], dv[2][2];
#pragma unroll
            for (int bj = 0; bj < 2; ++bj)
#pragma unroll
                for (int n = 0; n < 2; ++n) { cv[bj][n] = *(const f32x4*)(cb + bt * 1024 + col0 + bj * HALF + 4 * n); dv[bj][n] = *(const f32x4*)(db + bt * 1024 + col0 + bj * HALF + 4 * n); }
#pragma unroll
            for (int ai = 0; ai < 2; ++ai)
#pragma unroll
                for (int m = 0; m < 4; ++m) { const int rl = rl0 + ai * HALF + m * 16;
                    float mu, rs; row_stats(st_in, u.pm * BM + rl, fq, mu, rs);
                    float mx = -INFINITY;
#pragma unroll
                    for (int bj = 0; bj < 2; ++bj)
#pragma unroll
                        for (int n = 0; n < 2; ++n) { const f32x4 s = (acc[ai][bj][m][n] - cv[bj][n] * mu) * rs + dv[bj][n]; acc[ai][bj][m][n] = s;
                            mx = fmaxf(fmaxf(mx, s[0]), fmaxf(s[1], fmaxf(s[2], s[3]))); }
                    mx = xmax32(xmax16(mx));
                    if (fq == 0) xb[rl * 4 + wc] = mx; }
        }
        asm volatile("s_waitcnt lgkmcnt(0)" ::: "memory"); __builtin_amdgcn_s_barrier(); asm volatile("" ::: "memory");
#pragma unroll
        for (int ai = 0; ai < 2; ++ai)
#pragma unroll
            for (int m = 0; m < 4; ++m) { const int rl = rl0 + ai * HALF + m * 16;
                const f32x4 mm = *(const LAS f32x4*)(xb + rl * 4); const float rmax = fmaxf(fmaxf(mm[0], mm[1]), fmaxf(mm[2], mm[3])) * LOG2E;
                float sm = 0.f;
#pragma unroll
                for (int bj = 0; bj < 2; ++bj)
#pragma unroll
                    for (int n = 0; n < 2; ++n) { f32x4 p;
#pragma unroll
                        for (int j = 0; j < 4; ++j) p[j] = __builtin_amdgcn_exp2f(__builtin_fmaf(acc[ai][bj][m][n][j], LOG2E, -rmax));
                        acc[ai][bj][m][n] = p; sm += (p[0] + p[1]) + (p[2] + p[3]); }
                sm = xsum32(xsum16(sm));
                if (fq == 0) xb[1024 + rl * 4 + wc] = sm; }
        asm volatile("s_waitcnt lgkmcnt(0)" ::: "memory"); __builtin_amdgcn_s_barrier(); asm volatile("" ::: "memory");
#pragma unroll
        for (int ai = 0; ai < 2; ++ai)
#pragma unroll
            for (int m = 0; m < 4; ++m) { const int rl = rl0 + ai * HALF + m * 16;
                const f32x4 ss = *(const LAS f32x4*)(xb + 1024 + rl * 4); const float inv = 1.0f / ((ss[0] + ss[1]) + (ss[2] + ss[3]));
                bf16_t* rowp = P + (size_t)(u.pm * BM + rl) * 1024 + col0;
#pragma unroll
                for (int bj = 0; bj < 2; ++bj) { const f32x4 v0 = acc[ai][bj][m][0] * inv, v1 = acc[ai][bj][m][1] * inv;
                    u32x4 w; w.x = cvt_pk_bf16(v0[0], v0[1]); w.y = cvt_pk_bf16(v0[2], v0[3]); w.z = cvt_pk_bf16(v1[0], v1[1]); w.w = cvt_pk_bf16(v1[2], v1[3]);
                    *(u32x4*)(rowp + bj * HALF) = w; } }
    }
};

template <class Epi, class Sched>
__device__ __forceinline__ void gemm_phase(LAS unsigned char* lds, const Gemm g, const Sched S, const Epi E) {
    const int tid = threadIdx.x, wid = __builtin_amdgcn_readfirstlane(tid >> 6), lane = tid & 63, wr = wid >> 2, wc = wid & 3, fr = lane & 15, fq = lane >> 4;
    const int K = g.K, nt = K / BK;
    const int lda = g.lda ? g.lda : K, ldb = g.ldb ? g.ldb : K;
    unsigned voffA[2], voffB[2];
#pragma unroll
    for (int i = 0; i < 2; ++i) { int R, C; stage_rc(tid * 16 + i * 8192, R, C); const int Rb = Epi::PERM ? ((R & ~31) + perm32(R & 31)) : R;
        voffA[i] = (unsigned)(R * lda + C) * 2u; voffB[i] = (unsigned)(Rb * ldb + C) * 2u; }
    const size_t kstep = (size_t)(BK * 2);
    const size_t hstepA = (size_t)HALF * lda * 2, hstepB = (size_t)HALF * ldb * 2;
    const unsigned ldsw = (unsigned)wid * 1024u;
    const int aoff = lds_byte(wr * 64 + fr, fq * 8), boff = lds_byte(wc * 32 + fr, fq * 8);
#define PG8_SA(b, h) (((b) * 2 + (h)) * HTB)
#define PG8_SB(b, h) ((4 + (b) * 2 + (h)) * HTB)
#define PG8_STAGE(bufoff, gbase, voff) do { _Pragma("unroll") for (int _i = 0; _i < 2; ++_i) \
        __builtin_amdgcn_global_load_lds((const unsigned*)((const char*)(gbase) + (voff)[_i]), (LAS unsigned*)(lds + (bufoff) + ldsw + _i * 8192), 16, 0, 0); } while (0)
#define PG8_LDA(dst, b, h) do { _Pragma("unroll") for (int m = 0; m < 4; ++m) _Pragma("unroll") for (int k = 0; k < 2; ++k) dst[m][k] = *(const LAS bf16x8*)(lds + PG8_SA(b, h) + aoff + m * 2048 + k * 1024); } while (0)
#define PG8_LDB(dst, b, h) do { _Pragma("unroll") for (int n = 0; n < 2; ++n) _Pragma("unroll") for (int k = 0; k < 2; ++k) dst[n][k] = *(const LAS bf16x8*)(lds + PG8_SB(b, h) + boff + n * 2048 + k * 1024); } while (0)
#define PG8_MMA(ai, bj, At, Bt) do { __builtin_amdgcn_s_setprio(1); _Pragma("unroll") for (int m = 0; m < 4; ++m) _Pragma("unroll") for (int n = 0; n < 2; ++n) _Pragma("unroll") for (int k = 0; k < 2; ++k) \
        acc[ai][bj][m][n] = __builtin_amdgcn_mfma_f32_16x16x32_bf16(Bt[n][k], At[m][k], acc[ai][bj][m][n], 0, 0, 0); __builtin_amdgcn_s_setprio(0); } while (0)
#define PG8_WAIT_V(n) asm volatile("s_waitcnt vmcnt(" #n ")" ::: "memory")
#define PG8_WAIT_L(n) asm volatile("s_waitcnt lgkmcnt(" #n ")" ::: "memory")
#define PG8_BAR __builtin_amdgcn_s_barrier()
#define PG8_SCHED __builtin_amdgcn_sched_barrier(0)
    Unit cur, nxt; int ui = 0;
    if (!S.next(0, cur)) return;
    f32x4 acc[2][2][4][2];
#pragma unroll
    for (int a = 0; a < 2; ++a)
#pragma unroll
        for (int b = 0; b < 2; ++b)
#pragma unroll
            for (int m = 0; m < 4; ++m)
#pragma unroll
                for (int n = 0; n < 2; ++n) acc[a][b][m][n] = (f32x4){0.f, 0.f, 0.f, 0.f};
    bf16x8 At[4][2], B0[2][2], B1[2][2];
    const char* cA; const char* cB; unit_ptrs(g, cur, cA, cB);
    PG8_STAGE(PG8_SB(0, 0), cB, voffB); PG8_STAGE(PG8_SB(0, 1), cB + hstepB, voffB); PG8_STAGE(PG8_SA(0, 0), cA, voffA); PG8_STAGE(PG8_SA(0, 1), cA + hstepA, voffA);
    if (wr == 1) PG8_BAR;
    PG8_WAIT_V(2); PG8_BAR;
    PG8_STAGE(PG8_SB(1, 0), cB + kstep, voffB); PG8_STAGE(PG8_SA(1, 0), cA + kstep, voffA); PG8_STAGE(PG8_SB(1, 1), cB + hstepB + kstep, voffB);
    PG8_WAIT_V(6); PG8_BAR;
    for (;;) {
        const bool has_next = S.next(ui + 1, nxt);
        const char* nA = cA; const char* nB = cB; if (has_next) unit_ptrs(g, nxt, nA, nB);
#pragma unroll 1
        for (int t = 0; t < nt; t += 2) {
            const bool last = (t == nt - 2);
            const char* a1 = cA + (size_t)(t + 1) * kstep;
            const char* a2 = last ? nA : cA + (size_t)(t + 2) * kstep; const char* b2 = last ? nB : cB + (size_t)(t + 2) * kstep;
            const char* a3 = a2 + kstep; const char* b3 = b2 + kstep;
            PG8_LDB(B0, 0, 0); PG8_LDB(B1, 0, 1); PG8_SCHED; PG8_LDA(At, 0, 0); PG8_STAGE(PG8_SA(1, 1), a1 + hstepA, voffA);
            PG8_WAIT_V(8); PG8_WAIT_L(0); PG8_BAR; PG8_MMA(0, 0, At, B0); PG8_MMA(0, 1, At, B1); PG8_BAR; PG8_SCHED;
            PG8_LDA(At, 0, 1); PG8_STAGE(PG8_SB(0, 0), b2, voffB); PG8_STAGE(PG8_SB(0, 1), b2 + hstepB, voffB); PG8_STAGE(PG8_SA(0, 0), a2, voffA);
            PG8_WAIT_V(8); PG8_WAIT_L(0); PG8_BAR; PG8_MMA(1, 0, At, B0); PG8_MMA(1, 1, At, B1); PG8_BAR; PG8_SCHED;
            PG8_LDB(B0, 1, 0); PG8_LDB(B1, 1, 1); PG8_SCHED; PG8_LDA(At, 1, 0); PG8_STAGE(PG8_SA(0, 1), a2 + hstepA, voffA);
            PG8_WAIT_V(8); PG8_WAIT_L(0); PG8_BAR; PG8_MMA(0, 0, At, B0); PG8_MMA(0, 1, At, B1); PG8_BAR; PG8_SCHED;
            PG8_LDA(At, 1, 1); PG8_STAGE(PG8_SB(1, 0), b3, voffB); PG8_STAGE(PG8_SB(1, 1), b3 + hstepB, voffB); PG8_STAGE(PG8_SA(1, 0), a3, voffA);
            PG8_WAIT_V(8); PG8_WAIT_L(0); PG8_BAR; PG8_MMA(1, 0, At, B0); PG8_MMA(1, 1, At, B1); PG8_BAR; PG8_SCHED;
        }
        if (wr == 0) PG8_BAR;
        E(acc, cur, wr, wc, fr, fq);
        if (!has_next) break;
#pragma unroll
        for (int a = 0; a < 2; ++a)
#pragma unroll
            for (int b = 0; b < 2; ++b)
#pragma unroll
                for (int m = 0; m < 4; ++m)
#pragma unroll
                    for (int n = 0; n < 2; ++n) acc[a][b][m][n] = (f32x4){0.f, 0.f, 0.f, 0.f};
        cur = nxt; cA = nA; cB = nB; ++ui;
        if (wr == 1) PG8_BAR;
    }
    PG8_WAIT_V(0);
    PG8_BAR;
#undef PG8_SA
#undef PG8_SB
#undef PG8_STAGE
#undef PG8_LDA
#undef PG8_LDB
#undef PG8_MMA
#undef PG8_WAIT_V
#undef PG8_WAIT_L
#undef PG8_BAR
#undef PG8_SCHED
}
}

__device__ __forceinline__ s16x4 tr_read(const LAS unsigned char* p) { return __builtin_bit_cast(s16x4, __builtin_amdgcn_ds_read_tr16_b64_v4i16((LAS s16x4*)p)); }

template <int HD, int QI, int KT16 = 4>
__device__ __forceinline__ void attn_tile(const LAS unsigned char* Ks, const LAS unsigned char* Vs, const bf16x8 (&qf)[QI][HD / 32],
                                          float (&m)[QI], float (&l)[QI], f32x4 (&o)[QI][HD / 16], float sc,
                                          int maskmode, const int (&qloc)[QI], int kbase, const bool (&keep)[QI], int fr, int fq) {
    constexpr int KP = 2 * HD + 32;
    f32x4 s[QI][KT16];
#pragma unroll
    for (int qi = 0; qi < QI; ++qi)
#pragma unroll
        for (int kt = 0; kt < KT16; ++kt) s[qi][kt] = (f32x4){0.f, 0.f, 0.f, 0.f};
#pragma unroll
    for (int kt = 0; kt < KT16; ++kt)
#pragma unroll
        for (int dk = 0; dk < HD / 32; ++dk) {
            const bf16x8 kf = *(const LAS bf16x8*)(Ks + (16 * kt + fr) * KP + (32 * dk + 8 * fq) * 2);
#pragma unroll
            for (int qi = 0; qi < QI; ++qi) s[qi][kt] = __builtin_amdgcn_mfma_f32_16x16x32_bf16(kf, qf[qi][dk], s[qi][kt], 0, 0, 0);
        }
    float mxs[QI]; bool need = false;
#pragma unroll
    for (int qi = 0; qi < QI; ++qi) {
        if (maskmode == 1) {
#pragma unroll
            for (int kt = 0; kt < KT16; ++kt)
#pragma unroll
                for (int r = 0; r < 4; ++r) if (kbase + 16 * kt + 4 * fq + r > qloc[qi]) s[qi][kt][r] = -INFINITY;
        }
        float mx = fmaxf(fmaxf(s[qi][0][0], s[qi][0][1]), fmaxf(s[qi][0][2], s[qi][0][3]));
#pragma unroll
        for (int kt = 1; kt < KT16; ++kt) { mx = fmaxf(fmaxf(mx, s[qi][kt][0]), s[qi][kt][1]); mx = fmaxf(fmaxf(mx, s[qi][kt][2]), s[qi][kt][3]); }
        mx = xmax32(xmax16(mx));
        mxs[qi] = mx * sc;
        need = need || (keep[qi] && mxs[qi] > m[qi] + 8.0f);
    }
    if (__ballot(need) != 0ull) {
#pragma unroll
        for (int qi = 0; qi < QI; ++qi) {
            const bool upd = keep[qi] && mxs[qi] > m[qi] + 8.0f;
            const float mn = upd ? mxs[qi] : m[qi];
            const float al = __builtin_amdgcn_exp2f(m[qi] - mn); m[qi] = mn; l[qi] *= al;
#pragma unroll
            for (int dt = 0; dt < HD / 16; ++dt) o[qi][dt] = o[qi][dt] * al;
        }
    }
    bf16x8 pf[QI][KT16 / 2];
#pragma unroll
    for (int qi = 0; qi < QI; ++qi) {
        const float moff = keep[qi] ? -m[qi] : -INFINITY;
        float rs = 0.f;
#pragma unroll
        for (int kt = 0; kt < KT16; ++kt)
#pragma unroll
            for (int r = 0; r < 4; ++r) { const float p = __builtin_amdgcn_exp2f(__builtin_fmaf(s[qi][kt][r], sc, moff)); s[qi][kt][r] = p; rs += p; }
        l[qi] += rs;
#pragma unroll
        for (int p2 = 0; p2 < KT16 / 2; ++p2) {
            u32x4 w; w.x = cvt_pk_bf16(s[qi][2 * p2][0], s[qi][2 * p2][1]); w.y = cvt_pk_bf16(s[qi][2 * p2][2], s[qi][2 * p2][3]);
            w.z = cvt_pk_bf16(s[qi][2 * p2 + 1][0], s[qi][2 * p2 + 1][1]); w.w = cvt_pk_bf16(s[qi][2 * p2 + 1][2], s[qi][2 * p2 + 1][3]);
            pf[qi][p2] = __builtin_bit_cast(bf16x8, w);
        }
    }
    const LAS unsigned char* vb = Vs + (4 * fq + (fr >> 2)) * KP + (4 * (fr & 3)) * 2;
#pragma unroll
    for (int dt = 0; dt < HD / 16; ++dt)
#pragma unroll
        for (int p2 = 0; p2 < KT16 / 2; ++p2) {
            const s16x4 lo = tr_read(vb + (32 * p2) * KP + 32 * dt);
            const s16x4 hi = tr_read(vb + (32 * p2 + 16) * KP + 32 * dt);
            const bf16x8 vf = (bf16x8){lo[0], lo[1], lo[2], lo[3], hi[0], hi[1], hi[2], hi[3]};
#pragma unroll
            for (int qi = 0; qi < QI; ++qi) o[qi][dt] = __builtin_amdgcn_mfma_f32_16x16x32_bf16(vf, pf[qi][p2], o[qi][dt], 0, 0, 0);
        }
}

template <int HD, int QI, int KT16 = 4>
__device__ __forceinline__ void attn_tile_pl(const LAS unsigned char* Ks, const LAS unsigned char* Vs, const bf16x8 (&qf)[QI][HD / 32],
                                          float (&m)[QI], float (&l)[QI], f32x4 (&o)[QI][HD / 16], float sc,
                                          int maskmode, const int (&qloc)[QI], int kbase, const bool (&keep)[QI], int fr, int fq) {
    constexpr int KP = 2 * HD + 32;
    constexpr int NF = (HD / 32) * KT16, CH = 4, NCH = NF / CH;
    static_assert(NF % CH == 0, "fragment chunking");
    f32x4 s[QI][KT16];
#pragma unroll
    for (int qi = 0; qi < QI; ++qi)
#pragma unroll
        for (int kt = 0; kt < KT16; ++kt) s[qi][kt] = (f32x4){0.f, 0.f, 0.f, 0.f};
    const LAS unsigned char* kb = Ks + fr * KP + 16 * fq;
#define KFRAG(f) (*(const LAS bf16x8*)(kb + (16 * ((f) % KT16)) * KP + 64 * ((f) / KT16)))
    bf16x8 kf[2][CH];
#pragma unroll
    for (int i = 0; i < CH; ++i) kf[0][i] = KFRAG(i);
#pragma unroll
    for (int c = 0; c < NCH; ++c) {
        if (c + 1 < NCH) {
#pragma unroll
            for (int i = 0; i < CH; ++i) kf[(c + 1) & 1][i] = KFRAG((c + 1) * CH + i);
        }
        __builtin_amdgcn_sched_barrier(0);
#pragma unroll
        for (int i = 0; i < CH; ++i) { const int f = c * CH + i, kt = f % KT16, dk = f / KT16;
#pragma unroll
            for (int qi = 0; qi < QI; ++qi) s[qi][kt] = __builtin_amdgcn_mfma_f32_16x16x32_bf16(kf[c & 1][i], qf[qi][dk], s[qi][kt], 0, 0, 0); }
        __builtin_amdgcn_sched_barrier(0);
    }
#undef KFRAG
    constexpr int NV = (KT16 / 2) * (HD / 16), NVC = NV / CH;
    static_assert(NV % CH == 0, "V fragment chunking");
    const LAS unsigned char* vb = Vs + (4 * fq + (fr >> 2)) * KP + (4 * (fr & 3)) * 2;
#define VLO(g) tr_read(vb + (32 * ((g) / (HD / 16))) * KP + 32 * ((g) % (HD / 16)))
#define VHI(g) tr_read(vb + (32 * ((g) / (HD / 16)) + 16) * KP + 32 * ((g) % (HD / 16)))
    s16x4 vlo[2][CH], vhi[2][CH];
#pragma unroll
    for (int i = 0; i < CH; ++i) { vlo[0][i] = VLO(i); vhi[0][i] = VHI(i); }
    __builtin_amdgcn_sched_barrier(0);
    float mxs[QI]; bool need = false;
#pragma unroll
    for (int qi = 0; qi < QI; ++qi) {
        if (maskmode == 1) {
#pragma unroll
            for (int kt = 0; kt < KT16; ++kt)
#pragma unroll
                for (int r = 0; r < 4; ++r) if (kbase + 16 * kt + 4 * fq + r > qloc[qi]) s[qi][kt][r] = -INFINITY;
        }
        float mx = fmaxf(fmaxf(s[qi][0][0], s[qi][0][1]), fmaxf(s[qi][0][2], s[qi][0][3]));
#pragma unroll
        for (int kt = 1; kt < KT16; ++kt) { mx = fmaxf(fmaxf(mx, s[qi][kt][0]), s[qi][kt][1]); mx = fmaxf(fmaxf(mx, s[qi][kt][2]), s[qi][kt][3]); }
        mx = xmax32(xmax16(mx));
        mxs[qi] = mx * sc;
        need = need || (keep[qi] && mxs[qi] > m[qi] + 8.0f);
    }
    if (__ballot(need) != 0ull) {
#pragma unroll
        for (int qi = 0; qi < QI; ++qi) {
            const bool upd = keep[qi] && mxs[qi] > m[qi] + 8.0f;
            const float mn = upd ? mxs[qi] : m[qi];
            const float al = __builtin_amdgcn_exp2f(m[qi] - mn); m[qi] = mn; l[qi] *= al;
#pragma unroll
            for (int dt = 0; dt < HD / 16; ++dt) o[qi][dt] = o[qi][dt] * al;
        }
    }
    bf16x8 pf[QI][KT16 / 2];
#pragma unroll
    for (int qi = 0; qi < QI; ++qi) {
        const float moff = keep[qi] ? -m[qi] : -INFINITY;
        float rs = 0.f;
#pragma unroll
        for (int kt = 0; kt < KT16; ++kt)
#pragma unroll
            for (int r = 0; r < 4; ++r) { const float p = __builtin_amdgcn_exp2f(__builtin_fmaf(s[qi][kt][r], sc, moff)); s[qi][kt][r] = p; rs += p; }
        l[qi] += rs;
#pragma unroll
        for (int p2 = 0; p2 < KT16 / 2; ++p2) {
            u32x4 w; w.x = cvt_pk_bf16(s[qi][2 * p2][0], s[qi][2 * p2][1]); w.y = cvt_pk_bf16(s[qi][2 * p2][2], s[qi][2 * p2][3]);
            w.z = cvt_pk_bf16(s[qi][2 * p2 + 1][0], s[qi][2 * p2 + 1][1]); w.w = cvt_pk_bf16(s[qi][2 * p2 + 1][2], s[qi][2 * p2 + 1][3]);
            pf[qi][p2] = __builtin_bit_cast(bf16x8, w);
        }
    }
    __builtin_amdgcn_sched_barrier(0);
#pragma unroll
    for (int c = 0; c < NVC; ++c) {
        if (c + 1 < NVC) {
#pragma unroll
            for (int i = 0; i < CH; ++i) { vlo[(c + 1) & 1][i] = VLO((c + 1) * CH + i); vhi[(c + 1) & 1][i] = VHI((c + 1) * CH + i); }
        }
        __builtin_amdgcn_sched_barrier(0);
#pragma unroll
        for (int i = 0; i < CH; ++i) { const int g = c * CH + i, p2 = g / (HD / 16), dt = g % (HD / 16);
            const s16x4 lo = vlo[c & 1][i], hi = vhi[c & 1][i];
            const bf16x8 vf = (bf16x8){lo[0], lo[1], lo[2], lo[3], hi[0], hi[1], hi[2], hi[3]};
#pragma unroll
            for (int qi = 0; qi < QI; ++qi) o[qi][dt] = __builtin_amdgcn_mfma_f32_16x16x32_bf16(vf, pf[qi][p2], o[qi][dt], 0, 0, 0); }
        __builtin_amdgcn_sched_barrier(0);
    }
#undef VLO
#undef VHI
}

template <int HD> struct Stage { static constexpr int CH = HD / 8, NLD = 64 * CH / 512, KP = 2 * HD + 32, TILE_B = 64 * KP; u32x4 k[NLD], v[NLD]; };
template <int HD>
__device__ __forceinline__ void stage_load(Stage<HD>& st, const bf16_t* Kg, const bf16_t* Vg, int gp, int tid) {
#pragma unroll
    for (int i = 0; i < Stage<HD>::NLD; ++i) { const int idx = tid + 512 * i, row = idx / Stage<HD>::CH, ch = idx % Stage<HD>::CH;
        st.k[i] = *(const u32x4*)(Kg + (size_t)row * gp + ch * 8); st.v[i] = *(const u32x4*)(Vg + (size_t)row * gp + ch * 8); }
}
template <int HD>
__device__ __forceinline__ void stage_store(const Stage<HD>& st, LAS unsigned char* buf, int tid) {
#pragma unroll
    for (int i = 0; i < Stage<HD>::NLD; ++i) { const int idx = tid + 512 * i, row = idx / Stage<HD>::CH, ch = idx % Stage<HD>::CH;
        *(LAS u32x4*)(buf + row * Stage<HD>::KP + ch * 16) = st.k[i]; *(LAS u32x4*)(buf + Stage<HD>::TILE_B + row * Stage<HD>::KP + ch * 16) = st.v[i]; }
}

namespace moba {
constexpr int HD = 64, KP = 2 * HD + 32, BLKB = 256 * KP;
constexpr int L_K = 0, L_V = BLKB, L_O = 2 * BLKB, L_M = L_O + 256 * 128, L_L = L_M + 1024, L_LIST = L_L + 1024, L_CNT = L_LIST + 15 * 256, L_Q = L_CNT + 64, L_END = L_Q + 256 * 128;
struct BlkStage { u32x4 k[4], v[4]; };
__device__ __forceinline__ void blk_load(BlkStage& st, const bf16_t* Kg, const bf16_t* Vg, int tid) {
#pragma unroll
    for (int i = 0; i < 4; ++i) { const int idx = tid + 512 * i, row = idx >> 3, ch = idx & 7;
        st.k[i] = *(const u32x4*)(Kg + (size_t)row * INW + ch * 8); st.v[i] = *(const u32x4*)(Vg + (size_t)row * INW + ch * 8); }
}
__device__ __forceinline__ void blk_store(const BlkStage& st, LAS unsigned char* lds, int tid) {
#pragma unroll
    for (int i = 0; i < 4; ++i) { const int idx = tid + 512 * i, row = idx >> 3, ch = idx & 7;
        *(LAS u32x4*)(lds + L_K + row * KP + ch * 16) = st.k[i]; *(LAS u32x4*)(lds + L_V + row * KP + ch * 16) = st.v[i]; }
}
template <int QI>
__device__ __forceinline__ void past_tiles(LAS unsigned char* lds, const int (&rows)[QI], const bool (&valid)[QI], float sc, int fr, int fq) {
    bf16x8 qf[QI][2]; float m[QI], l[QI]; f32x4 o[QI][4]; int qloc[QI];
#pragma unroll
    for (int qi = 0; qi < QI; ++qi) {
#pragma unroll
        for (int dk = 0; dk < 2; ++dk) qf[qi][dk] = *(const LAS bf16x8*)(lds + L_Q + rows[qi] * 128 + (32 * dk + 8 * fq) * 2);
        m[qi] = *(const LAS float*)(lds + L_M + rows[qi] * 4);
        l[qi] = (fq == 0) ? *(const LAS float*)(lds + L_L + rows[qi] * 4) : 0.f;
        qloc[qi] = 0;
#pragma unroll
        for (int dt = 0; dt < 4; ++dt) { const u32x2 ov = *(const LAS u32x2*)(lds + L_O + rows[qi] * 128 + (16 * dt + 4 * fq) * 2);
            o[qi][dt] = (f32x4){__uint_as_float(ov.x << 16), __uint_as_float(ov.x & 0xffff0000u), __uint_as_float(ov.y << 16), __uint_as_float(ov.y & 0xffff0000u)}; }
    }
    if constexpr (QI == 1) attn_tile_pl<HD, 1, 16>(lds + L_K, lds + L_V, qf, m, l, o, sc, 0, qloc, 0, valid, fr, fq);
    else {
#pragma unroll 1
        for (int half = 0; half < 2; ++half)
            attn_tile<HD, QI, 8>(lds + L_K + half * 128 * KP, lds + L_V + half * 128 * KP, qf, m, l, o, sc, 0, qloc, 0, valid, fr, fq);
    }
#pragma unroll
    for (int qi = 0; qi < QI; ++qi) {
        const float lt = xsum32(xsum16(l[qi]));
        if (valid[qi]) {
            if (fq == 0) { *(LAS float*)(lds + L_M + rows[qi] * 4) = m[qi]; *(LAS float*)(lds + L_L + rows[qi] * 4) = lt; }
#pragma unroll
            for (int dt = 0; dt < 4; ++dt) { u32x2 ov; ov.x = cvt_pk_bf16(o[qi][dt][0], o[qi][dt][1]); ov.y = cvt_pk_bf16(o[qi][dt][2], o[qi][dt][3]);
                *(LAS u32x2*)(lds + L_O + rows[qi] * 128 + (16 * dt + 4 * fq) * 2) = ov; }
        }
    }
}
}

__device__ __forceinline__ void moba_unit(int b, int h, int blk, const bf16_t* Z, const float* KM, bf16_t* MIX, LAS unsigned char* lds) {
    using namespace moba;
    constexpr int QI = 2;
    const int tid = threadIdx.x, lane = tid & 63, w = __builtin_amdgcn_readfirstlane(tid >> 6), fr = lane & 15, fq = lane >> 4;
    const size_t rowb = (size_t)b * SEQ;
    const int q0 = 256 * blk + 32 * w;
    const bf16_t* Kh = Z + rowb * INW + 1024 + h * 64; const bf16_t* Vh = Z + rowb * INW + 1536 + h * 64;
    const bf16_t* Qblk = Z + (rowb + 256 * blk) * INW + 512 + h * 64;
    BlkStage st;
    blk_load(st, Kh + (size_t)(256 * blk) * INW, Vh + (size_t)(256 * blk) * INW, tid);
    bf16x8 qf[QI][2];
#pragma unroll
    for (int qi = 0; qi < QI; ++qi)
#pragma unroll
        for (int dk = 0; dk < 2; ++dk) qf[qi][dk] = *(const bf16x8*)(Qblk + (size_t)(32 * w + 16 * qi + fr) * INW + 32 * dk + 8 * fq);
    __syncthreads();
    if (tid < 16) *(LAS unsigned*)(lds + L_CNT + tid * 4) = 0u;
    if (blk > 0) {
#pragma unroll
        for (int i = 0; i < 4; ++i) { const int idx = tid + 512 * i, row = idx >> 3, ch = idx & 7;
            *(LAS u32x4*)(lds + L_Q + row * 128 + ch * 16) = *(const u32x4*)(Qblk + (size_t)row * INW + ch * 8); }
    }
    __syncthreads();
    {
        float v1[QI], v2[QI], v3[QI]; int i1[QI], i2[QI], i3[QI];
#pragma unroll
        for (int qi = 0; qi < QI; ++qi) { v1[qi] = v2[qi] = v3[qi] = -INFINITY; i1[qi] = i2[qi] = i3[qi] = -1; }
        const float* kmb = KM + (size_t)((b * 8 + h) * NBLK) * 64;
        for (int j = 0; j < blk; ++j) {
            f32x4 km[2][2];
#pragma unroll
            for (int dk = 0; dk < 2; ++dk) { km[dk][0] = *(const f32x4*)(kmb + j * 64 + 32 * dk + 8 * fq); km[dk][1] = *(const f32x4*)(kmb + j * 64 + 32 * dk + 8 * fq + 4); }
#pragma unroll
            for (int qi = 0; qi < QI; ++qi) {
                float g = 0.f;
#pragma unroll
                for (int dk = 0; dk < 2; ++dk)
#pragma unroll
                    for (int e = 0; e < 8; ++e) g += bf2f((unsigned short)qf[qi][dk][e]) * km[dk][e >> 2][e & 3];
                g = xsum32(xsum16(g));
                if (g > v1[qi]) { v3[qi] = v2[qi]; i3[qi] = i2[qi]; v2[qi] = v1[qi]; i2[qi] = i1[qi]; v1[qi] = g; i1[qi] = j; }
                else if (g > v2[qi]) { v3[qi] = v2[qi]; i3[qi] = i2[qi]; v2[qi] = g; i2[qi] = j; }
                else if (g > v3[qi]) { v3[qi] = g; i3[qi] = j; }
            }
        }
        if (fq == 0) {
#pragma unroll
            for (int qi = 0; qi < QI; ++qi) { const int row = 32 * w + 16 * qi + fr; const int ids[3] = {i1[qi], i2[qi], i3[qi]};
#pragma unroll
                for (int k3 = 0; k3 < 3; ++k3) if (ids[k3] >= 0) {
                    const unsigned pos = __hip_atomic_fetch_add((LAS unsigned*)(lds + L_CNT + ids[k3] * 4), 1u, __ATOMIC_RELAXED, __HIP_MEMORY_SCOPE_WORKGROUP);
                    *(LAS unsigned char*)(lds + L_LIST + ids[k3] * 256 + pos) = (unsigned char)row; } }
        }
    }
    blk_store(st, lds, tid);
    __syncthreads();
    { const int jn = blk > 0 ? 0 : blk; blk_load(st, Kh + (size_t)(256 * jn) * INW, Vh + (size_t)(256 * jn) * INW, tid); }
    const float sc = 0.125f * LOG2E;
    {
        float m[QI], l[QI]; f32x4 o[QI][4]; int qloc[QI]; bool keep[QI];
#pragma unroll
        for (int qi = 0; qi < QI; ++qi) { m[qi] = -1e30f; l[qi] = 0.f; qloc[qi] = 32 * w + 16 * qi + fr; keep[qi] = true;
#pragma unroll
            for (int dt = 0; dt < 4; ++dt) o[qi][dt] = (f32x4){0.f, 0.f, 0.f, 0.f}; }
#pragma unroll 1
        for (int half = 0; half < 2; ++half)
            if (128 * half <= 32 * w) attn_tile<HD, QI, 8>(lds + L_K + half * 128 * KP, lds + L_V + half * 128 * KP, qf, m, l, o, sc, 1, qloc, 128 * half, keep, fr, fq);
#pragma unroll
        for (int qi = 0; qi < QI; ++qi) {
            const float lt = xsum32(xsum16(l[qi])); const int row = 32 * w + 16 * qi + fr;
            if (blk == 0) {
                const float inv = 1.0f / lt; bf16_t* op = MIX + (rowb + q0 + 16 * qi + fr) * DM + 512 + h * 64 + 4 * fq;
#pragma unroll
                for (int dt = 0; dt < 4; ++dt) { const f32x4 v = o[qi][dt] * inv; u32x2 wv; wv.x = cvt_pk_bf16(v[0], v[1]); wv.y = cvt_pk_bf16(v[2], v[3]); *(u32x2*)(op + 16 * dt) = wv; }
            } else {
                if (fq == 0) { *(LAS float*)(lds + L_M + row * 4) = m[qi]; *(LAS float*)(lds + L_L + row * 4) = lt; }
#pragma unroll
                for (int dt = 0; dt < 4; ++dt) { u32x2 ov; ov.x = cvt_pk_bf16(o[qi][dt][0], o[qi][dt][1]); ov.y = cvt_pk_bf16(o[qi][dt][2], o[qi][dt][3]);
                    *(LAS u32x2*)(lds + L_O + row * 128 + (16 * dt + 4 * fq) * 2) = ov; }
            }
        }
    }
    for (int j = 0; j < blk; ++j) {
        __syncthreads();
        blk_store(st, lds, tid);
        __syncthreads();
        { const int jn = (j + 1 < blk) ? j + 1 : j; blk_load(st, Kh + (size_t)(256 * jn) * INW, Vh + (size_t)(256 * jn) * INW, tid); }
        const int n = (int)*(const LAS unsigned*)(lds + L_CNT + j * 4);
        const int tiles = (n + 15) >> 4;
        for (int tw = w; tw < tiles; tw += 8) {
            int rows[1]; bool valid[1];
            { const int idx = 16 * tw + fr; valid[0] = idx < n; rows[0] = *(const LAS unsigned char*)(lds + L_LIST + j * 256 + (valid[0] ? idx : 0)); }
            past_tiles<1>(lds, rows, valid, sc, fr, fq);
        }
    }
    if (blk > 0) {
        __syncthreads();
#pragma unroll
        for (int qi = 0; qi < QI; ++qi) {
            const int row = 32 * w + 16 * qi + fr;
            const float inv = 1.0f / *(const LAS float*)(lds + L_L + row * 4);
            bf16_t* op = MIX + (rowb + q0 + 16 * qi + fr) * DM + 512 + h * 64 + 4 * fq;
#pragma unroll
            for (int dt = 0; dt < 4; ++dt) { const u32x2 ov = *(const LAS u32x2*)(lds + L_O + row * 128 + (16 * dt + 4 * fq) * 2);
                const f32x4 v = (f32x4){__uint_as_float(ov.x << 16), __uint_as_float(ov.x & 0xffff0000u), __uint_as_float(ov.y << 16), __uint_as_float(ov.y & 0xffff0000u)} * inv;
                u32x2 wv; wv.x = cvt_pk_bf16(v[0], v[1]); wv.y = cvt_pk_bf16(v[2], v[3]); *(u32x2*)(op + 16 * dt) = wv; }
        }
    }
}

__device__ __forceinline__ void xattn_unit(int qt, int hd, const bf16_t* XQ, const bf16_t* MEMKV, bf16_t* XO, LAS unsigned char* lds) {
    constexpr int HD = 256, QI = 1, TB = Stage<HD>::TILE_B;
    const int tid = threadIdx.x, lane = tid & 63, w = __builtin_amdgcn_readfirstlane(tid >> 6), fr = lane & 15, fq = lane >> 4;
    const int b = qt >> 5;
    const size_t qrow = (size_t)qt * 128 + 16 * w + fr;
    bf16x8 qf[QI][HD / 32];
#pragma unroll
    for (int dk = 0; dk < HD / 32; ++dk) qf[0][dk] = *(const bf16x8*)(XQ + qrow * DM + hd * 256 + 32 * dk + 8 * fq);
    float m[QI] = {-1e30f}, l[QI] = {0.f}; f32x4 o[QI][HD / 16]; int qloc[QI] = {0}; bool keep[QI] = {true};
#pragma unroll
    for (int dt = 0; dt < HD / 16; ++dt) o[0][dt] = (f32x4){0.f, 0.f, 0.f, 0.f};
    const float sc = 0.0625f * LOG2E;
    const bf16_t* Kh = MEMKV + (size_t)b * MEMLEN * 2048 + hd * 256; const bf16_t* Vh = Kh + 1024;
    Stage<HD> st;
    __syncthreads();
    stage_load<HD>(st, Kh, Vh, 2048, tid);
    stage_store<HD>(st, lds, tid);
    __syncthreads();
    for (int t = 0; t < 4; ++t) {
        if (t + 1 < 4) stage_load<HD>(st, Kh + (size_t)(64 * (t + 1)) * 2048, Vh + (size_t)(64 * (t + 1)) * 2048, 2048, tid);
        const LAS unsigned char* buf = lds + (t & 1) * 2 * TB;
        attn_tile<HD, QI>(buf, buf + TB, qf, m, l, o, sc, 0, qloc, 0, keep, fr, fq);
        if (t + 1 < 4) stage_store<HD>(st, lds + ((t + 1) & 1) * 2 * TB, tid);
        __syncthreads();
    }
    float ls = xsum32(xsum16(l[0]));
    const float inv = 1.0f / ls;
    bf16_t* op = XO + qrow * DM + hd * 256 + 4 * fq;
#pragma unroll
    for (int dt = 0; dt < HD / 16; ++dt) { const f32x4 v = o[0][dt] * inv; u32x2 wv; wv.x = cvt_pk_bf16(v[0], v[1]); wv.y = cvt_pk_bf16(v[2], v[3]); *(u32x2*)(op + 16 * dt) = wv; }
}

__device__ __forceinline__ void p0_transpose_item(const float* W, int K, int N, bf16_t* WT, int mode, LAS float* scr, int item, int lane, const float* ks = nullptr) {
    const int nblk = N / 32, kb = item / nblk, nb = item % nblk, k0 = 64 * kb, n0 = 32 * nb;
    float wv[32];
#pragma unroll
    for (int i = 0; i < 32; ++i) wv[i] = W[(size_t)(k0 + 2 * i + (lane >> 5)) * N + n0 + (lane & 31)];
#pragma unroll
    for (int i = 0; i < 32; ++i) { const int kk = 2 * i + (lane >> 5); scr[kk * 33 + (lane & 31)] = ks ? wv[i] * ks[k0 + kk] : wv[i]; }
    asm volatile("s_waitcnt lgkmcnt(0)" ::: "memory");
    const int c = lane & 7;
#pragma unroll
    for (int j = 0; j < 4; ++j) { const int n = (lane >> 3) + 8 * j; const LAS float* s = scr + (8 * c) * 33 + n;
        u32x4 o; o.x = cvt_pk_bf16(s[0 * 33], s[1 * 33]); o.y = cvt_pk_bf16(s[2 * 33], s[3 * 33]); o.z = cvt_pk_bf16(s[4 * 33], s[5 * 33]); o.w = cvt_pk_bf16(s[6 * 33], s[7 * 33]);
        const int gn = n0 + n; const int row = (mode == 0) ? gn : (32 * (gn >> 4) + (gn & 15) + (mode == 2 ? 16 : 0));
        *(u32x4*)(WT + (size_t)row * K + k0 + 8 * c) = o; }
    asm volatile("s_waitcnt lgkmcnt(0)" ::: "memory");
}
__device__ __forceinline__ void cvt_rows_bf16(const float* src, bf16_t* dst, size_t n8, size_t gtid, size_t nthr) {
    size_t i = gtid;
    for (; i + 3 * nthr < n8; i += 4 * nthr) {
        f32x4 a[4], b[4];
#pragma unroll
        for (int q = 0; q < 4; ++q) { a[q] = *(const f32x4*)(src + (i + q * nthr) * 8); b[q] = *(const f32x4*)(src + (i + q * nthr) * 8 + 4); }
#pragma unroll
        for (int q = 0; q < 4; ++q) { u32x4 o; o.x = cvt_pk_bf16(a[q][0], a[q][1]); o.y = cvt_pk_bf16(a[q][2], a[q][3]); o.z = cvt_pk_bf16(b[q][0], b[q][1]); o.w = cvt_pk_bf16(b[q][2], b[q][3]); *(u32x4*)(dst + (i + q * nthr) * 8) = o; }
    }
    for (; i < n8; i += nthr) { const f32x4 a = *(const f32x4*)(src + i * 8), b = *(const f32x4*)(src + i * 8 + 4);
        u32x4 o; o.x = cvt_pk_bf16(a[0], a[1]); o.y = cvt_pk_bf16(a[2], a[3]); o.z = cvt_pk_bf16(b[0], b[1]); o.w = cvt_pk_bf16(b[2], b[3]); *(u32x4*)(dst + i * 8) = o; }
}
__device__ __forceinline__ void ln_row(const float* yrow, const float* g, const float* bta, float* hrow, bf16_t* brow, int lane) {
    f32x4 v[4]; float s = 0.f;
#pragma unroll
    for (int j = 0; j < 4; ++j) { v[j] = *((const f32x4*)yrow + lane + 64 * j); s += (v[j][0] + v[j][1]) + (v[j][2] + v[j][3]); }
    const float mean = wave_sum(s) * (1.f / DM); float s2 = 0.f;
#pragma unroll
    for (int j = 0; j < 4; ++j) { v[j] = v[j] - mean; s2 += (v[j][0] * v[j][0] + v[j][1] * v[j][1]) + (v[j][2] * v[j][2] + v[j][3] * v[j][3]); }
    const float rstd = 1.f / sqrtf(wave_sum(s2) * (1.f / DM) + LN_EPS);
#pragma unroll
    for (int j = 0; j < 4; ++j) { const f32x4 gg = *((const f32x4*)g + lane + 64 * j), bb = *((const f32x4*)bta + lane + 64 * j);
        const f32x4 r = v[j] * rstd * gg + bb; *((f32x4*)hrow + lane + 64 * j) = r;
        if (brow) { u32x2 wv; wv.x = cvt_pk_bf16(r[0], r[1]); wv.y = cvt_pk_bf16(r[2], r[3]); *((u32x2*)brow + lane + 64 * j) = wv; } }
}

__device__ __forceinline__ void ln_row_bf16in(const bf16_t* yrow, const float* g, const float* bta, float* orow, int lane) {
    f32x4 v[4]; float s = 0.f;
#pragma unroll
    for (int j = 0; j < 2; ++j) { const u32x4 rr = *((const u32x4*)yrow + lane + 64 * j);
        v[2 * j] = (f32x4){__uint_as_float(rr.x << 16), __uint_as_float(rr.x & 0xffff0000u), __uint_as_float(rr.y << 16), __uint_as_float(rr.y & 0xffff0000u)};
        v[2 * j + 1] = (f32x4){__uint_as_float(rr.z << 16), __uint_as_float(rr.z & 0xffff0000u), __uint_as_float(rr.w << 16), __uint_as_float(rr.w & 0xffff0000u)};
        s += ((v[2 * j][0] + v[2 * j][1]) + (v[2 * j][2] + v[2 * j][3])) + ((v[2 * j + 1][0] + v[2 * j + 1][1]) + (v[2 * j + 1][2] + v[2 * j + 1][3])); }
    const float mean = wave_sum(s) * (1.f / DM); float s2 = 0.f;
#pragma unroll
    for (int j = 0; j < 4; ++j) { v[j] = v[j] - mean; s2 += (v[j][0] * v[j][0] + v[j][1] * v[j][1]) + (v[j][2] * v[j][2] + v[j][3] * v[j][3]); }
    const float rstd = 1.f / sqrtf(wave_sum(s2) * (1.f / DM) + LN_EPS);
#pragma unroll
    for (int q = 0; q < 4; ++q) { const int ci = 512 * (q >> 1) + 8 * lane + 4 * (q & 1);
        const f32x4 gg = *(const f32x4*)(g + ci), bb = *(const f32x4*)(bta + ci);
        *(f32x4*)(orow + ci) = v[q] * rstd * gg + bb; }
}

__device__ __forceinline__ void ln_rows4_bf16in(const bf16_t* y, const float* g, const float* bta, float* o, int ld, int lane) {
    u32x4 rr[4][2];
#pragma unroll
    for (int q = 0; q < 4; ++q)
#pragma unroll
        for (int j = 0; j < 2; ++j) rr[q][j] = *((const u32x4*)(y + (size_t)q * ld) + lane + 64 * j);
    f32x4 gg[4], bb[4];
#pragma unroll
    for (int c4 = 0; c4 < 4; ++c4) { const int ci = 512 * (c4 >> 1) + 8 * lane + 4 * (c4 & 1); gg[c4] = *(const f32x4*)(g + ci); bb[c4] = *(const f32x4*)(bta + ci); }
#pragma unroll
    for (int q = 0; q < 4; ++q) {
        f32x4 v[4]; float s = 0.f;
#pragma unroll
        for (int j = 0; j < 2; ++j) { const u32x4 w = rr[q][j];
            v[2 * j] = (f32x4){__uint_as_float(w.x << 16), __uint_as_float(w.x & 0xffff0000u), __uint_as_float(w.y << 16), __uint_as_float(w.y & 0xffff0000u)};
            v[2 * j + 1] = (f32x4){__uint_as_float(w.z << 16), __uint_as_float(w.z & 0xffff0000u), __uint_as_float(w.w << 16), __uint_as_float(w.w & 0xffff0000u)}; }
#pragma unroll
        for (int c4 = 0; c4 < 4; ++c4) s += (v[c4][0] + v[c4][1]) + (v[c4][2] + v[c4][3]);
        const float mean = wave_sum(s) * (1.f / DM); float s2 = 0.f;
#pragma unroll
        for (int c4 = 0; c4 < 4; ++c4) { v[c4] = v[c4] - mean; s2 += (v[c4][0] * v[c4][0] + v[c4][1] * v[c4][1]) + (v[c4][2] * v[c4][2] + v[c4][3] * v[c4][3]); }
        const float rstd = 1.f / sqrtf(wave_sum(s2) * (1.f / DM) + LN_EPS);
#pragma unroll
        for (int c4 = 0; c4 < 4; ++c4) { const int ci = 512 * (c4 >> 1) + 8 * lane + 4 * (c4 & 1); *(f32x4*)(o + (size_t)q * ld + ci) = v[c4] * rstd * gg[c4] + bb[c4]; }
    }
}

#define XB_TMO      128
#define XB_XCNT(j)  (256  + 64 * (j))
#define XB_XSUB(j)  (1280 + 64 * (j))
#define XB_XGEN(j)  (2304 + 64 * (j))
#define XB_TOP      3328
#define XB_TOPGEN   3392
#define XCD_BAR_WORDS 3456
#define XB_SPIN_CAP (1u << 20)
__device__ __forceinline__ unsigned xb_ld(unsigned* p)              { return __hip_atomic_load(p, __ATOMIC_RELAXED, __HIP_MEMORY_SCOPE_AGENT); }
__device__ __forceinline__ unsigned xb_add(unsigned* p, unsigned v) { return __hip_atomic_fetch_add(p, v, __ATOMIC_RELAXED, __HIP_MEMORY_SCOPE_AGENT); }
__device__ __forceinline__ unsigned xb_xcc_id() { return (unsigned)__builtin_amdgcn_s_getreg((3 << 11) | 20) & 0xFu; }
#define XB_SPIN(cond, bar) do { unsigned _sp = 0; while (cond) { __builtin_amdgcn_s_sleep(1); \
    if ((++_sp & 255u) == 0u) { if (xb_ld(&(bar)[XB_TMO])) break; if (_sp > XB_SPIN_CAP) { atomicAdd(&(bar)[XB_TMO], 1u); break; } } } } while (0)
struct XcdBarrier { unsigned* bar; unsigned x; volatile LAS unsigned* st; };
__device__ __forceinline__ XcdBarrier xcd_barrier_post(unsigned* bar, volatile LAS unsigned* st) {
    XcdBarrier b; b.bar = bar; b.x = xb_xcc_id(); b.st = st;
    if (threadIdx.x == 0) (void)xb_add(&bar[XB_XCNT(b.x)], 1u);
    return b;
}
__device__ __forceinline__ void xcd_barrier_complete(unsigned* bar, unsigned x, unsigned& nloc, unsigned& nx) {
    const unsigned G = gridDim.x * gridDim.y * gridDim.z;
    unsigned sum, cnt, mine, sp = 0u;
    for (;;) {
        sum = 0u; cnt = 0u; mine = 0u;
#pragma unroll
        for (unsigned j = 0; j < 16; ++j) { const unsigned c = xb_ld(&bar[XB_XCNT(j)]); sum += c; cnt += (c > 0u) ? 1u : 0u; mine = (j == x) ? c : mine; }
        if (sum == G) break;
        __builtin_amdgcn_s_sleep(1);
        if ((++sp & 255u) == 0u) { if (xb_ld(&bar[XB_TMO])) break; if (sp > XB_SPIN_CAP) { atomicAdd(&bar[XB_TMO], 1u); break; } }
    }
    nloc = mine > 0u ? mine : 1u; nx = cnt > 0u ? cnt : 1u;
}
__device__ __forceinline__ void xcd_barrier(const XcdBarrier& b) {
    asm volatile("s_waitcnt vmcnt(0)" ::: "memory");
    __syncthreads();
    if (threadIdx.x == 0) {
        unsigned* bar = b.bar;
        __builtin_amdgcn_s_waitcnt(0);
        unsigned nloc = b.st[0], nx = b.st[1];
        if (nloc == 0u) { xcd_barrier_complete(bar, b.x, nloc, nx); b.st[0] = nloc; b.st[1] = nx; }
        const unsigned old = xb_add(&bar[XB_XSUB(b.x)], 1u);
        const unsigned gen = old / nloc;
        if (old + 1u == (gen + 1u) * nloc) {
            __builtin_amdgcn_fence(__ATOMIC_RELEASE, "agent");
            asm volatile("s_waitcnt vmcnt(0)" ::: "memory");
            const unsigned og = xb_add(&bar[XB_TOP], 1u);
            const unsigned tg = og / nx;
            if (og + 1u == (tg + 1u) * nx) xb_add(&bar[XB_TOPGEN], 1u);
            else XB_SPIN(xb_ld(&bar[XB_TOPGEN]) == tg, bar);
            __builtin_amdgcn_fence(__ATOMIC_ACQUIRE, "agent");
            xb_add(&bar[XB_XGEN(b.x)], 1u);
            asm volatile("s_waitcnt vmcnt(0)" ::: "memory");
        } else {
            XB_SPIN(xb_ld(&bar[XB_XGEN(b.x)]) == gen, bar);
            __builtin_amdgcn_fence(__ATOMIC_ACQUIRE, "agent");
            asm volatile("s_waitcnt vmcnt(0)" ::: "memory");
        }
    }
    __syncthreads();
}

#ifndef PROBE_PHASE
#define PROBE_PHASE -1
#endif
constexpr int LDS_BYTES = 159744;
constexpr int LDS_MISC = 159744 - 256;
struct Args { const float* in[18]; float* out; unsigned char* ws; int ph_lo, ph_hi; };
enum { I_X = 0, I_MEM, I_WIN, I_WPOOL, I_PSCALE, I_WOUT, I_LN1G, I_LN1B, I_WXQ, I_WXKV, I_WXO, I_LN2G, I_LN2B, I_WGATE, I_WUP, I_WDOWN, I_LN3G, I_LN3B };
constexpr int N_PHASES = 13;

struct Ctx {
    const float* const* in; LAS unsigned char* lds; unsigned char* ws; float* H;
    int tid, lane, wave, G, bx, vcu, gw, NGW;
};
#define WSP(T, off) ((T*)(c.ws + (off)))

template <int PH> __device__ __forceinline__ void run_phase(const Ctx& c) {
    const int lane = c.lane, wave = c.wave, G = c.G, bx = c.bx, vcu = c.vcu, gw = c.gw, NGW = c.NGW, tid = c.tid;
    LAS unsigned char* lds = c.lds;
    float* KM = WSP(float, WS_KM);
    bf16_t* Win_t = WSP(bf16_t, WS_WIN); bf16_t* Wout_t = WSP(bf16_t, WS_WOUT); bf16_t* Wxq_t = WSP(bf16_t, WS_WXQ); bf16_t* Wxkv_t = WSP(bf16_t, WS_WXKV);
    bf16_t* Wxo_t = WSP(bf16_t, WS_WXO); bf16_t* Wgu_t = WSP(bf16_t, WS_WGU); bf16_t* Wdn_t = WSP(bf16_t, WS_WDN); bf16_t* Wpool_t = WSP(bf16_t, WS_WPOOL);
    bf16_t* MEMB = WSP(bf16_t, WS_MEMB); bf16_t* MEMKV = WSP(bf16_t, WS_MEMKV);
    bf16_t* XB = WSP(bf16_t, WS_XB); bf16_t* Z = WSP(bf16_t, WS_Z); bf16_t* MIX = WSP(bf16_t, WS_MIX); bf16_t* HF = WSP(bf16_t, WS_HF);
    bf16_t* XQ = MIX; bf16_t* XO = Z;
    float* H = c.H; float* PST1 = WSP(float, WS_PST1); float* PST2 = WSP(float, WS_PST2);
    if constexpr (PH == 0) {
        if (bx < 208) {
            const float* W; int N, n0, mode; const float* gg; const float* bb; float* cd; int cdn;
            if (bx < 32) { W = c.in[I_WXQ]; N = DM; n0 = 32 * bx; mode = 0; gg = c.in[I_LN1G]; bb = c.in[I_LN1B]; cd = WSP(float, WS_CDX); cdn = DM; }
            else if (bx < 120) { W = c.in[I_WGATE]; N = DFF; n0 = 32 * (bx - 32); mode = 1; gg = c.in[I_LN2G]; bb = c.in[I_LN2B]; cd = WSP(float, WS_CDG); cdn = 2 * DFF; }
            else { W = c.in[I_WUP]; N = DFF; n0 = 32 * (bx - 120); mode = 2; gg = c.in[I_LN2G]; bb = c.in[I_LN2B]; cd = WSP(float, WS_CDG); cdn = 2 * DFF; }
            const int col = n0 + (lane & 31), kbeg = wave * 128 + (lane >> 5) * 64;
            float cs = 0.f, ds = 0.f;
#pragma unroll 8
            for (int k = kbeg; k < kbeg + 64; ++k) { const float wv = W[(size_t)k * N + col]; cs += gg[k] * wv; ds += bb[k] * wv; }
            cs += __shfl_xor(cs, 32); ds += __shfl_xor(ds, 32);
            LAS float* red = (LAS float*)(lds + 131072);
            if (lane < 32) { red[(wave * 32 + lane) * 2] = cs; red[(wave * 32 + lane) * 2 + 1] = ds; }
            __syncthreads();
            if (tid < 32) { float ct = 0.f, dt = 0.f;
#pragma unroll
                for (int w8 = 0; w8 < 8; ++w8) { ct += red[(w8 * 32 + tid) * 2]; dt += red[(w8 * 32 + tid) * 2 + 1]; }
                const int oi = (mode == 0) ? col : (32 * (col >> 4) + (col & 15) + (mode == 2 ? 16 : 0));
                cd[oi] = ct; cd[cdn + oi] = dt; }
        }
        LAS float* scr = (LAS float*)(lds + wave * 16384);
        constexpr int I_IN = (DM / 64) * (INW / 32), I_SQ = (DM / 64) * (DM / 32), I_KV = (DM / 64) * (2048 / 32), I_GU = (DM / 64) * (DFF / 32), I_DN = (DFF / 64) * (DM / 32), I_PL = 2 * 4;
        constexpr int NITEMS = I_IN + 3 * I_SQ + I_KV + 2 * I_GU + I_DN + 4 * I_PL;
        for (int it = gw; it < NITEMS; it += NGW) {
            int r = it;
            if (r < I_IN) { p0_transpose_item(c.in[I_WIN], DM, INW, Win_t, 0, scr, r, lane); continue; } r -= I_IN;
            if (r < I_SQ) { if (r >= 8 * (DM / 32)) p0_transpose_item(c.in[I_WOUT], DM, DM, Wout_t, 0, scr, r, lane); continue; } r -= I_SQ;
            if (r < I_SQ) { continue; } r -= I_SQ;
            if (r < I_SQ) { p0_transpose_item(c.in[I_WXO], DM, DM, Wxo_t, 0, scr, r, lane); continue; } r -= I_SQ;
            if (r < I_KV) { p0_transpose_item(c.in[I_WXKV], DM, 2048, Wxkv_t, 0, scr, r, lane); continue; } r -= I_KV;
            if (r < I_GU) { p0_transpose_item(c.in[I_WGATE], DM, DFF, Wgu_t, 1, scr, r, lane, c.in[I_LN2G]); continue; } r -= I_GU;
            if (r < I_GU) { p0_transpose_item(c.in[I_WUP], DM, DFF, Wgu_t, 2, scr, r, lane, c.in[I_LN2G]); continue; } r -= I_GU;
            if (r < I_DN) { p0_transpose_item(c.in[I_WDOWN], DFF, DM, Wdn_t, 0, scr, r, lane); continue; } r -= I_DN;
            { const int gidx = r / I_PL; p0_transpose_item(c.in[I_WPOOL] + gidx * 16384, 128, 128, Wpool_t + gidx * 16384, 0, scr, r % I_PL, lane); }
        }
        const size_t gtid = (size_t)vcu * 512 + tid, nthr = (size_t)G * 512;
        for (size_t idx = gtid; idx < (size_t)512 * DM; idx += nthr) {
            const int n = (int)(idx & (DM - 1)), k = (int)(idx >> 10), gidx = k >> 7;
            const float* wp = c.in[I_WPOOL] + (size_t)k * 128;
            const float* ps = c.in[I_PSCALE] + gidx * 128;
            const float* wo = c.in[I_WOUT] + (size_t)(gidx * 128) * DM + n;
            float a = 0.f;
#pragma unroll 8
            for (int d = 0; d < 128; ++d) a += wp[d] * ps[d] * wo[(size_t)d * DM];
            const unsigned pk = cvt_pk_bf16(a, 0.f);
            Wout_t[(size_t)n * DM + k] = (bf16_t)(pk & 0xffffu);
        }
        for (size_t i8 = gtid; i8 < (size_t)DM * DM / 8; i8 += nthr) {
            const float gsc = c.in[I_LN1G][(i8 * 8) >> 10]; const f32x4 a = *(const f32x4*)(c.in[I_WXQ] + i8 * 8) * gsc, b4 = *(const f32x4*)(c.in[I_WXQ] + i8 * 8 + 4) * gsc;
            u32x4 o; o.x = cvt_pk_bf16(a[0], a[1]); o.y = cvt_pk_bf16(a[2], a[3]); o.z = cvt_pk_bf16(b4[0], b4[1]); o.w = cvt_pk_bf16(b4[2], b4[3]); *(u32x4*)(Wxq_t + i8 * 8) = o; }
        for (size_t i4 = gtid; i4 < (size_t)BATCH * 8 * NBLK * 64 / 4; i4 += nthr) *((f32x4*)KM + i4) = (f32x4){0.f, 0.f, 0.f, 0.f};
        cvt_rows_bf16(c.in[I_X], XB, (size_t)TOK * DM / 8, gtid, nthr);
        cvt_rows_bf16(c.in[I_MEM], MEMB, (size_t)MEMROWS * DM / 8, gtid, nthr);
    }
    if constexpr (PH == 1) {
        { pg8::Gemm g{XB, Win_t, TOK, INW, DM}; pg8::StaticOrder S; S.init(TOK, INW, G, bx); pg8::EpiBf16 E{Z, INW, KM}; pg8::gemm_phase(lds, g, S, E); }
        { pg8::Gemm g{MEMB, Wxkv_t, MEMROWS, 2048, DM}; pg8::StaticOrder S; S.init(MEMROWS, 2048, G, bx); pg8::EpiBf16 E{MEMKV, 2048}; pg8::gemm_phase(lds, g, S, E); }
    }
    if constexpr (PH == 2) {
        for (int run = gw; run < TOK / 32; run += NGW) {
            const int wdw = 2 << (lane >> 4);
            const size_t t0 = (size_t)run * 32; const int tpos0 = (int)(t0 & (SEQ - 1));
            const bf16_t* up = Z + t0 * INW + lane * 8;
            bf16_t* op = MIX + t0 * DM + lane * 8;
            float sacc[8] = {0.f, 0.f, 0.f, 0.f, 0.f, 0.f, 0.f, 0.f};
#pragma unroll 1
            for (int ib = 1; ib <= 16; ib += 8) { bf16x8 ui[8]; bool ok[8];
#pragma unroll
                for (int q = 0; q < 8; ++q) { const int i = ib + q; ok[q] = (i <= wdw && tpos0 - i >= 0); ui[q] = *(const bf16x8*)(up - (size_t)(ok[q] ? i : 0) * INW); }
#pragma unroll
                for (int q = 0; q < 8; ++q) if (ok[q]) {
#pragma unroll
                    for (int e8 = 0; e8 < 8; ++e8) sacc[e8] += bf2f((unsigned short)ui[q][e8]); } }
#pragma unroll 1
            for (int tb = 0; tb < 32; tb += 8) {
                bf16x8 un[8], uo[8];
#pragma unroll
                for (int i = 0; i < 8; ++i) { un[i] = *(const bf16x8*)(up + (size_t)(tb + i) * INW);
                    const int told = tpos0 + tb + i - wdw; uo[i] = *(const bf16x8*)(up + (size_t)(tb + i - (told >= 0 ? wdw : 0)) * INW); }
#pragma unroll
                for (int i = 0; i < 8; ++i) { const int tpos = tpos0 + tb + i; const bool sub = tpos - wdw >= 0;
                    const float rc = 1.0f / (float)((tpos + 1 < wdw) ? tpos + 1 : wdw); float p[8];
#pragma unroll
                    for (int e8 = 0; e8 < 8; ++e8) { const float uv = bf2f((unsigned short)un[i][e8]); sacc[e8] += uv; if (sub) sacc[e8] -= bf2f((unsigned short)uo[i][e8]); p[e8] = sacc[e8] * rc - uv; }
                    u32x4 pw; pw.x = cvt_pk_bf16(p[0], p[1]); pw.y = cvt_pk_bf16(p[2], p[3]); pw.z = cvt_pk_bf16(p[4], p[5]); pw.w = cvt_pk_bf16(p[6], p[7]);
                    *(u32x4*)(op + (size_t)(tb + i) * DM) = pw; }
            }
        }
    }
    if constexpr (PH == 2) {
        bf16_t* BtM = WSP(bf16_t, WS_BTM); bf16_t* BtN = WSP(bf16_t, WS_BTN); float* CB = WSP(float, WS_CDB); float* DB = CB + 16 * 1024;
        { pg8::Gemm g{MEMKV, Wxq_t, 64 * 256, 1024, 256, 2048, 1024, 2}; pg8::StaticOrder S; S.init(64 * 256, 1024, G, bx); pg8::EpiPrep E{BtM, 0.0625f, 0}; pg8::gemm_phase(lds, g, S, E); }
        { pg8::Gemm g{Wxo_t, MEMKV + 1024, 64 * 256, 1024, 256, 1024, 2048, 3}; pg8::StaticOrder S; S.init(64 * 256, 1024, G, bx); pg8::EpiPrep E{BtN, 1.0f, 1}; pg8::gemm_phase(lds, g, S, E); }
        const float* cx = WSP(float, WS_CDX); const float* dx = cx + DM;
        for (int o8 = vcu * 512 + tid; o8 < 16 * 1024 * 8; o8 += G * 512) {
            const int o = o8 >> 3, part = o8 & 7;
            const int bt = o >> 10, hm = o & 1023, hh = hm >> 8, mm = hm & 255;
            const bf16_t* kr = MEMKV + (size_t)(bt * 256 + mm) * 2048 + hh * 256; float ca = 0.f, da = 0.f;
#pragma unroll
            for (int it = 0; it < 4; ++it) { const int d8 = part + 8 * it; const bf16x8 kv = *(const bf16x8*)(kr + d8 * 8);
                const f32x4 c0 = *(const f32x4*)(cx + hh * 256 + d8 * 8), c1 = *(const f32x4*)(cx + hh * 256 + d8 * 8 + 4), d0 = *(const f32x4*)(dx + hh * 256 + d8 * 8), d1 = *(const f32x4*)(dx + hh * 256 + d8 * 8 + 4);
#pragma unroll
                for (int e8 = 0; e8 < 8; ++e8) { const float kf = bf2f((unsigned short)kv[e8]); ca += (e8 < 4 ? c0[e8 & 3] : c1[e8 & 3]) * kf; da += (e8 < 4 ? d0[e8 & 3] : d1[e8 & 3]) * kf; } }
            ca += __shfl_xor(ca, 1); ca += __shfl_xor(ca, 2); ca += __shfl_xor(ca, 4); da += __shfl_xor(da, 1); da += __shfl_xor(da, 2); da += __shfl_xor(da, 4);
            if (part == 0) { CB[o] = ca * 0.0625f; DB[o] = da * 0.0625f; }
        }
    }
    if constexpr (PH == 3) {
        for (int it = 0; it * G < BATCH * 8 * NBLK; ++it) {
            const int u = it * G + vcu; if (u >= BATCH * 8 * NBLK) break;
            int bh = u >> 4, blk = u & 15;
            if (G == 256) { bh = it * 16 + (vcu >> 4); blk = ((vcu & 15) + 2 * it) & 15; }
            moba_unit(bh >> 3, bh & 7, blk, Z, KM, MIX, lds);
        }
    }
    if constexpr (PH == 4) { pg8::Gemm g{MIX, Wout_t, TOK, DM, DM}; pg8::StaticOrder S; S.init(TOK, DM, G, bx); pg8::EpiResStat<false, true> E{XB, XB, DM, ALPHA, nullptr, nullptr, nullptr, PST1}; pg8::gemm_phase(lds, g, S, E); }
    if constexpr (PH == 5) { }
    if constexpr (PH == 6) { pg8::Gemm g{XB, WSP(bf16_t, WS_BTM), TOK, DM, DM, 0, 0, 1, (size_t)DM * DM * 2}; pg8::StaticOrder S; S.init(TOK, DM, G, bx); pg8::EpiSoftmaxP E{XQ, PST1, WSP(float, WS_CDB), WSP(float, WS_CDB) + 16 * 1024, (LAS float*)(lds + 131072)}; pg8::gemm_phase(lds, g, S, E); }
    if constexpr (PH == 7) { for (int u = vcu; u < (TOK / 128) * 4; u += G) xattn_unit(u >> 2, u & 3, XQ, MEMKV, XO, lds); }
    if constexpr (PH == 8) { pg8::Gemm g{XQ, WSP(bf16_t, WS_BTN), TOK, DM, DM, 0, 0, 1, (size_t)DM * DM * 2}; pg8::StaticOrder S; S.init(TOK, DM, G, bx); pg8::EpiResStat<true, true> E{XB, XB, DM, ALPHA, PST1, c.in[I_LN1G], c.in[I_LN1B], PST2}; pg8::gemm_phase(lds, g, S, E); }
    if constexpr (PH == 9) { }
    if constexpr (PH == 10) { pg8::Gemm g{XB, Wgu_t, TOK, 2 * DFF, DM}; pg8::StaticOrder S; S.init(TOK, 2 * DFF, G, bx); pg8::EpiLnSwiGLU E{HF, DFF, PST2, WSP(float, WS_CDG), WSP(float, WS_CDG) + 2 * DFF}; pg8::gemm_phase(lds, g, S, E); }
    if constexpr (PH == 11) { pg8::Gemm g{HF, Wdn_t, TOK, DM, DFF}; pg8::StaticOrder S; S.init(TOK, DM, G, bx); pg8::EpiResStat<true, false> E{XB, XB, DM, ALPHA, PST2, c.in[I_LN2G], c.in[I_LN2B], nullptr}; pg8::gemm_phase(lds, g, S, E); }
    if constexpr (PH == 12) { for (int r = gw * 4; r < TOK; r += NGW * 4) ln_rows4_bf16in(XB + (size_t)r * DM, c.in[I_LN3G], c.in[I_LN3B], H + (size_t)r * DM, DM, lane); }
}

__global__ void __launch_bounds__(512, 2) fwd_kernel(Args args) {
    extern __shared__ __attribute__((aligned(16))) unsigned char lds_raw[];
    Ctx c;
    c.in = args.in; c.lds = (LAS unsigned char*)lds_raw; c.ws = args.ws; c.H = args.out;
    c.tid = threadIdx.x; c.lane = c.tid & 63; c.wave = __builtin_amdgcn_readfirstlane(c.tid >> 6);
    c.G = gridDim.x; c.bx = blockIdx.x;
    c.vcu = (c.G % 8 == 0) ? (c.bx % 8) * (c.G / 8) + c.bx / 8 : c.bx;
    c.gw = c.vcu * 8 + c.wave; c.NGW = c.G * 8;
    const int lo = args.ph_lo, hi = args.ph_hi;
    volatile LAS unsigned* MISC = (volatile LAS unsigned*)(c.lds + LDS_MISC);
    if (c.tid < 2) MISC[c.tid] = 0u;
    __syncthreads();
    XcdBarrier bar; bar.bar = (unsigned*)(args.ws + WS_CTL); bar.x = 0; bar.st = MISC;
    if (hi - lo > 1) bar = xcd_barrier_post((unsigned*)(args.ws + WS_CTL), MISC);
    if (hi < 0) cg::this_grid().sync();
#define IN(k) (lo <= (k) && (k) < hi)
#define PHASE(k) do { if (IN(k)) { run_phase<k>(c); if (PROBE_PHASE == (k)) { xcd_barrier(bar); run_phase<k>(c); } } \
        if (IN(k) && IN((k) + 1)) { xcd_barrier(bar); } } while (0)
    PHASE(0); PHASE(1);
    if (IN(2)) run_phase<2>(c);
    PHASE(3); PHASE(4); PHASE(6); PHASE(8); PHASE(10); PHASE(11); PHASE(12);
#undef IN
#undef PHASE
}

extern "C" void kernel_launch(void* const* d_in, const int* in_sizes, int n_in, void* d_out, int out_size, void* d_ws, size_t ws_size, hipStream_t stream) {
    static int grid = 0;
    if (grid == 0) {
        if (n_in != 18 || out_size != TOK * DM || ws_size < WS_END) { fprintf(stderr, "kernel_launch: unexpected shapes (n_in %d, out %d, ws %zu)\n", n_in, out_size, ws_size); grid = -1; return; }
        int dev = 0, cus = 0, per_cu = 0;
        (void)hipGetDevice(&dev); (void)hipDeviceGetAttribute(&cus, hipDeviceAttributeMultiprocessorCount, dev);
        if (hipFuncSetAttribute((const void*)fwd_kernel, hipFuncAttributeMaxDynamicSharedMemorySize, LDS_BYTES) != hipSuccess) { fprintf(stderr, "kernel_launch: hipFuncSetAttribute failed\n"); grid = -1; return; }
        if (hipOccupancyMaxActiveBlocksPerMultiprocessor(&per_cu, (const void*)fwd_kernel, 512, LDS_BYTES) != hipSuccess || per_cu < 1) { fprintf(stderr, "kernel_launch: occupancy query says %d\n", per_cu); per_cu = 1; }
        (void)hipGetLastError();
        grid = cus * 1;
        if (grid <= 0) grid = 256;
    }
    if (grid < 0) return;
    Args a{};
    for (int i = 0; i < 18; ++i) a.in[i] = (const float*)d_in[i];
    a.out = (float*)d_out; a.ws = (unsigned char*)d_ws;
#if N_LAUNCH_MODE == 1
    for (int p = 0; p < N_PHASES; ++p) { a.ph_lo = p; a.ph_hi = p + 1; hipLaunchKernelGGL(fwd_kernel, dim3(grid), dim3(512), LDS_BYTES, stream, a); }
#else
    a.ph_lo = 0; a.ph_hi = N_PHASES;
    (void)hipMemsetAsync((unsigned char*)d_ws + WS_CTL, 0, CTL_BYTES, stream);
    void* kargs[] = {&a};
    hipError_t e = hipLaunchCooperativeKernel((const void*)fwd_kernel, dim3(grid), dim3(512), kargs, LDS_BYTES, stream);
    if (e != hipSuccess) fprintf(stderr, "kernel_launch: cooperative launch failed: %s (grid %d)\n", hipGetErrorString(e), grid);
#endif
}
```

```cpp
#include <hip/hip_runtime.h>
#include <hip/hip_cooperative_groups.h>
#include <cstdio>
#include <cstdint>
namespace cg = cooperative_groups;

#ifndef N_LAUNCH_MODE
#define N_LAUNCH_MODE 0
#endif

#define LAS __attribute__((address_space(3)))
typedef unsigned short bf16_t;
typedef short bf16x8 __attribute__((ext_vector_type(8)));
typedef short s16x4 __attribute__((ext_vector_type(4)));
typedef float f32x4 __attribute__((ext_vector_type(4)));
typedef float f32x2 __attribute__((ext_vector_type(2)));
typedef unsigned u32x4 __attribute__((ext_vector_type(4)));
typedef unsigned u32x2 __attribute__((ext_vector_type(2)));

constexpr int BATCH = 16, SEQ = 4096, DM = 1024, TOK = BATCH * SEQ;
constexpr int MEMLEN = 256, MEMROWS = BATCH * MEMLEN;
constexpr int INW = 2048, DFF = 2816, NBLK = SEQ / 256;
constexpr float ALPHA = 1.189207115002721f;
constexpr float LN_EPS = 1e-5f;
constexpr float LOG2E = 1.4426950408889634f;

constexpr size_t MiB = 1u << 20;
constexpr size_t WS_KM = 0;
constexpr size_t WS_CTL = 1 * MiB, CTL_BYTES = 16384;
constexpr size_t WS_WIN = 2 * MiB, WS_WOUT = 6 * MiB, WS_WXQ = 8 * MiB, WS_WXKV = 10 * MiB, WS_WXO = 14 * MiB, WS_WGU = 16 * MiB, WS_WDN = 27 * MiB, WS_WPOOL = 33 * MiB;
constexpr size_t WS_MEMB = 34 * MiB, WS_MEMKV = 42 * MiB;
constexpr size_t WS_XB = 64 * MiB;
constexpr size_t WS_Z = 192 * MiB;
constexpr size_t WS_MIX = 448 * MiB;
constexpr size_t WS_HF = 192 * MiB;
constexpr size_t WS_PST1 = 576 * MiB, WS_PST2 = 584 * MiB;
constexpr size_t WS_CDX = 60 * MiB, WS_CDG = 60 * MiB + 65536;
constexpr size_t WS_CDB = 60 * MiB + 131072;
constexpr size_t WS_BTM = 592 * MiB, WS_BTN = 624 * MiB;
constexpr size_t WS_END = 656 * MiB;

typedef __bf16 bf16x2_t __attribute__((ext_vector_type(2)));
__device__ __forceinline__ unsigned cvt_pk_bf16(float lo, float hi) { f32x2 v = {lo, hi}; bf16x2_t b = __builtin_convertvector(v, bf16x2_t); return __builtin_bit_cast(unsigned, b); }
__device__ __forceinline__ float xmax16(float v) { auto r = __builtin_amdgcn_permlane16_swap(__float_as_uint(v), __float_as_uint(v), false, false); return fmaxf(__uint_as_float(r[0]), __uint_as_float(r[1])); }
__device__ __forceinline__ float xmax32(float v) { auto r = __builtin_amdgcn_permlane32_swap(__float_as_uint(v), __float_as_uint(v), false, false); return fmaxf(__uint_as_float(r[0]), __uint_as_float(r[1])); }
__device__ __forceinline__ float xsum16(float v) { auto r = __builtin_amdgcn_permlane16_swap(__float_as_uint(v), __float_as_uint(v), false, false); return __uint_as_float(r[0]) + __uint_as_float(r[1]); }
__device__ __forceinline__ float xsum32(float v) { auto r = __builtin_amdgcn_permlane32_swap(__float_as_uint(v), __float_as_uint(v), false, false); return __uint_as_float(r[0]) + __uint_as_float(r[1]); }
__device__ __forceinline__ float bf2f(unsigned short b) { return __uint_as_float(((unsigned)b) << 16); }
__device__ __forceinline__ float wave_sum(float v) {
#pragma unroll
    for (int o = 1; o < 64; o <<= 1) v += __shfl_xor(v, o);
    return v;
}

namespace pg8 {
constexpr int BM = 256, BK = 64, HALF = 128, HTB = HALF * BK * 2, STAGE_BYTES = 8 * HTB, NXCD = 8, WGM = 4;
__host__ __device__ __forceinline__ int lds_byte(int r, int c) { const int st = (r >> 4) * 2 + (c >> 5), rr = r & 15, cc = c & 31, ob = rr * 64 + cc * 2; return st * 1024 + (ob ^ (((ob >> 9) & 1) << 5)); }
__host__ __device__ __forceinline__ void stage_rc(int b, int& R, int& C) { const int st = b / 1024, sb = b % 1024, swz = sb ^ (((sb >> 9) & 1) << 5); R = (st >> 1) * 16 + swz / 64; C = (st & 1) * 32 + (swz % 64) / 2; }
__host__ __device__ __forceinline__ int perm32(int rho) { const int n = rho >> 4, i = rho & 15; return 8 * (i >> 2) + 4 * n + (i & 3); }

struct Unit { int pm, pn; };
struct Gemm { const bf16_t* A; const bf16_t* Bt; int M, N, K; int lda = 0, ldb = 0, mode = 0; size_t s1 = 0; };
__device__ __forceinline__ void unit_ptrs(const Gemm& g, const Unit& u, const char*& cA, const char*& cB) {
    const int lda = g.lda ? g.lda : g.K, ldb = g.ldb ? g.ldb : g.K;
    if (g.mode <= 1) { cA = (const char*)g.A + (size_t)u.pm * BM * lda * 2; cB = (const char*)g.Bt + (size_t)u.pn * BM * ldb * 2 + (g.mode == 1 ? (size_t)(u.pm >> 4) * g.s1 : 0); }
    else if (g.mode == 2) { cA = (const char*)g.A + (size_t)(u.pm >> 2) * 256 * lda * 2 + (size_t)(u.pm & 3) * 512; cB = (const char*)g.Bt + (size_t)u.pn * BM * ldb * 2 + (size_t)(u.pm & 3) * 512; }
    else { cA = (const char*)g.A + (size_t)u.pn * BM * lda * 2 + (size_t)(u.pm & 3) * 512; cB = (const char*)g.Bt + (size_t)(u.pm >> 2) * 256 * ldb * 2 + (size_t)(u.pm & 3) * 512; }
}

struct StaticOrder {
    int nM, nN, nwg, G, c;
    __device__ void init(int M, int N, int G_, int c_) { nM = M / BM; nN = N / BM; nwg = nM * nN; G = G_; c = c_; }
    __device__ bool next(int i, Unit& u) const {
        const long L = (long)i * G + c; if (L >= nwg) return false;
        int wgid = (int)L; { const int q = nwg / NXCD, r = nwg % NXCD, xcd = wgid % NXCD, off = wgid / NXCD; wgid = (xcd < r ? xcd * (q + 1) : r * (q + 1) + (xcd - r) * q) + off; }
        const int nig = WGM * nN, gid = wgid / nig, fm = gid * WGM, gsz = (nM - fm) < WGM ? (nM - fm) : WGM;
        u.pm = fm + ((wgid % nig) % gsz); u.pn = (wgid % nig) / gsz; return true;
    }
};

struct EpiBf16 {
    static constexpr bool PERM = true;
    bf16_t* O; int ldc; float* km = nullptr;
    __device__ __forceinline__ void operator()(const f32x4 (&acc)[2][2][4][2], const Unit& u, int wr, int wc, int fr, int fq) const {
        const int row0 = u.pm * BM + wr * 64 + fr; const int col0 = u.pn * BM + wc * 32 + 8 * fq;
#pragma unroll
        for (int ai = 0; ai < 2; ++ai)
#pragma unroll
            for (int m = 0; m < 4; ++m) { bf16_t* rowp = O + (size_t)(row0 + ai * HALF + m * 16) * ldc + col0;
#pragma unroll
                for (int bj = 0; bj < 2; ++bj) { const f32x4 v0 = acc[ai][bj][m][0], v1 = acc[ai][bj][m][1];
                    u32x4 w; w.x = cvt_pk_bf16(v0[0], v0[1]); w.y = cvt_pk_bf16(v0[2], v0[3]); w.z = cvt_pk_bf16(v1[0], v1[1]); w.w = cvt_pk_bf16(v1[2], v1[3]);
                    *(u32x4*)(rowp + bj * HALF) = w; } }
        if (km && (u.pn == 4 || u.pn == 5)) {
#pragma unroll
            for (int bj = 0; bj < 2; ++bj)
#pragma unroll
                for (int n = 0; n < 2; ++n) { f32x4 cs = (f32x4){0.f, 0.f, 0.f, 0.f};
#pragma unroll
                    for (int ai = 0; ai < 2; ++ai)
#pragma unroll
                        for (int m = 0; m < 4; ++m) cs = cs + acc[ai][bj][m][n];
#pragma unroll
                    for (int j = 0; j < 4; ++j) { float v = cs[j]; v += __shfl_xor(v, 1); v += __shfl_xor(v, 2); v += __shfl_xor(v, 4); v += __shfl_xor(v, 8);
                        if (fr == 0) { const int kc = (u.pn - 4) * 256 + bj * HALF + wc * 32 + 8 * fq + 4 * n + j;
                            __hip_atomic_fetch_add(km + (size_t)(((u.pm >> 4) * 8 + (kc >> 6)) * 16 + (u.pm & 15)) * 64 + (kc & 63), v * (1.0f / 256.0f), __ATOMIC_RELAXED, __HIP_MEMORY_SCOPE_AGENT); } } }
        }
    }
};
__device__ __forceinline__ void row_stats(const float* pst, int row, int fq, float& mu, float& rstd) {
    const f32x4 a = *(const f32x4*)(pst + (size_t)row * 32 + 8 * fq), b = *(const f32x4*)(pst + (size_t)row * 32 + 8 * fq + 4);
    float s1 = (a[0] + a[2]) + (b[0] + b[2]), s2 = (a[1] + a[3]) + (b[1] + b[3]);
    s1 = xsum32(xsum16(s1)); s2 = xsum32(xsum16(s2));
    mu = s1 * (1.0f / 1024.0f); const float var = s2 * (1.0f / 1024.0f) - mu * mu; rstd = 1.0f / sqrtf(var + LN_EPS);
}
template <bool HAS_LN, bool HAS_OUT> struct EpiResStat {
    static constexpr bool PERM = true;
    const bf16_t* R; bf16_t* YB; int ldc; float alpha; const float* st_in; const float* g; const float* b; float* st_out;
    __device__ __forceinline__ void operator()(const f32x4 (&acc)[2][2][4][2], const Unit& u, int wr, int wc, int fr, int fq) const {
        const int row0 = u.pm * BM + wr * 64 + fr; const int col0 = u.pn * BM + wc * 32 + 8 * fq;
        f32x4 gv[2][2], bv[2][2];
        if (HAS_LN) {
#pragma unroll
            for (int bj = 0; bj < 2; ++bj)
#pragma unroll
                for (int n = 0; n < 2; ++n) { gv[bj][n] = *(const f32x4*)(g + col0 + bj * HALF + 4 * n); bv[bj][n] = *(const f32x4*)(b + col0 + bj * HALF + 4 * n); }
        }
#pragma unroll
        for (int ai = 0; ai < 2; ++ai)
#pragma unroll
            for (int m = 0; m < 4; ++m) { const int row = row0 + ai * HALF + m * 16; const size_t off = (size_t)row * ldc + col0;
                float mu = 0.f, rs = 1.f; if (HAS_LN) row_stats(st_in, row, fq, mu, rs);
                float s1 = 0.f, s2 = 0.f;
#pragma unroll
                for (int bj = 0; bj < 2; ++bj) { const u32x4 rr = *(const u32x4*)(R + off + bj * HALF);
                    f32x4 v0 = (f32x4){__uint_as_float(rr.x << 16), __uint_as_float(rr.x & 0xffff0000u), __uint_as_float(rr.y << 16), __uint_as_float(rr.y & 0xffff0000u)};
                    f32x4 v1 = (f32x4){__uint_as_float(rr.z << 16), __uint_as_float(rr.z & 0xffff0000u), __uint_as_float(rr.w << 16), __uint_as_float(rr.w & 0xffff0000u)};
                    if (HAS_LN) { v0 = (v0 - mu) * rs * gv[bj][0] + bv[bj][0]; v1 = (v1 - mu) * rs * gv[bj][1] + bv[bj][1]; }
                    const f32x4 y0 = v0 * alpha + acc[ai][bj][m][0], y1 = v1 * alpha + acc[ai][bj][m][1];
                    u32x4 w; w.x = cvt_pk_bf16(y0[0], y0[1]); w.y = cvt_pk_bf16(y0[2], y0[3]); w.z = cvt_pk_bf16(y1[0], y1[1]); w.w = cvt_pk_bf16(y1[2], y1[3]);
                    *(u32x4*)(YB + off + bj * HALF) = w;
                    s1 += ((y0[0] + y0[1]) + (y0[2] + y0[3])) + ((y1[0] + y1[1]) + (y1[2] + y1[3]));
                    s2 += ((y0[0] * y0[0] + y0[1] * y0[1]) + (y0[2] * y0[2] + y0[3] * y0[3])) + ((y1[0] * y1[0] + y1[1] * y1[1]) + (y1[2] * y1[2] + y1[3] * y1[3])); }
                if (HAS_OUT) { s1 = xsum32(xsum16(s1)); s2 = xsum32(xsum16(s2));
                    if (fq == 0) *(f32x2*)(st_out + (size_t)row * 32 + (u.pn * 4 + wc) * 2) = (f32x2){s1, s2}; } }
    }
};
struct EpiLnBf16 {
    static constexpr bool PERM = true;
    bf16_t* O; int ldc; const float* st_in; const float* cvec; const float* dvec;
    __device__ __forceinline__ void operator()(const f32x4 (&acc)[2][2][4][2], const Unit& u, int wr, int wc, int fr, int fq) const {
        const int row0 = u.pm * BM + wr * 64 + fr; const int col0 = u.pn * BM + wc * 32 + 8 * fq;
        f32x4 cv[2][2], dv[2][2];
#pragma unroll
        for (int bj = 0; bj < 2; ++bj)
#pragma unroll
            for (int n = 0; n < 2; ++n) { cv[bj][n] = *(const f32x4*)(cvec + col0 + bj * HALF + 4 * n); dv[bj][n] = *(const f32x4*)(dvec + col0 + bj * HALF + 4 * n); }
#pragma unroll
        for (int ai = 0; ai < 2; ++ai)
#pragma unroll
            for (int m = 0; m < 4; ++m) { const int row = row0 + ai * HALF + m * 16; bf16_t* rowp = O + (size_t)row * ldc + col0;
                float mu, rs; row_stats(st_in, row, fq, mu, rs);
#pragma unroll
                for (int bj = 0; bj < 2; ++bj) { const f32x4 v0 = (acc[ai][bj][m][0] - cv[bj][0] * mu) * rs + dv[bj][0], v1 = (acc[ai][bj][m][1] - cv[bj][1] * mu) * rs + dv[bj][1];
                    u32x4 w; w.x = cvt_pk_bf16(v0[0], v0[1]); w.y = cvt_pk_bf16(v0[2], v0[3]); w.z = cvt_pk_bf16(v1[0], v1[1]); w.w = cvt_pk_bf16(v1[2], v1[3]);
                    *(u32x4*)(rowp + bj * HALF) = w; } }
    }
};
struct EpiLnSwiGLU {
    static constexpr bool PERM = false;
    bf16_t* O; int ldc; const float* st_in; const float* cvec; const float* dvec;
    __device__ __forceinline__ void operator()(const f32x4 (&acc)[2][2][4][2], const Unit& u, int wr, int wc, int fr, int fq) const {
        const int row0 = u.pm * BM + wr * 64 + fr; const int col0 = u.pn * HALF + wc * 16 + 4 * fq; const int gcol0 = u.pn * BM + wc * 32 + 4 * fq;
        f32x4 cv[2][2], dv[2][2];
#pragma unroll
        for (int bj = 0; bj < 2; ++bj)
#pragma unroll
            for (int n = 0; n < 2; ++n) { cv[bj][n] = *(const f32x4*)(cvec + gcol0 + bj * HALF + 16 * n); dv[bj][n] = *(const f32x4*)(dvec + gcol0 + bj * HALF + 16 * n); }
#pragma unroll
        for (int ai = 0; ai < 2; ++ai)
#pragma unroll
            for (int m = 0; m < 4; ++m) { const int row = row0 + ai * HALF + m * 16; bf16_t* rowp = O + (size_t)row * ldc + col0;
                float mu, rs; row_stats(st_in, row, fq, mu, rs);
#pragma unroll
                for (int bj = 0; bj < 2; ++bj) { const f32x4 g = (acc[ai][bj][m][0] - cv[bj][0] * mu) * rs + dv[bj][0], up = (acc[ai][bj][m][1] - cv[bj][1] * mu) * rs + dv[bj][1]; float h[4];
#pragma unroll
                    for (int j = 0; j < 4; ++j) { const float s = g[j] * __builtin_amdgcn_rcpf(1.0f + __builtin_amdgcn_exp2f(-g[j] * LOG2E)); h[j] = s * up[j]; }
                    u32x2 w; w.x = cvt_pk_bf16(h[0], h[1]); w.y = cvt_pk_bf16(h[2], h[3]);
                    *(u32x2*)(rowp + bj * 64) = w; } }
    }
};

struct EpiPrep {
    static constexpr bool PERM = true;
    bf16_t* O; float scale; int omode;
    __device__ __forceinline__ void operator()(const f32x4 (&acc)[2][2][4][2], const Unit& u, int wr, int wc, int fr, int fq) const {
        bf16_t* base = (omode == 0) ? O + (size_t)u.pm * 256 * 1024 + u.pn * 256 : O + (size_t)(u.pm >> 2) * 1048576 + (size_t)u.pn * 256 * 1024 + (u.pm & 3) * 256;
        base += (size_t)(wr * 64 + fr) * 1024 + wc * 32 + 8 * fq;
#pragma unroll
        for (int ai = 0; ai < 2; ++ai)
#pragma unroll
            for (int m = 0; m < 4; ++m) { bf16_t* rowp = base + (size_t)(ai * HALF + m * 16) * 1024;
#pragma unroll
                for (int bj = 0; bj < 2; ++bj) { const f32x4 v0 = acc[ai][bj][m][0] * scale, v1 = acc[ai][bj][m][1] * scale;
                    u32x4 w; w.x = cvt_pk_bf16(v0[0], v0[1]); w.y = cvt_pk_bf16(v0[2], v0[3]); w.z = cvt_pk_bf16(v1[0], v1[1]); w.w = cvt_pk_bf16(v1[2], v1[3]);
                    *(u32x4*)(rowp + bj * HALF) = w; } }
    }
};
struct EpiSoftmaxP {
    static constexpr bool PERM = true;
    bf16_t* P; const float* st_in; const float* cb; const float* db; LAS float* xb;
    __device__ __forceinline__ void operator()(f32x4 (&acc)[2][2][4][2], const Unit& u, int wr, int wc, int fr, int fq) const {
        const int rl0 = wr * 64 + fr; const int col0 = u.pn * BM + wc * 32 + 8 * fq; const int bt = u.pm >> 4;
        {
            f32x4 cv[2][2], dv[2][2];
#pragma unroll
            for (int bj = 0; bj < 2; ++bj)
#pragma unroll
                for (int n = 0; n < 2; ++n) { cv[bj][n] = *(const f32x4*)(cb + bt * 1024 + col0 + bj * HALF + 4 * n); dv[bj][n] = *(const f32x4*)(db + bt * 1024 + col0 + bj * HALF + 4 * n); }
#pragma unroll
            for (int ai = 0; ai < 2; ++ai)
#pragma unroll
                for (int m = 0; m < 4; ++m) { const int rl = rl0 + ai * HALF + m * 16;
                    float mu, rs; row_stats(st_in, u.pm * BM + rl, fq, mu, rs);
                    float mx = -INFINITY;
#pragma unroll
                    for (int bj = 0; bj < 2; ++bj)
#pragma unroll
                        for (int n = 0; n < 2; ++n) { const f32x4 s = (acc[ai][bj][m][n] - cv[bj][n] * mu) * rs + dv[bj][n]; acc[ai][bj][m][n] = s;
                            mx = fmaxf(fmaxf(mx, s[0]), fmaxf(s[1], fmaxf(s[2], s[3]))); }
                    mx = xmax32(xmax16(mx));
                    if (fq == 0) xb[rl * 4 + wc] = mx; }
        }
        asm volatile("s_waitcnt lgkmcnt(0)" ::: "memory"); __builtin_amdgcn_s_barrier(); asm volatile("" ::: "memory");
#pragma unroll
        for (int ai = 0; ai < 2; ++ai)
#pragma unroll
            for (int m = 0; m < 4; ++m) { const int rl = rl0 + ai * HALF + m * 16;
                const f32x4 mm = *(const LAS f32x4*)(xb + rl * 4); const float rmax = fmaxf(fmaxf(mm[0], mm[1]), fmaxf(mm[2], mm[3])) * LOG2E;
                float sm = 0.f;
#pragma unroll
                for (int bj = 0; bj < 2; ++bj)
#pragma unroll
                    for (int n = 0; n < 2; ++n) { f32x4 p;
#pragma unroll
                        for (int j = 0; j < 4; ++j) p[j] = __builtin_amdgcn_exp2f(__builtin_fmaf(acc[ai][bj][m][n][j], LOG2E, -rmax));
                        acc[ai][bj][m][n] = p; sm += (p[0] + p[1]) + (p[2] + p[3]); }
                sm = xsum32(xsum16(sm));
                if (fq == 0) xb[1024 + rl * 4 + wc] = sm; }
        asm volatile("s_waitcnt lgkmcnt(0)" ::: "memory"); __builtin_amdgcn_s_barrier(); asm volatile("" ::: "memory");
#pragma unroll
        for (int ai = 0; ai < 2; ++ai)
#pragma unroll
            for (int m = 0; m < 4; ++m) { const int rl = rl0 + ai * HALF + m * 16;
                const f32x4 ss = *(const LAS f32x4*)(xb + 1024 + rl * 4); const float inv = 1.0f / ((ss[0] + ss[1]) + (ss[2] + ss[3]));
                bf16_t* rowp = P + (size_t)(u.pm * BM + rl) * 1024 + col0;
#pragma unroll
                for (int bj = 0; bj < 2; ++bj) { const f32x4 v0 = acc[ai][bj][m][0] * inv, v1 = acc[ai][bj][m][1] * inv;
                    u32x4 w; w.x = cvt_pk_bf16(v0[0], v0[1]); w.y = cvt_pk_bf16(v0[2], v0[3]); w.z = cvt_pk_bf16(v1[0], v1[1]); w.w = cvt_pk_bf16(v1[2], v1[3]);
                    *(u32x4*)(rowp + bj * HALF) = w; } }
    }
};

template <class Epi, class Sched>
__device__ __forceinline__ void gemm_phase(LAS unsigned char* lds, const Gemm g, const Sched S, const Epi E) {
    const int tid = threadIdx.x, wid = __builtin_amdgcn_readfirstlane(tid >> 6), lane = tid & 63, wr = wid >> 2, wc = wid & 3, fr = lane & 15, fq = lane >> 4;
    const int K = g.K, nt = K / BK;
    const int lda = g.lda ? g.lda : K, ldb = g.ldb ? g.ldb : K;
    unsigned voffA[2], voffB[2];
#pragma unroll
    for (int i = 0; i < 2; ++i) { int R, C; stage_rc(tid * 16 + i * 8192, R, C); const int Rb = Epi::PERM ? ((R & ~31) + perm32(R & 31)) : R;
        voffA[i] = (unsigned)(R * lda + C) * 2u; voffB[i] = (unsigned)(Rb * ldb + C) * 2u; }
    const size_t kstep = (size_t)(BK * 2);
    const size_t hstepA = (size_t)HALF * lda * 2, hstepB = (size_t)HALF * ldb * 2;
    const unsigned ldsw = (unsigned)wid * 1024u;
    const int aoff = lds_byte(wr * 64 + fr, fq * 8), boff = lds_byte(wc * 32 + fr, fq * 8);
#define PG8_SA(b, h) (((b) * 2 + (h)) * HTB)
#define PG8_SB(b, h) ((4 + (b) * 2 + (h)) * HTB)
#define PG8_STAGE(bufoff, gbase, voff) do { _Pragma("unroll") for (int _i = 0; _i < 2; ++_i) \
        __builtin_amdgcn_global_load_lds((const unsigned*)((const char*)(gbase) + (voff)[_i]), (LAS unsigned*)(lds + (bufoff) + ldsw + _i * 8192), 16, 0, 0); } while (0)
#define PG8_LDA(dst, b, h) do { _Pragma("unroll") for (int m = 0; m < 4; ++m) _Pragma("unroll") for (int k = 0; k < 2; ++k) dst[m][k] = *(const LAS bf16x8*)(lds + PG8_SA(b, h) + aoff + m * 2048 + k * 1024); } while (0)
#define PG8_LDB(dst, b, h) do { _Pragma("unroll") for (int n = 0; n < 2; ++n) _Pragma("unroll") for (int k = 0; k < 2; ++k) dst[n][k] = *(const LAS bf16x8*)(lds + PG8_SB(b, h) + boff + n * 2048 + k * 1024); } while (0)
#define PG8_MMA(ai, bj, At, Bt) do { __builtin_amdgcn_s_setprio(1); _Pragma("unroll") for (int m = 0; m < 4; ++m) _Pragma("unroll") for (int n = 0; n < 2; ++n) _Pragma("unroll") for (int k = 0; k < 2; ++k) \
        acc[ai][bj][m][n] = __builtin_amdgcn_mfma_f32_16x16x32_bf16(Bt[n][k], At[m][k], acc[ai][bj][m][n], 0, 0, 0); __builtin_amdgcn_s_setprio(0); } while (0)
#define PG8_WAIT_V(n) asm volatile("s_waitcnt vmcnt(" #n ")" ::: "memory")
#define PG8_WAIT_L(n) asm volatile("s_waitcnt lgkmcnt(" #n ")" ::: "memory")
#define PG8_BAR __builtin_amdgcn_s_barrier()
#define PG8_SCHED __builtin_amdgcn_sched_barrier(0)
    Unit cur, nxt; int ui = 0;
    if (!S.next(0, cur)) return;
    f32x4 acc[2][2][4][2];
#pragma unroll
    for (int a = 0; a < 2; ++a)
#pragma unroll
        for (int b = 0; b < 2; ++b)
#pragma unroll
            for (int m = 0; m < 4; ++m)
#pragma unroll
                for (int n = 0; n < 2; ++n) acc[a][b][m][n] = (f32x4){0.f, 0.f, 0.f, 0.f};
    bf16x8 At[4][2], B0[2][2], B1[2][2];
    const char* cA; const char* cB; unit_ptrs(g, cur, cA, cB);
    PG8_STAGE(PG8_SB(0, 0), cB, voffB); PG8_STAGE(PG8_SB(0, 1), cB + hstepB, voffB); PG8_STAGE(PG8_SA(0, 0), cA, voffA); PG8_STAGE(PG8_SA(0, 1), cA + hstepA, voffA);
    if (wr == 1) PG8_BAR;
    PG8_WAIT_V(2); PG8_BAR;
    PG8_STAGE(PG8_SB(1, 0), cB + kstep, voffB); PG8_STAGE(PG8_SA(1, 0), cA + kstep, voffA); PG8_STAGE(PG8_SB(1, 1), cB + hstepB + kstep, voffB);
    PG8_WAIT_V(6); PG8_BAR;
    for (;;) {
        const bool has_next = S.next(ui + 1, nxt);
        const char* nA = cA; const char* nB = cB; if (has_next) unit_ptrs(g, nxt, nA, nB);
#pragma unroll 1
        for (int t = 0; t < nt; t += 2) {
            const bool last = (t == nt - 2);
            const char* a1 = cA + (size_t)(t + 1) * kstep;
            const char* a2 = last ? nA : cA + (size_t)(t + 2) * kstep; const char* b2 = last ? nB : cB + (size_t)(t + 2) * kstep;
            const char* a3 = a2 + kstep; const char* b3 = b2 + kstep;
            PG8_LDB(B0, 0, 0); PG8_LDB(B1, 0, 1); PG8_SCHED; PG8_LDA(At, 0, 0); PG8_STAGE(PG8_SA(1, 1), a1 + hstepA, voffA);
            PG8_WAIT_V(8); PG8_WAIT_L(0); PG8_BAR; PG8_MMA(0, 0, At, B0); PG8_MMA(0, 1, At, B1); PG8_BAR; PG8_SCHED;
            PG8_LDA(At, 0, 1); PG8_STAGE(PG8_SB(0, 0), b2, voffB); PG8_STAGE(PG8_SB(0, 1), b2 + hstepB, voffB); PG8_STAGE(PG8_SA(0, 0), a2, voffA);
            PG8_WAIT_V(8); PG8_WAIT_L(0); PG8_BAR; PG8_MMA(1, 0, At, B0); PG8_MMA(1, 1, At, B1); PG8_BAR; PG8_SCHED;
            PG8_LDB(B0, 1, 0); PG8_LDB(B1, 1, 1); PG8_SCHED; PG8_LDA(At, 1, 0); PG8_STAGE(PG8_SA(0, 1), a2 + hstepA, voffA);
            PG8_WAIT_V(8); PG8_WAIT_L(0); PG8_BAR; PG8_MMA(0, 0, At, B0); PG8_MMA(0, 1, At, B1); PG8_BAR; PG8_SCHED;
            PG8_LDA(At, 1, 1); PG8_STAGE(PG8_SB(1, 0), b3, voffB); PG8_STAGE(PG8_SB(1, 1), b3 + hstepB, voffB); PG8_STAGE(PG8_SA(1, 0), a3, voffA);
            PG8_WAIT_V(8); PG8_WAIT_L(0); PG8_BAR; PG8_MMA(1, 0, At, B0); PG8_MMA(1, 1, At, B1); PG8_BAR; PG8_SCHED;
        }
        if (wr == 0) PG8_BAR;
        E(acc, cur, wr, wc, fr, fq);
        if (!has_next) break;
#pragma unroll
        for (int a = 0; a < 2; ++a)
#pragma unroll
            for (int b = 0; b < 2; ++b)
#pragma unroll
                for (int m = 0; m < 4; ++m)
#pragma unroll
                    for (int n = 0; n < 2; ++n) acc[a][b][m][n] = (f32x4){0.f, 0.f, 0.f, 0.f};
        cur = nxt; cA = nA; cB = nB; ++ui;
        if (wr == 1) PG8_BAR;
    }
    PG8_WAIT_V(0);
    PG8_BAR;
#undef PG8_SA
#undef PG8_SB
#undef PG8_STAGE
#undef PG8_LDA
#undef PG8_LDB
#undef PG8_MMA
#undef PG8_WAIT_V
#undef PG8_WAIT_L
#undef PG8_BAR
#undef PG8_SCHED
}
}

__device__ __forceinline__ s16x4 tr_read(const LAS unsigned char* p) { return __builtin_bit_cast(s16x4, __builtin_amdgcn_ds_read_tr16_b64_v4i16((LAS s16x4*)p)); }

template <int HD, int QI, int KT16 = 4>
__device__ __forceinline__ void attn_tile(const LAS unsigned char* Ks, const LAS unsigned char* Vs, const bf16x8 (&qf)[QI][HD / 32],
                                          float (&m)[QI], float (&l)[QI], f32x4 (&o)[QI][HD / 16], float sc,
                                          int maskmode, const int (&qloc)[QI], int kbase, const bool (&keep)[QI], int fr, int fq) {
    constexpr int KP = 2 * HD + 32;
    f32x4 s[QI][KT16];
#pragma unroll
    for (int qi = 0; qi < QI; ++qi)
#pragma unroll
        for (int kt = 0; kt < KT16; ++kt) s[qi][kt] = (f32x4){0.f, 0.f, 0.f, 0.f};
#pragma unroll
    for (int kt = 0; kt < KT16; ++kt)
#pragma unroll
        for (int dk = 0; dk < HD / 32; ++dk) {
            const bf16x8 kf = *(const LAS bf16x8*)(Ks + (16 * kt + fr) * KP + (32 * dk + 8 * fq) * 2);
#pragma unroll
            for (int qi = 0; qi < QI; ++qi) s[qi][kt] = __builtin_amdgcn_mfma_f32_16x16x32_bf16(kf, qf[qi][dk], s[qi][kt], 0, 0, 0);
        }
    float mxs[QI]; bool need = false;
#pragma unroll
    for (int qi = 0; qi < QI; ++qi) {
        if (maskmode == 1) {
#pragma unroll
            for (int kt = 0; kt < KT16; ++kt)
#pragma unroll
                for (int r = 0; r < 4; ++r) if (kbase + 16 * kt + 4 * fq + r > qloc[qi]) s[qi][kt][r] = -INFINITY;
        }
        float mx = fmaxf(fmaxf(s[qi][0][0], s[qi][0][1]), fmaxf(s[qi][0][2], s[qi][0][3]));
#pragma unroll
        for (int kt = 1; kt < KT16; ++kt) { mx = fmaxf(fmaxf(mx, s[qi][kt][0]), s[qi][kt][1]); mx = fmaxf(fmaxf(mx, s[qi][kt][2]), s[qi][kt][3]); }
        mx = xmax32(xmax16(mx));
        mxs[qi] = mx * sc;
        need = need || (keep[qi] && mxs[qi] > m[qi] + 8.0f);
    }
    if (__ballot(need) != 0ull) {
#pragma unroll
        for (int qi = 0; qi < QI; ++qi) {
            const bool upd = keep[qi] && mxs[qi] > m[qi] + 8.0f;
            const float mn = upd ? mxs[qi] : m[qi];
            const float al = __builtin_amdgcn_exp2f(m[qi] - mn); m[qi] = mn; l[qi] *= al;
#pragma unroll
            for (int dt = 0; dt < HD / 16; ++dt) o[qi][dt] = o[qi][dt] * al;
        }
    }
    bf16x8 pf[QI][KT16 / 2];
#pragma unroll
    for (int qi = 0; qi < QI; ++qi) {
        const float moff = keep[qi] ? -m[qi] : -INFINITY;
        float rs = 0.f;
#pragma unroll
        for (int kt = 0; kt < KT16; ++kt)
#pragma unroll
            for (int r = 0; r < 4; ++r) { const float p = __builtin_amdgcn_exp2f(__builtin_fmaf(s[qi][kt][r], sc, moff)); s[qi][kt][r] = p; rs += p; }
        l[qi] += rs;
#pragma unroll
        for (int p2 = 0; p2 < KT16 / 2; ++p2) {
            u32x4 w; w.x = cvt_pk_bf16(s[qi][2 * p2][0], s[qi][2 * p2][1]); w.y = cvt_pk_bf16(s[qi][2 * p2][2], s[qi][2 * p2][3]);
            w.z = cvt_pk_bf16(s[qi][2 * p2 + 1][0], s[qi][2 * p2 + 1][1]); w.w = cvt_pk_bf16(s[qi][2 * p2 + 1][2], s[qi][2 * p2 + 1][3]);
            pf[qi][p2] = __builtin_bit_cast(bf16x8, w);
        }
    }
    const LAS unsigned char* vb = Vs + (4 * fq + (fr >> 2)) * KP + (4 * (fr & 3)) * 2;
#pragma unroll
    for (int dt = 0; dt < HD / 16; ++dt)
#pragma unroll
        for (int p2 = 0; p2 < KT16 / 2; ++p2) {
            const s16x4 lo = tr_read(vb + (32 * p2) * KP + 32 * dt);
            const s16x4 hi = tr_read(vb + (32 * p2 + 16) * KP + 32 * dt);
            const bf16x8 vf = (bf16x8){lo[0], lo[1], lo[2], lo[3], hi[0], hi[1], hi[2], hi[3]};
#pragma unroll
            for (int qi = 0; qi < QI; ++qi) o[qi][dt] = __builtin_amdgcn_mfma_f32_16x16x32_bf16(vf, pf[qi][p2], o[qi][dt], 0, 0, 0);
        }
}

template <int HD, int QI, int KT16 = 4>
__device__ __forceinline__ void attn_tile_pl(const LAS unsigned char* Ks, const LAS unsigned char* Vs, const bf16x8 (&qf)[QI][HD / 32],
                                          float (&m)[QI], float (&l)[QI], f32x4 (&o)[QI][HD / 16], float sc,
                                          int maskmode, const int (&qloc)[QI], int kbase, const bool (&keep)[QI], int fr, int fq) {
    constexpr int KP = 2 * HD + 32;
    constexpr int NF = (HD / 32) * KT16, CH = 4, NCH = NF / CH;
    static_assert(NF % CH == 0, "fragment chunking");
    f32x4 s[QI][KT16];
#pragma unroll
    for (int qi = 0; qi < QI; ++qi)
#pragma unroll
        for (int kt = 0; kt < KT16; ++kt) s[qi][kt] = (f32x4){0.f, 0.f, 0.f, 0.f};
    const LAS unsigned char* kb = Ks + fr * KP + 16 * fq;
#define KFRAG(f) (*(const LAS bf16x8*)(kb + (16 * ((f) % KT16)) * KP + 64 * ((f) / KT16)))
    bf16x8 kf[2][CH];
#pragma unroll
    for (int i = 0; i < CH; ++i) kf[0][i] = KFRAG(i);
#pragma unroll
    for (int c = 0; c < NCH; ++c) {
        if (c + 1 < NCH) {
#pragma unroll
            for (int i = 0; i < CH; ++i) kf[(c + 1) & 1][i] = KFRAG((c + 1) * CH + i);
        }
        __builtin_amdgcn_sched_barrier(0);
#pragma unroll
        for (int i = 0; i < CH; ++i) { const int f = c * CH + i, kt = f % KT16, dk = f / KT16;
#pragma unroll
            for (int qi = 0; qi < QI; ++qi) s[qi][kt] = __builtin_amdgcn_mfma_f32_16x16x32_bf16(kf[c & 1][i], qf[qi][dk], s[qi][kt], 0, 0, 0); }
        __builtin_amdgcn_sched_barrier(0);
    }
#undef KFRAG
    constexpr int NV = (KT16 / 2) * (HD / 16), NVC = NV / CH;
    static_assert(NV % CH == 0, "V fragment chunking");
    const LAS unsigned char* vb = Vs + (4 * fq + (fr >> 2)) * KP + (4 * (fr & 3)) * 2;
#define VLO(g) tr_read(vb + (32 * ((g) / (HD / 16))) * KP + 32 * ((g) % (HD / 16)))
#define VHI(g) tr_read(vb + (32 * ((g) / (HD / 16)) + 16) * KP + 32 * ((g) % (HD / 16)))
    s16x4 vlo[2][CH], vhi[2][CH];
#pragma unroll
    for (int i = 0; i < CH; ++i) { vlo[0][i] = VLO(i); vhi[0][i] = VHI(i); }
    __builtin_amdgcn_sched_barrier(0);
    float mxs[QI]; bool need = false;
#pragma unroll
    for (int qi = 0; qi < QI; ++qi) {
        if (maskmode == 1) {
#pragma unroll
            for (int kt = 0; kt < KT16; ++kt)
#pragma unroll
                for (int r = 0; r < 4; ++r) if (kbase + 16 * kt + 4 * fq + r > qloc[qi]) s[qi][kt][r] = -INFINITY;
        }
        float mx = fmaxf(fmaxf(s[qi][0][0], s[qi][0][1]), fmaxf(s[qi][0][2], s[qi][0][3]));
#pragma unroll
        for (int kt = 1; kt < KT16; ++kt) { mx = fmaxf(fmaxf(mx, s[qi][kt][0]), s[qi][kt][1]); mx = fmaxf(fmaxf(mx, s[qi][kt][2]), s[qi][kt][3]); }
        mx = xmax32(xmax16(mx));
        mxs[qi] = mx * sc;
        need = need || (keep[qi] && mxs[qi] > m[qi] + 8.0f);
    }
    if (__ballot(need) != 0ull) {
#pragma unroll
        for (int qi = 0; qi < QI; ++qi) {
            const bool upd = keep[qi] && mxs[qi] > m[qi] + 8.0f;
            const float mn = upd ? mxs[qi] : m[qi];
            const float al = __builtin_amdgcn_exp2f(m[qi] - mn); m[qi] = mn; l[qi] *= al;
#pragma unroll
            for (int dt = 0; dt < HD / 16; ++dt) o[qi][dt] = o[qi][dt] * al;
        }
    }
    bf16x8 pf[QI][KT16 / 2];
#pragma unroll
    for (int qi = 0; qi < QI; ++qi) {
        const float moff = keep[qi] ? -m[qi] : -INFINITY;
        float rs = 0.f;
#pragma unroll
        for (int kt = 0; kt < KT16; ++kt)
#pragma unroll
            for (int r = 0; r < 4; ++r) { const float p = __builtin_amdgcn_exp2f(__builtin_fmaf(s[qi][kt][r], sc, moff)); s[qi][kt][r] = p; rs += p; }
        l[qi] += rs;
#pragma unroll
        for (int p2 = 0; p2 < KT16 / 2; ++p2) {
            u32x4 w; w.x = cvt_pk_bf16(s[qi][2 * p2][0], s[qi][2 * p2][1]); w.y = cvt_pk_bf16(s[qi][2 * p2][2], s[qi][2 * p2][3]);
            w.z = cvt_pk_bf16(s[qi][2 * p2 + 1][0], s[qi][2 * p2 + 1][1]); w.w = cvt_pk_bf16(s[qi][2 * p2 + 1][2], s[qi][2 * p2 + 1][3]);
            pf[qi][p2] = __builtin_bit_cast(bf16x8, w);
        }
    }
    __builtin_amdgcn_sched_barrier(0);
#pragma unroll
    for (int c = 0; c < NVC; ++c) {
        if (c + 1 < NVC) {
#pragma unroll
            for (int i = 0; i < CH; ++i) { vlo[(c + 1) & 1][i] = VLO((c + 1) * CH + i); vhi[(c + 1) & 1][i] = VHI((c + 1) * CH + i); }
        }
        __builtin_amdgcn_sched_barrier(0);
#pragma unroll
        for (int i = 0; i < CH; ++i) { const int g = c * CH + i, p2 = g / (HD / 16), dt = g % (HD / 16);
            const s16x4 lo = vlo[c & 1][i], hi = vhi[c & 1][i];
            const bf16x8 vf = (bf16x8){lo[0], lo[1], lo[2], lo[3], hi[0], hi[1], hi[2], hi[3]};
#pragma unroll
            for (int qi = 0; qi < QI; ++qi) o[qi][dt] = __builtin_amdgcn_mfma_f32_16x16x32_bf16(vf, pf[qi][p2], o[qi][dt], 0, 0, 0); }
        __builtin_amdgcn_sched_barrier(0);
    }
#undef VLO
#undef VHI
}

template <int HD> struct Stage { static constexpr int CH = HD / 8, NLD = 64 * CH / 512, KP = 2 * HD + 32, TILE_B = 64 * KP; u32x4 k[NLD], v[NLD]; };
template <int HD>
__device__ __forceinline__ void stage_load(Stage<HD>& st, const bf16_t* Kg, const bf16_t* Vg, int gp, int tid) {
#pragma unroll
    for (int i = 0; i < Stage<HD>::NLD; ++i) { const int idx = tid + 512 * i, row = idx / Stage<HD>::CH, ch = idx % Stage<HD>::CH;
        st.k[i] = *(const u32x4*)(Kg + (size_t)row * gp + ch * 8); st.v[i] = *(const u32x4*)(Vg + (size_t)row * gp + ch * 8); }
}
template <int HD>
__device__ __forceinline__ void stage_store(const Stage<HD>& st, LAS unsigned char* buf, int tid) {
#pragma unroll
    for (int i = 0; i < Stage<HD>::NLD; ++i) { const int idx = tid + 512 * i, row = idx / Stage<HD>::CH, ch = idx % Stage<HD>::CH;
        *(LAS u32x4*)(buf + row * Stage<HD>::KP + ch * 16) = st.k[i]; *(LAS u32x4*)(buf + Stage<HD>::TILE_B + row * Stage<HD>::KP + ch * 16) = st.v[i]; }
}

namespace moba {
constexpr int HD = 64, KP = 2 * HD + 32, BLKB = 256 * KP;
constexpr int L_K = 0, L_V = BLKB, L_O = 2 * BLKB, L_M = L_O + 256 * 128, L_L = L_M + 1024, L_LIST = L_L + 1024, L_CNT = L_LIST + 15 * 256, L_Q = L_CNT + 64, L_END = L_Q + 256 * 128;
struct BlkStage { u32x4 k[4], v[4]; };
__device__ __forceinline__ void blk_load(BlkStage& st, const bf16_t* Kg, const bf16_t* Vg, int tid) {
#pragma unroll
    for (int i = 0; i < 4; ++i) { const int idx = tid + 512 * i, row = idx >> 3, ch = idx & 7;
        st.k[i] = *(const u32x4*)(Kg + (size_t)row * INW + ch * 8); st.v[i] = *(const u32x4*)(Vg + (size_t)row * INW + ch * 8); }
}
__device__ __forceinline__ void blk_store(const BlkStage& st, LAS unsigned char* lds, int tid) {
#pragma unroll
    for (int i = 0; i < 4; ++i) { const int idx = tid + 512 * i, row = idx >> 3, ch = idx & 7;
        *(LAS u32x4*)(lds + L_K + row * KP + ch * 16) = st.k[i]; *(LAS u32x4*)(lds + L_V + row * KP + ch * 16) = st.v[i]; }
}
template <int QI>
__device__ __forceinline__ void past_tiles(LAS unsigned char* lds, const int (&rows)[QI], const bool (&valid)[QI], float sc, int fr, int fq) {
    bf16x8 qf[QI][2]; float m[QI], l[QI]; f32x4 o[QI][4]; int qloc[QI];
#pragma unroll
    for (int qi = 0; qi < QI; ++qi) {
#pragma unroll
        for (int dk = 0; dk < 2; ++dk) qf[qi][dk] = *(const LAS bf16x8*)(lds + L_Q + rows[qi] * 128 + (32 * dk + 8 * fq) * 2);
        m[qi] = *(const LAS float*)(lds + L_M + rows[qi] * 4);
        l[qi] = (fq == 0) ? *(const LAS float*)(lds + L_L + rows[qi] * 4) : 0.f;
        qloc[qi] = 0;
#pragma unroll
        for (int dt = 0; dt < 4; ++dt) { const u32x2 ov = *(const LAS u32x2*)(lds + L_O + rows[qi] * 128 + (16 * dt + 4 * fq) * 2);
            o[qi][dt] = (f32x4){__uint_as_float(ov.x << 16), __uint_as_float(ov.x & 0xffff0000u), __uint_as_float(ov.y << 16), __uint_as_float(ov.y & 0xffff0000u)}; }
    }
    if constexpr (QI == 1) attn_tile_pl<HD, 1, 16>(lds + L_K, lds + L_V, qf, m, l, o, sc, 0, qloc, 0, valid, fr, fq);
    else {
#pragma unroll 1
        for (int half = 0; half < 2; ++half)
            attn_tile<HD, QI, 8>(lds + L_K + half * 128 * KP, lds + L_V + half * 128 * KP, qf, m, l, o, sc, 0, qloc, 0, valid, fr, fq);
    }
#pragma unroll
    for (int qi = 0; qi < QI; ++qi) {
        const float lt = xsum32(xsum16(l[qi]));
        if (valid[qi]) {
            if (fq == 0) { *(LAS float*)(lds + L_M + rows[qi] * 4) = m[qi]; *(LAS float*)(lds + L_L + rows[qi] * 4) = lt; }
#pragma unroll
            for (int dt = 0; dt < 4; ++dt) { u32x2 ov; ov.x = cvt_pk_bf16(o[qi][dt][0], o[qi][dt][1]); ov.y = cvt_pk_bf16(o[qi][dt][2], o[qi][dt][3]);
                *(LAS u32x2*)(lds + L_O + rows[qi] * 128 + (16 * dt + 4 * fq) * 2) = ov; }
        }
    }
}
}

__device__ __forceinline__ void moba_unit(int b, int h, int blk, const bf16_t* Z, const float* KM, bf16_t* MIX, LAS unsigned char* lds) {
    using namespace moba;
    constexpr int QI = 2;
    const int tid = threadIdx.x, lane = tid & 63, w = __builtin_amdgcn_readfirstlane(tid >> 6), fr = lane & 15, fq = lane >> 4;
    const size_t rowb = (size_t)b * SEQ;
    const int q0 = 256 * blk + 32 * w;
    const bf16_t* Kh = Z + rowb * INW + 1024 + h * 64; const bf16_t* Vh = Z + rowb * INW + 1536 + h * 64;
    const bf16_t* Qblk = Z + (rowb + 256 * blk) * INW + 512 + h * 64;
    BlkStage st;
    blk_load(st, Kh + (size_t)(256 * blk) * INW, Vh + (size_t)(256 * blk) * INW, tid);
    bf16x8 qf[QI][2];
#pragma unroll
    for (int qi = 0; qi < QI; ++qi)
#pragma unroll
        for (int dk = 0; dk < 2; ++dk) qf[qi][dk] = *(const bf16x8*)(Qblk + (size_t)(32 * w + 16 * qi + fr) * INW + 32 * dk + 8 * fq);
    __syncthreads();
    if (tid < 16) *(LAS unsigned*)(lds + L_CNT + tid * 4) = 0u;
    if (blk > 0) {
#pragma unroll
        for (int i = 0; i < 4; ++i) { const int idx = tid + 512 * i, row = idx >> 3, ch = idx & 7;
            *(LAS u32x4*)(lds + L_Q + row * 128 + ch * 16) = *(const u32x4*)(Qblk + (size_t)row * INW + ch * 8); }
    }
    __syncthreads();
    {
        float v1[QI], v2[QI], v3[QI]; int i1[QI], i2[QI], i3[QI];
#pragma unroll
        for (int qi = 0; qi < QI; ++qi) { v1[qi] = v2[qi] = v3[qi] = -INFINITY; i1[qi] = i2[qi] = i3[qi] = -1; }
        const float* kmb = KM + (size_t)((b * 8 + h) * NBLK) * 64;
        for (int j = 0; j < blk; ++j) {
            f32x4 km[2][2];
#pragma unroll
            for (int dk = 0; dk < 2; ++dk) { km[dk][0] = *(const f32x4*)(kmb + j * 64 + 32 * dk + 8 * fq); km[dk][1] = *(const f32x4*)(kmb + j * 64 + 32 * dk + 8 * fq + 4); }
#pragma unroll
            for (int qi = 0; qi < QI; ++qi) {
                float g = 0.f;
#pragma unroll
                for (int dk = 0; dk < 2; ++dk)
#pragma unroll
                    for (int e = 0; e < 8; ++e) g += bf2f((unsigned short)qf[qi][dk][e]) * km[dk][e >> 2][e & 3];
                g = xsum32(xsum16(g));
                if (g > v1[qi]) { v3[qi] = v2[qi]; i3[qi] = i2[qi]; v2[qi] = v1[qi]; i2[qi] = i1[qi]; v1[qi] = g; i1[qi] = j; }
                else if (g > v2[qi]) { v3[qi] = v2[qi]; i3[qi] = i2[qi]; v2[qi] = g; i2[qi] = j; }
                else if (g > v3[qi]) { v3[qi] = g; i3[qi] = j; }
            }
        }
        if (fq == 0) {
#pragma unroll
            for (int qi = 0; qi < QI; ++qi) { const int row = 32 * w + 16 * qi + fr; const int ids[3] = {i1[qi], i2[qi], i3[qi]};
#pragma unroll
                for (int k3 = 0; k3 < 3; ++k3) if (ids[k3] >= 0) {
                    const unsigned pos = __hip_atomic_fetch_add((LAS unsigned*)(lds + L_CNT + ids[k3] * 4), 1u, __ATOMIC_RELAXED, __HIP_MEMORY_SCOPE_WORKGROUP);
                    *(LAS unsigned char*)(lds + L_LIST + ids[k3] * 256 + pos) = (unsigned char)row; } }
        }
    }
    blk_store(st, lds, tid);
    __syncthreads();
    { const int jn = blk > 0 ? 0 : blk; blk_load(st, Kh + (size_t)(256 * jn) * INW, Vh + (size_t)(256 * jn) * INW, tid); }
    const float sc = 0.125f * LOG2E;
    {
        float m[QI], l[QI]; f32x4 o[QI][4]; int qloc[QI]; bool keep[QI];
#pragma unroll
        for (int qi = 0; qi < QI; ++qi) { m[qi] = -1e30f; l[qi] = 0.f; qloc[qi] = 32 * w + 16 * qi + fr; keep[qi] = true;
#pragma unroll
            for (int dt = 0; dt < 4; ++dt) o[qi][dt] = (f32x4){0.f, 0.f, 0.f, 0.f}; }
#pragma unroll 1
        for (int half = 0; half < 2; ++half)
            if (128 * half <= 32 * w) attn_tile<HD, QI, 8>(lds + L_K + half * 128 * KP, lds + L_V + half * 128 * KP, qf, m, l, o, sc, 1, qloc, 128 * half, keep, fr, fq);
#pragma unroll
        for (int qi = 0; qi < QI; ++qi) {
            const float lt = xsum32(xsum16(l[qi])); const int row = 32 * w + 16 * qi + fr;
            if (blk == 0) {
                const float inv = 1.0f / lt; bf16_t* op = MIX + (rowb + q0 + 16 * qi + fr) * DM + 512 + h * 64 + 4 * fq;
#pragma unroll
                for (int dt = 0; dt < 4; ++dt) { const f32x4 v = o[qi][dt] * inv; u32x2 wv; wv.x = cvt_pk_bf16(v[0], v[1]); wv.y = cvt_pk_bf16(v[2], v[3]); *(u32x2*)(op + 16 * dt) = wv; }
            } else {
                if (fq == 0) { *(LAS float*)(lds + L_M + row * 4) = m[qi]; *(LAS float*)(lds + L_L + row * 4) = lt; }
#pragma unroll
                for (int dt = 0; dt < 4; ++dt) { u32x2 ov; ov.x = cvt_pk_bf16(o[qi][dt][0], o[qi][dt][1]); ov.y = cvt_pk_bf16(o[qi][dt][2], o[qi][dt][3]);
                    *(LAS u32x2*)(lds + L_O + row * 128 + (16 * dt + 4 * fq) * 2) = ov; }
            }
        }
    }
    for (int j = 0; j < blk; ++j) {
        __syncthreads();
        blk_store(st, lds, tid);
        __syncthreads();
        { const int jn = (j + 1 < blk) ? j + 1 : j; blk_load(st, Kh + (size_t)(256 * jn) * INW, Vh + (size_t)(256 * jn) * INW, tid); }
        const int n = (int)*(const LAS unsigned*)(lds + L_CNT + j * 4);
        const int tiles = (n + 15) >> 4;
        for (int tw = w; tw < tiles; tw += 8) {
            int rows[1]; bool valid[1];
            { const int idx = 16 * tw + fr; valid[0] = idx < n; rows[0] = *(const LAS unsigned char*)(lds + L_LIST + j * 256 + (valid[0] ? idx : 0)); }
            past_tiles<1>(lds, rows, valid, sc, fr, fq);
        }
    }
    if (blk > 0) {
        __syncthreads();
#pragma unroll
        for (int qi = 0; qi < QI; ++qi) {
            const int row = 32 * w + 16 * qi + fr;
            const float inv = 1.0f / *(const LAS float*)(lds + L_L + row * 4);
            bf16_t* op = MIX + (rowb + q0 + 16 * qi + fr) * DM + 512 + h * 64 + 4 * fq;
#pragma unroll
            for (int dt = 0; dt < 4; ++dt) { const u32x2 ov = *(const LAS u32x2*)(lds + L_O + row * 128 + (16 * dt + 4 * fq) * 2);
                const f32x4 v = (f32x4){__uint_as_float(ov.x << 16), __uint_as_float(ov.x & 0xffff0000u), __uint_as_float(ov.y << 16), __uint_as_float(ov.y & 0xffff0000u)} * inv;
                u32x2 wv; wv.x = cvt_pk_bf16(v[0], v[1]); wv.y = cvt_pk_bf16(v[2], v[3]); *(u32x2*)(op + 16 * dt) = wv; }
        }
    }
}

__device__ __forceinline__ void xattn_unit(int qt, int hd, const bf16_t* XQ, const bf16_t* MEMKV, bf16_t* XO, LAS unsigned char* lds) {
    constexpr int HD = 256, QI = 1, TB = Stage<HD>::TILE_B;
    const int tid = threadIdx.x, lane = tid & 63, w = __builtin_amdgcn_readfirstlane(tid >> 6), fr = lane & 15, fq = lane >> 4;
    const int b = qt >> 5;
    const size_t qrow = (size_t)qt * 128 + 16 * w + fr;
    bf16x8 qf[QI][HD / 32];
#pragma unroll
    for (int dk = 0; dk < HD / 32; ++dk) qf[0][dk] = *(const bf16x8*)(XQ + qrow * DM + hd * 256 + 32 * dk + 8 * fq);
    float m[QI] = {-1e30f}, l[QI] = {0.f}; f32x4 o[QI][HD / 16]; int qloc[QI] = {0}; bool keep[QI] = {true};
#pragma unroll
    for (int dt = 0; dt < HD / 16; ++dt) o[0][dt] = (f32x4){0.f, 0.f, 0.f, 0.f};
    const float sc = 0.0625f * LOG2E;
    const bf16_t* Kh = MEMKV + (size_t)b * MEMLEN * 2048 + hd * 256; const bf16_t* Vh = Kh + 1024;
    Stage<HD> st;
    __syncthreads();
    stage_load<HD>(st, Kh, Vh, 2048, tid);
    stage_store<HD>(st, lds, tid);
    __syncthreads();
    for (int t = 0; t < 4; ++t) {
        if (t + 1 < 4) stage_load<HD>(st, Kh + (size_t)(64 * (t + 1)) * 2048, Vh + (size_t)(64 * (t + 1)) * 2048, 2048, tid);
        const LAS unsigned char* buf = lds + (t & 1) * 2 * TB;
        attn_tile<HD, QI>(buf, buf + TB, qf, m, l, o, sc, 0, qloc, 0, keep, fr, fq);
        if (t + 1 < 4) stage_store<HD>(st, lds + ((t + 1) & 1) * 2 * TB, tid);
        __syncthreads();
    }
    float ls = xsum32(xsum16(l[0]));
    const float inv = 1.0f / ls;
    bf16_t* op = XO + qrow * DM + hd * 256 + 4 * fq;
#pragma unroll
    for (int dt = 0; dt < HD / 16; ++dt) { const f32x4 v = o[0][dt] * inv; u32x2 wv; wv.x = cvt_pk_bf16(v[0], v[1]); wv.y = cvt_pk_bf16(v[2], v[3]); *(u32x2*)(op + 16 * dt) = wv; }
}

__device__ __forceinline__ void p0_transpose_item(const float* W, int K, int N, bf16_t* WT, int mode, LAS float* scr, int item, int lane, const float* ks = nullptr) {
    const int nblk = N / 32, kb = item / nblk, nb = item % nblk, k0 = 64 * kb, n0 = 32 * nb;
    float wv[32];
#pragma unroll
    for (int i = 0; i < 32; ++i) wv[i] = W[(size_t)(k0 + 2 * i + (lane >> 5)) * N + n0 + (lane & 31)];
#pragma unroll
    for (int i = 0; i < 32; ++i) { const int kk = 2 * i + (lane >> 5); scr[kk * 33 + (lane & 31)] = ks ? wv[i] * ks[k0 + kk] : wv[i]; }
    asm volatile("s_waitcnt lgkmcnt(0)" ::: "memory");
    const int c = lane & 7;
#pragma unroll
    for (int j = 0; j < 4; ++j) { const int n = (lane >> 3) + 8 * j; const LAS float* s = scr + (8 * c) * 33 + n;
        u32x4 o; o.x = cvt_pk_bf16(s[0 * 33], s[1 * 33]); o.y = cvt_pk_bf16(s[2 * 33], s[3 * 33]); o.z = cvt_pk_bf16(s[4 * 33], s[5 * 33]); o.w = cvt_pk_bf16(s[6 * 33], s[7 * 33]);
        const int gn = n0 + n; const int row = (mode == 0) ? gn : (32 * (gn >> 4) + (gn & 15) + (mode == 2 ? 16 : 0));
        *(u32x4*)(WT + (size_t)row * K + k0 + 8 * c) = o; }
    asm volatile("s_waitcnt lgkmcnt(0)" ::: "memory");
}
__device__ __forceinline__ void cvt_rows_bf16(const float* src, bf16_t* dst, size_t n8, size_t gtid, size_t nthr) {
    size_t i = gtid;
    for (; i + 3 * nthr < n8; i += 4 * nthr) {
        f32x4 a[4], b[4];
#pragma unroll
        for (int q = 0; q < 4; ++q) { a[q] = *(const f32x4*)(src + (i + q * nthr) * 8); b[q] = *(const f32x4*)(src + (i + q * nthr) * 8 + 4); }
#pragma unroll
        for (int q = 0; q < 4; ++q) { u32x4 o; o.x = cvt_pk_bf16(a[q][0], a[q][1]); o.y = cvt_pk_bf16(a[q][2], a[q][3]); o.z = cvt_pk_bf16(b[q][0], b[q][1]); o.w = cvt_pk_bf16(b[q][2], b[q][3]); *(u32x4*)(dst + (i + q * nthr) * 8) = o; }
    }
    for (; i < n8; i += nthr) { const f32x4 a = *(const f32x4*)(src + i * 8), b = *(const f32x4*)(src + i * 8 + 4);
        u32x4 o; o.x = cvt_pk_bf16(a[0], a[1]); o.y = cvt_pk_bf16(a[2], a[3]); o.z = cvt_pk_bf16(b[0], b[1]); o.w = cvt_pk_bf16(b[2], b[3]); *(u32x4*)(dst + i * 8) = o; }
}
__device__ __forceinline__ void ln_row(const float* yrow, const float* g, const float* bta, float* hrow, bf16_t* brow, int lane) {
    f32x4 v[4]; float s = 0.f;
#pragma unroll
    for (int j = 0; j < 4; ++j) { v[j] = *((const f32x4*)yrow + lane + 64 * j); s += (v[j][0] + v[j][1]) + (v[j][2] + v[j][3]); }
    const float mean = wave_sum(s) * (1.f / DM); float s2 = 0.f;
#pragma unroll
    for (int j = 0; j < 4; ++j) { v[j] = v[j] - mean; s2 += (v[j][0] * v[j][0] + v[j][1] * v[j][1]) + (v[j][2] * v[j][2] + v[j][3] * v[j][3]); }
    const float rstd = 1.f / sqrtf(wave_sum(s2) * (1.f / DM) + LN_EPS);
#pragma unroll
    for (int j = 0; j < 4; ++j) { const f32x4 gg = *((const f32x4*)g + lane + 64 * j), bb = *((const f32x4*)bta + lane + 64 * j);
        const f32x4 r = v[j] * rstd * gg + bb; *((f32x4*)hrow + lane + 64 * j) = r;
        if (brow) { u32x2 wv; wv.x = cvt_pk_bf16(r[0], r[1]); wv.y = cvt_pk_bf16(r[2], r[3]); *((u32x2*)brow + lane + 64 * j) = wv; } }
}

__device__ __forceinline__ void ln_row_bf16in(const bf16_t* yrow, const float* g, const float* bta, float* orow, int lane) {
    f32x4 v[4]; float s = 0.f;
#pragma unroll
    for (int j = 0; j < 2; ++j) { const u32x4 rr = *((const u32x4*)yrow + lane + 64 * j);
        v[2 * j] = (f32x4){__uint_as_float(rr.x << 16), __uint_as_float(rr.x & 0xffff0000u), __uint_as_float(rr.y << 16), __uint_as_float(rr.y & 0xffff0000u)};
        v[2 * j + 1] = (f32x4){__uint_as_float(rr.z << 16), __uint_as_float(rr.z & 0xffff0000u), __uint_as_float(rr.w << 16), __uint_as_float(rr.w & 0xffff0000u)};
        s += ((v[2 * j][0] + v[2 * j][1]) + (v[2 * j][2] + v[2 * j][3])) + ((v[2 * j + 1][0] + v[2 * j + 1][1]) + (v[2 * j + 1][2] + v[2 * j + 1][3])); }
    const float mean = wave_sum(s) * (1.f / DM); float s2 = 0.f;
#pragma unroll
    for (int j = 0; j < 4; ++j) { v[j] = v[j] - mean; s2 += (v[j][0] * v[j][0] + v[j][1] * v[j][1]) + (v[j][2] * v[j][2] + v[j][3] * v[j][3]); }
    const float rstd = 1.f / sqrtf(wave_sum(s2) * (1.f / DM) + LN_EPS);
#pragma unroll
    for (int q = 0; q < 4; ++q) { const int ci = 512 * (q >> 1) + 8 * lane + 4 * (q & 1);
        const f32x4 gg = *(const f32x4*)(g + ci), bb = *(const f32x4*)(bta + ci);
        *(f32x4*)(orow + ci) = v[q] * rstd * gg + bb; }
}

__device__ __forceinline__ void ln_rows4_bf16in(const bf16_t* y, const float* g, const float* bta, float* o, int ld, int lane) {
    u32x4 rr[4][2];
#pragma unroll
    for (int q = 0; q < 4; ++q)
#pragma unroll
        for (int j = 0; j < 2; ++j) rr[q][j] = *((const u32x4*)(y + (size_t)q * ld) + lane + 64 * j);
    f32x4 gg[4], bb[4];
#pragma unroll
    for (int c4 = 0; c4 < 4; ++c4) { const int ci = 512 * (c4 >> 1) + 8 * lane + 4 * (c4 & 1); gg[c4] = *(const f32x4*)(g + ci); bb[c4] = *(const f32x4*)(bta + ci); }
#pragma unroll
    for (int q = 0; q < 4; ++q) {
        f32x4 v[4]; float s = 0.f;
#pragma unroll
        for (int j = 0; j < 2; ++j) { const u32x4 w = rr[q][j];
            v[2 * j] = (f32x4){__uint_as_float(w.x << 16), __uint_as_float(w.x & 0xffff0000u), __uint_as_float(w.y << 16), __uint_as_float(w.y & 0xffff0000u)};
            v[2 * j + 1] = (f32x4){__uint_as_float(w.z << 16), __uint_as_float(w.z & 0xffff0000u), __uint_as_float(w.w << 16), __uint_as_float(w.w & 0xffff0000u)}; }
#pragma unroll
        for (int c4 = 0; c4 < 4; ++c4) s += (v[c4][0] + v[c4][1]) + (v[c4][2] + v[c4][3]);
        const float mean = wave_sum(s) * (1.f / DM); float s2 = 0.f;
#pragma unroll
        for (int c4 = 0; c4 < 4; ++c4) { v[c4] = v[c4] - mean; s2 += (v[c4][0] * v[c4][0] + v[c4][1] * v[c4][1]) + (v[c4][2] * v[c4][2] + v[c4][3] * v[c4][3]); }
        const float rstd = 1.f / sqrtf(wave_sum(s2) * (1.f / DM) + LN_EPS);
#pragma unroll
        for (int c4 = 0; c4 < 4; ++c4) { const int ci = 512 * (c4 >> 1) + 8 * lane + 4 * (c4 & 1); *(f32x4*)(o + (size_t)q * ld + ci) = v[c4] * rstd * gg[c4] + bb[c4]; }
    }
}

#define XB_TMO      128
#define XB_XCNT(j)  (256  + 64 * (j))
#define XB_XSUB(j)  (1280 + 64 * (j))
#define XB_XGEN(j)  (2304 + 64 * (j))
#define XB_TOP      3328
#define XB_TOPGEN   3392
#define XCD_BAR_WORDS 3456
#define XB_SPIN_CAP (1u << 20)
__device__ __forceinline__ unsigned xb_ld(unsigned* p)              { return __hip_atomic_load(p, __ATOMIC_RELAXED, __HIP_MEMORY_SCOPE_AGENT); }
__device__ __forceinline__ unsigned xb_add(unsigned* p, unsigned v) { return __hip_atomic_fetch_add(p, v, __ATOMIC_RELAXED, __HIP_MEMORY_SCOPE_AGENT); }
__device__ __forceinline__ unsigned xb_xcc_id() { return (unsigned)__builtin_amdgcn_s_getreg((3 << 11) | 20) & 0xFu; }
#define XB_SPIN(cond, bar) do { unsigned _sp = 0; while (cond) { __builtin_amdgcn_s_sleep(1); \
    if ((++_sp & 255u) == 0u) { if (xb_ld(&(bar)[XB_TMO])) break; if (_sp > XB_SPIN_CAP) { atomicAdd(&(bar)[XB_TMO], 1u); break; } } } } while (0)
struct XcdBarrier { unsigned* bar; unsigned x; volatile LAS unsigned* st; };
__device__ __forceinline__ XcdBarrier xcd_barrier_post(unsigned* bar, volatile LAS unsigned* st) {
    XcdBarrier b; b.bar = bar; b.x = xb_xcc_id(); b.st = st;
    if (threadIdx.x == 0) (void)xb_add(&bar[XB_XCNT(b.x)], 1u);
    return b;
}
__device__ __forceinline__ void xcd_barrier_complete(unsigned* bar, unsigned x, unsigned& nloc, unsigned& nx) {
    const unsigned G = gridDim.x * gridDim.y * gridDim.z;
    unsigned sum, cnt, mine, sp = 0u;
    for (;;) {
        sum = 0u; cnt = 0u; mine = 0u;
#pragma unroll
        for (unsigned j = 0; j < 16; ++j) { const unsigned c = xb_ld(&bar[XB_XCNT(j)]); sum += c; cnt += (c > 0u) ? 1u : 0u; mine = (j == x) ? c : mine; }
        if (sum == G) break;
        __builtin_amdgcn_s_sleep(1);
        if ((++sp & 255u) == 0u) { if (xb_ld(&bar[XB_TMO])) break; if (sp > XB_SPIN_CAP) { atomicAdd(&bar[XB_TMO], 1u); break; } }
    }
    nloc = mine > 0u ? mine : 1u; nx = cnt > 0u ? cnt : 1u;
}
__device__ __forceinline__ void xcd_barrier(const XcdBarrier& b) {
    asm volatile("s_waitcnt vmcnt(0)" ::: "memory");
    __syncthreads();
    if (threadIdx.x == 0) {
        unsigned* bar = b.bar;
        __builtin_amdgcn_s_waitcnt(0);
        unsigned nloc = b.st[0], nx = b.st[1];
        if (nloc == 0u) { xcd_barrier_complete(bar, b.x, nloc, nx); b.st[0] = nloc; b.st[1] = nx; }
        const unsigned old = xb_add(&bar[XB_XSUB(b.x)], 1u);
        const unsigned gen = old / nloc;
        if (old + 1u == (gen + 1u) * nloc) {
            __builtin_amdgcn_fence(__ATOMIC_RELEASE, "agent");
            asm volatile("s_waitcnt vmcnt(0)" ::: "memory");
            const unsigned og = xb_add(&bar[XB_TOP], 1u);
            const unsigned tg = og / nx;
            if (og + 1u == (tg + 1u) * nx) xb_add(&bar[XB_TOPGEN], 1u);
            else XB_SPIN(xb_ld(&bar[XB_TOPGEN]) == tg, bar);
            __builtin_amdgcn_fence(__ATOMIC_ACQUIRE, "agent");
            xb_add(&bar[XB_XGEN(b.x)], 1u);
            asm volatile("s_waitcnt vmcnt(0)" ::: "memory");
        } else {
            XB_SPIN(xb_ld(&bar[XB_XGEN(b.x)]) == gen, bar);
            __builtin_amdgcn_fence(__ATOMIC_ACQUIRE, "agent");
            asm volatile("s_waitcnt vmcnt(0)" ::: "memory");
        }
    }
    __syncthreads();
}

#ifndef PROBE_PHASE
#define PROBE_PHASE -1
#endif
constexpr int LDS_BYTES = 159744;
constexpr int LDS_MISC = 159744 - 256;
struct Args { const float* in[18]; float* out; unsigned char* ws; int ph_lo, ph_hi; };
enum { I_X = 0, I_MEM, I_WIN, I_WPOOL, I_PSCALE, I_WOUT, I_LN1G, I_LN1B, I_WXQ, I_WXKV, I_WXO, I_LN2G, I_LN2B, I_WGATE, I_WUP, I_WDOWN, I_LN3G, I_LN3B };
constexpr int N_PHASES = 13;

struct Ctx {
    const float* const* in; LAS unsigned char* lds; unsigned char* ws; float* H;
    int tid, lane, wave, G, bx, vcu, gw, NGW;
};
#define WSP(T, off) ((T*)(c.ws + (off)))

template <int PH> __device__ __forceinline__ void run_phase(const Ctx& c) {
    const int lane = c.lane, wave = c.wave, G = c.G, bx = c.bx, vcu = c.vcu, gw = c.gw, NGW = c.NGW, tid = c.tid;
    LAS unsigned char* lds = c.lds;
    float* KM = WSP(float, WS_KM);
    bf16_t* Win_t = WSP(bf16_t, WS_WIN); bf16_t* Wout_t = WSP(bf16_t, WS_WOUT); bf16_t* Wxq_t = WSP(bf16_t, WS_WXQ); bf16_t* Wxkv_t = WSP(bf16_t, WS_WXKV);
    bf16_t* Wxo_t = WSP(bf16_t, WS_WXO); bf16_t* Wgu_t = WSP(bf16_t, WS_WGU); bf16_t* Wdn_t = WSP(bf16_t, WS_WDN); bf16_t* Wpool_t = WSP(bf16_t, WS_WPOOL);
    bf16_t* MEMB = WSP(bf16_t, WS_MEMB); bf16_t* MEMKV = WSP(bf16_t, WS_MEMKV);
    bf16_t* XB = WSP(bf16_t, WS_XB); bf16_t* Z = WSP(bf16_t, WS_Z); bf16_t* MIX = WSP(bf16_t, WS_MIX); bf16_t* HF = WSP(bf16_t, WS_HF);
    bf16_t* XQ = MIX; bf16_t* XO = Z;
    float* H = c.H; float* PST1 = WSP(float, WS_PST1); float* PST2 = WSP(float, WS_PST2);
    if constexpr (PH == 0) {
        if (bx < 208) {
            const float* W; int N, n0, mode; const float* gg; const float* bb; float* cd; int cdn;
            if (bx < 32) { W = c.in[I_WXQ]; N = DM; n0 = 32 * bx; mode = 0; gg = c.in[I_LN1G]; bb = c.in[I_LN1B]; cd = WSP(float, WS_CDX); cdn = DM; }
            else if (bx < 120) { W = c.in[I_WGATE]; N = DFF; n0 = 32 * (bx - 32); mode = 1; gg = c.in[I_LN2G]; bb = c.in[I_LN2B]; cd = WSP(float, WS_CDG); cdn = 2 * DFF; }
            else { W = c.in[I_WUP]; N = DFF; n0 = 32 * (bx - 120); mode = 2; gg = c.in[I_LN2G]; bb = c.in[I_LN2B]; cd = WSP(float, WS_CDG); cdn = 2 * DFF; }
            const int col = n0 + (lane & 31), kbeg = wave * 128 + (lane >> 5) * 64;
            float cs = 0.f, ds = 0.f;
#pragma unroll 8
            for (int k = kbeg; k < kbeg + 64; ++k) { const float wv = W[(size_t)k * N + col]; cs += gg[k] * wv; ds += bb[k] * wv; }
            cs += __shfl_xor(cs, 32); ds += __shfl_xor(ds, 32);
            LAS float* red = (LAS float*)(lds + 131072);
            if (lane < 32) { red[(wave * 32 + lane) * 2] = cs; red[(wave * 32 + lane) * 2 + 1] = ds; }
            __syncthreads();
            if (tid < 32) { float ct = 0.f, dt = 0.f;
#pragma unroll
                for (int w8 = 0; w8 < 8; ++w8) { ct += red[(w8 * 32 + tid) * 2]; dt += red[(w8 * 32 + tid) * 2 + 1]; }
                const int oi = (mode == 0) ? col : (32 * (col >> 4) + (col & 15) + (mode == 2 ? 16 : 0));
                cd[oi] = ct; cd[cdn + oi] = dt; }
        }
        LAS float* scr = (LAS float*)(lds + wave * 16384);
        constexpr int I_IN = (DM / 64) * (INW / 32), I_SQ = (DM / 64) * (DM / 32), I_KV = (DM / 64) * (2048 / 32), I_GU = (DM / 64) * (DFF / 32), I_DN = (DFF / 64) * (DM / 32), I_PL = 2 * 4;
        constexpr int NITEMS = I_IN + 3 * I_SQ + I_KV + 2 * I_GU + I_DN + 4 * I_PL;
        for (int it = gw; it < NITEMS; it += NGW) {
            int r = it;
            if (r < I_IN) { p0_transpose_item(c.in[I_WIN], DM, INW, Win_t, 0, scr, r, lane); continue; } r -= I_IN;
            if (r < I_SQ) { if (r >= 8 * (DM / 32)) p0_transpose_item(c.in[I_WOUT], DM, DM, Wout_t, 0, scr, r, lane); continue; } r -= I_SQ;
            if (r < I_SQ) { continue; } r -= I_SQ;
            if (r < I_SQ) { p0_transpose_item(c.in[I_WXO], DM, DM, Wxo_t, 0, scr, r, lane); continue; } r -= I_SQ;
            if (r < I_KV) { p0_transpose_item(c.in[I_WXKV], DM, 2048, Wxkv_t, 0, scr, r, lane); continue; } r -= I_KV;
            if (r < I_GU) { p0_transpose_item(c.in[I_WGATE], DM, DFF, Wgu_t, 1, scr, r, lane, c.in[I_LN2G]); continue; } r -= I_GU;
            if (r < I_GU) { p0_transpose_item(c.in[I_WUP], DM, DFF, Wgu_t, 2, scr, r, lane, c.in[I_LN2G]); continue; } r -= I_GU;
            if (r < I_DN) { p0_transpose_item(c.in[I_WDOWN], DFF, DM, Wdn_t, 0, scr, r, lane); continue; } r -= I_DN;
            { const int gidx = r / I_PL; p0_transpose_item(c.in[I_WPOOL] + gidx * 16384, 128, 128, Wpool_t + gidx * 16384, 0, scr, r % I_PL, lane); }
        }
        const size_t gtid = (size_t)vcu * 512 + tid, nthr = (size_t)G * 512;
        for (size_t idx = gtid; idx < (size_t)512 * DM; idx += nthr) {
            const int n = (int)(idx & (DM - 1)), k = (int)(idx >> 10), gidx = k >> 7;
            const float* wp = c.in[I_WPOOL] + (size_t)k * 128;
            const float* ps = c.in[I_PSCALE] + gidx * 128;
            const float* wo = c.in[I_WOUT] + (size_t)(gidx * 128) * DM + n;
            float a = 0.f;
#pragma unroll 8
            for (int d = 0; d < 128; ++d) a += wp[d] * ps[d] * wo[(size_t)d * DM];
            const unsigned pk = cvt_pk_bf16(a, 0.f);
            Wout_t[(size_t)n * DM + k] = (bf16_t)(pk & 0xffffu);
        }
        for (size_t i8 = gtid; i8 < (size_t)DM * DM / 8; i8 += nthr) {
            const float gsc = c.in[I_LN1G][(i8 * 8) >> 10]; const f32x4 a = *(const f32x4*)(c.in[I_WXQ] + i8 * 8) * gsc, b4 = *(const f32x4*)(c.in[I_WXQ] + i8 * 8 + 4) * gsc;
            u32x4 o; o.x = cvt_pk_bf16(a[0], a[1]); o.y = cvt_pk_bf16(a[2], a[3]); o.z = cvt_pk_bf16(b4[0], b4[1]); o.w = cvt_pk_bf16(b4[2], b4[3]); *(u32x4*)(Wxq_t + i8 * 8) = o; }
        for (size_t i4 = gtid; i4 < (size_t)BATCH * 8 * NBLK * 64 / 4; i4 += nthr) *((f32x4*)KM + i4) = (f32x4){0.f, 0.f, 0.f, 0.f};
        cvt_rows_bf16(c.in[I_X], XB, (size_t)TOK * DM / 8, gtid, nthr);
        cvt_rows_bf16(c.in[I_MEM], MEMB, (size_t)MEMROWS * DM / 8, gtid, nthr);
    }
    if constexpr (PH == 1) {
        { pg8::Gemm g{XB, Win_t, TOK, INW, DM}; pg8::StaticOrder S; S.init(TOK, INW, G, bx); pg8::EpiBf16 E{Z, INW, KM}; pg8::gemm_phase(lds, g, S, E); }
        { pg8::Gemm g{MEMB, Wxkv_t, MEMROWS, 2048, DM}; pg8::StaticOrder S; S.init(MEMROWS, 2048, G, bx); pg8::EpiBf16 E{MEMKV, 2048}; pg8::gemm_phase(lds, g, S, E); }
    }
    if constexpr (PH == 2) {
        for (int run = gw; run < TOK / 32; run += NGW) {
            const int wdw = 2 << (lane >> 4);
            const size_t t0 = (size_t)run * 32; const int tpos0 = (int)(t0 & (SEQ - 1));
            const bf16_t* up = Z + t0 * INW + lane * 8;
            bf16_t* op = MIX + t0 * DM + lane * 8;
            float sacc[8] = {0.f, 0.f, 0.f, 0.f, 0.f, 0.f, 0.f, 0.f};
#pragma unroll 1
            for (int ib = 1; ib <= 16; ib += 8) { bf16x8 ui[8]; bool ok[8];
#pragma unroll
                for (int q = 0; q < 8; ++q) { const int i = ib + q; ok[q] = (i <= wdw && tpos0 - i >= 0); ui[q] = *(const bf16x8*)(up - (size_t)(ok[q] ? i : 0) * INW); }
#pragma unroll
                for (int q = 0; q < 8; ++q) if (ok[q]) {
#pragma unroll
                    for (int e8 = 0; e8 < 8; ++e8) sacc[e8] += bf2f((unsigned short)ui[q][e8]); } }
#pragma unroll 1
            for (int tb = 0; tb < 32; tb += 8) {
                bf16x8 un[8], uo[8];
#pragma unroll
                for (int i = 0; i < 8; ++i) { un[i] = *(const bf16x8*)(up + (size_t)(tb + i) * INW);
                    const int told = tpos0 + tb + i - wdw; uo[i] = *(const bf16x8*)(up + (size_t)(tb + i - (told >= 0 ? wdw : 0)) * INW); }
#pragma unroll
                for (int i = 0; i < 8; ++i) { const int tpos = tpos0 + tb + i; const bool sub = tpos - wdw >= 0;
                    const float rc = 1.0f / (float)((tpos + 1 < wdw) ? tpos + 1 : wdw); float p[8];
#pragma unroll
                    for (int e8 = 0; e8 < 8; ++e8) { const float uv = bf2f((unsigned short)un[i][e8]); sacc[e8] += uv; if (sub) sacc[e8] -= bf2f((unsigned short)uo[i][e8]); p[e8] = sacc[e8] * rc - uv; }
                    u32x4 pw; pw.x = cvt_pk_bf16(p[0], p[1]); pw.y = cvt_pk_bf16(p[2], p[3]); pw.z = cvt_pk_bf16(p[4], p[5]); pw.w = cvt_pk_bf16(p[6], p[7]);
                    *(u32x4*)(op + (size_t)(tb + i) * DM) = pw; }
            }
        }
    }
    if constexpr (PH == 2) {
        bf16_t* BtM = WSP(bf16_t, WS_BTM); bf16_t* BtN = WSP(bf16_t, WS_BTN); float* CB = WSP(float, WS_CDB); float* DB = CB + 16 * 1024;
        { pg8::Gemm g{MEMKV, Wxq_t, 64 * 256, 1024, 256, 2048, 1024, 2}; pg8::StaticOrder S; S.init(64 * 256, 1024, G, bx); pg8::EpiPrep E{BtM, 0.0625f, 0}; pg8::gemm_phase(lds, g, S, E); }
        { pg8::Gemm g{Wxo_t, MEMKV + 1024, 64 * 256, 1024, 256, 1024, 2048, 3}; pg8::StaticOrder S; S.init(64 * 256, 1024, G, bx); pg8::EpiPrep E{BtN, 1.0f, 1}; pg8::gemm_phase(lds, g, S, E); }
        const float* cx = WSP(float, WS_CDX); const float* dx = cx + DM;
        for (int o8 = vcu * 512 + tid; o8 < 16 * 1024 * 8; o8 += G * 512) {
            const int o = o8 >> 3, part = o8 & 7;
            const int bt = o >> 10, hm = o & 1023, hh = hm >> 8, mm = hm & 255;
            const bf16_t* kr = MEMKV + (size_t)(bt * 256 + mm) * 2048 + hh * 256; float ca = 0.f, da = 0.f;
#pragma unroll
            for (int it = 0; it < 4; ++it) { const int d8 = part + 8 * it; const bf16x8 kv = *(const bf16x8*)(kr + d8 * 8);
                const f32x4 c0 = *(const f32x4*)(cx + hh * 256 + d8 * 8), c1 = *(const f32x4*)(cx + hh * 256 + d8 * 8 + 4), d0 = *(const f32x4*)(dx + hh * 256 + d8 * 8), d1 = *(const f32x4*)(dx + hh * 256 + d8 * 8 + 4);
#pragma unroll
                for (int e8 = 0; e8 < 8; ++e8) { const float kf = bf2f((unsigned short)kv[e8]); ca += (e8 < 4 ? c0[e8 & 3] : c1[e8 & 3]) * kf; da += (e8 < 4 ? d0[e8 & 3] : d1[e8 & 3]) * kf; } }
            ca += __shfl_xor(ca, 1); ca += __shfl_xor(ca, 2); ca += __shfl_xor(ca, 4); da += __shfl_xor(da, 1); da += __shfl_xor(da, 2); da += __shfl_xor(da, 4);
            if (part == 0) { CB[o] = ca * 0.0625f; DB[o] = da * 0.0625f; }
        }
    }
    if constexpr (PH == 3) {
        for (int it = 0; it * G < BATCH * 8 * NBLK; ++it) {
            const int u = it * G + vcu; if (u >= BATCH * 8 * NBLK) break;
            int bh = u >> 4, blk = u & 15;
            if (G == 256) { bh = it * 16 + (vcu >> 4); blk = ((vcu & 15) + 2 * it) & 15; }
            moba_unit(bh >> 3, bh & 7, blk, Z, KM, MIX, lds);
        }
    }
    if constexpr (PH == 4) { pg8::Gemm g{MIX, Wout_t, TOK, DM, DM}; pg8::StaticOrder S; S.init(TOK, DM, G, bx); pg8::EpiResStat<false, true> E{XB, XB, DM, ALPHA, nullptr, nullptr, nullptr, PST1}; pg8::gemm_phase(lds, g, S, E); }
    if constexpr (PH == 5) { }
    if constexpr (PH == 6) { pg8::Gemm g{XB, WSP(bf16_t, WS_BTM), TOK, DM, DM, 0, 0, 1, (size_t)DM * DM * 2}; pg8::StaticOrder S; S.init(TOK, DM, G, bx); pg8::EpiSoftmaxP E{XQ, PST1, WSP(float, WS_CDB), WSP(float, WS_CDB) + 16 * 1024, (LAS float*)(lds + 131072)}; pg8::gemm_phase(lds, g, S, E); }
    if constexpr (PH == 7) { for (int u = vcu; u < (TOK / 128) * 4; u += G) xattn_unit(u >> 2, u & 3, XQ, MEMKV, XO, lds); }
    if constexpr (PH == 8) { pg8::Gemm g{XQ, WSP(bf16_t, WS_BTN), TOK, DM, DM, 0, 0, 1, (size_t)DM * DM * 2}; pg8::StaticOrder S; S.init(TOK, DM, G, bx); pg8::EpiResStat<true, true> E{XB, XB, DM, ALPHA, PST1, c.in[I_LN1G], c.in[I_LN1B], PST2}; pg8::gemm_phase(lds, g, S, E); }
    if constexpr (PH == 9) { }
    if constexpr (PH == 10) { pg8::Gemm g{XB, Wgu_t, TOK, 2 * DFF, DM}; pg8::StaticOrder S; S.init(TOK, 2 * DFF, G, bx); pg8::EpiLnSwiGLU E{HF, DFF, PST2, WSP(float, WS_CDG), WSP(float, WS_CDG) + 2 * DFF}; pg8::gemm_phase(lds, g, S, E); }
    if constexpr (PH == 11) { pg8::Gemm g{HF, Wdn_t, TOK, DM, DFF}; pg8::StaticOrder S; S.init(TOK, DM, G, bx); pg8::EpiResStat<true, false> E{XB, XB, DM, ALPHA, PST2, c.in[I_LN2G], c.in[I_LN2B], nullptr}; pg8::gemm_phase(lds, g, S, E); }
    if constexpr (PH == 12) { for (int r = gw * 4; r < TOK; r += NGW * 4) ln_rows4_bf16in(XB + (size_t)r * DM, c.in[I_LN3G], c.in[I_LN3B], H + (size_t)r * DM, DM, lane); }
}

__global__ void __launch_bounds__(512, 2) fwd_kernel(Args args) {
    extern __shared__ __attribute__((aligned(16))) unsigned char lds_raw[];
    Ctx c;
    c.in = args.in; c.lds = (LAS unsigned char*)lds_raw; c.ws = args.ws; c.H = args.out;
    c.tid = threadIdx.x; c.lane = c.tid & 63; c.wave = __builtin_amdgcn_readfirstlane(c.tid >> 6);
    c.G = gridDim.x; c.bx = blockIdx.x;
    c.vcu = (c.G % 8 == 0) ? (c.bx % 8) * (c.G / 8) + c.bx / 8 : c.bx;
    c.gw = c.vcu * 8 + c.wave; c.NGW = c.G * 8;
    const int lo = args.ph_lo, hi = args.ph_hi;
    volatile LAS unsigned* MISC = (volatile LAS unsigned*)(c.lds + LDS_MISC);
    if (c.tid < 2) MISC[c.tid] = 0u;
    __syncthreads();
    XcdBarrier bar; bar.bar = (unsigned*)(args.ws + WS_CTL); bar.x = 0; bar.st = MISC;
    if (hi - lo > 1) bar = xcd_barrier_post((unsigned*)(args.ws + WS_CTL), MISC);
    if (hi < 0) cg::this_grid().sync();
#define IN(k) (lo <= (k) && (k) < hi)
#define PHASE(k) do { if (IN(k)) { run_phase<k>(c); if (PROBE_PHASE == (k)) { xcd_barrier(bar); run_phase<k>(c); } } \
        if (IN(k) && IN((k) + 1)) { xcd_barrier(bar); } } while (0)
    PHASE(0); PHASE(1);
    if (IN(3)) run_phase<3>(c);
    __syncthreads();
    if (IN(2)) run_phase<2>(c);
    if (IN(3) && IN(4)) xcd_barrier(bar);
    PHASE(4); PHASE(6); PHASE(8); PHASE(10); PHASE(11); PHASE(12);
#undef IN
#undef PHASE
}

extern "C" void kernel_launch(void* const* d_in, const int* in_sizes, int n_in, void* d_out, int out_size, void* d_ws, size_t ws_size, hipStream_t stream) {
    static int grid = 0;
    if (grid == 0) {
        if (n_in != 18 || out_size != TOK * DM || ws_size < WS_END) { fprintf(stderr, "kernel_launch: unexpected shapes (n_in %d, out %d, ws %zu)\n", n_in, out_size, ws_size); grid = -1; return; }
        int dev = 0, cus = 0, per_cu = 0;
        (void)hipGetDevice(&dev); (void)hipDeviceGetAttribute(&cus, hipDeviceAttributeMultiprocessorCount, dev);
        if (hipFuncSetAttribute((const void*)fwd_kernel, hipFuncAttributeMaxDynamicSharedMemorySize, LDS_BYTES) != hipSuccess) { fprintf(stderr, "kernel_launch: hipFuncSetAttribute failed\n"); grid = -1; return; }
        if (hipOccupancyMaxActiveBlocksPerMultiprocessor(&per_cu, (const void*)fwd_kernel, 512, LDS_BYTES) != hipSuccess || per_cu < 1) { fprintf(stderr, "kernel_launch: occupancy query says %d\n", per_cu); per_cu = 1; }
        (void)hipGetLastError();
        grid = cus * 1;
        if (grid <= 0) grid = 256;
    }
    if (grid < 0) return;
    Args a{};
    for (int i = 0; i < 18; ++i) a.in[i] = (const float*)d_in[i];
    a.out = (float*)d_out; a.ws = (unsigned char*)d_ws;
#if N_LAUNCH_MODE == 1
    for (int p = 0; p < N_PHASES; ++p) { a.ph_lo = p; a.ph_hi = p + 1; hipLaunchKernelGGL(fwd_kernel, dim3(grid), dim3(512), LDS_BYTES, stream, a); }
#else
    a.ph_lo = 0; a.ph_hi = N_PHASES;
    (void)hipMemsetAsync((unsigned char*)d_ws + WS_CTL, 0, CTL_BYTES, stream);
    void* kargs[] = {&a};
    hipError_t e = hipLaunchCooperativeKernel((const void*)fwd_kernel, dim3(grid), dim3(512), kargs, LDS_BYTES, stream);
    if (e != hipSuccess) fprintf(stderr, "kernel_launch: cooperative launch failed: %s (grid %d)\n", hipGetErrorString(e), grid);
#endif
}
```

```cpp
#include <hip/hip_runtime.h>
#include <hip/hip_cooperative_groups.h>
#include <cstdio>
#include <cstdint>
namespace cg = cooperative_groups;

#ifndef N_LAUNCH_MODE
#define N_LAUNCH_MODE 0
#endif

#define LAS __attribute__((address_space(3)))
typedef unsigned short bf16_t;
typedef short bf16x8 __attribute__((ext_vector_type(8)));
typedef short s16x4 __attribute__((ext_vector_type(4)));
typedef float f32x4 __attribute__((ext_vector_type(4)));
typedef float f32x2 __attribute__((ext_vector_type(2)));
typedef unsigned u32x4 __attribute__((ext_vector_type(4)));
typedef unsigned u32x2 __attribute__((ext_vector_type(2)));

constexpr int BATCH = 16, SEQ = 4096, DM = 1024, TOK = BATCH * SEQ;
constexpr int MEMLEN = 256, MEMROWS = BATCH * MEMLEN;
constexpr int INW = 2048, DFF = 2816, NBLK = SEQ / 256;
constexpr float ALPHA = 1.189207115002721f;
constexpr float LN_EPS = 1e-5f;
constexpr float LOG2E = 1.4426950408889634f;

constexpr size_t MiB = 1u << 20;
constexpr size_t WS_KM = 0;
constexpr size_t WS_CTL = 1 * MiB, CTL_BYTES = 16384;
constexpr size_t WS_WIN = 2 * MiB, WS_WOUT = 6 * MiB, WS_WXQ = 8 * MiB, WS_WXKV = 10 * MiB, WS_WXO = 14 * MiB, WS_WGU = 16 * MiB, WS_WDN = 27 * MiB, WS_WPOOL = 33 * MiB;
constexpr size_t WS_MEMB = 34 * MiB, WS_MEMKV = 42 * MiB;
constexpr size_t WS_XB = 64 * MiB;
constexpr size_t WS_Z = 192 * MiB;
constexpr size_t WS_MIX = 448 * MiB;
constexpr size_t WS_HF = 192 * MiB;
constexpr size_t WS_PST1 = 576 * MiB, WS_PST2 = 584 * MiB;
constexpr size_t WS_CDX = 60 * MiB, WS_CDG = 60 * MiB + 65536;
constexpr size_t WS_CDB = 60 * MiB + 131072;
constexpr size_t WS_BTM = 592 * MiB, WS_BTN = 624 * MiB;
constexpr size_t WS_END = 656 * MiB;

typedef __bf16 bf16x2_t __attribute__((ext_vector_type(2)));
__device__ __forceinline__ unsigned cvt_pk_bf16(float lo, float hi) { f32x2 v = {lo, hi}; bf16x2_t b = __builtin_convertvector(v, bf16x2_t); return __builtin_bit_cast(unsigned, b); }
__device__ __forceinline__ float xmax16(float v) { auto r = __builtin_amdgcn_permlane16_swap(__float_as_uint(v), __float_as_uint(v), false, false); return fmaxf(__uint_as_float(r[0]), __uint_as_float(r[1])); }
__device__ __forceinline__ float xmax32(float v) { auto r = __builtin_amdgcn_permlane32_swap(__float_as_uint(v), __float_as_uint(v), false, false); return fmaxf(__uint_as_float(r[0]), __uint_as_float(r[1])); }
__device__ __forceinline__ float xsum16(float v) { auto r = __builtin_amdgcn_permlane16_swap(__float_as_uint(v), __float_as_uint(v), false, false); return __uint_as_float(r[0]) + __uint_as_float(r[1]); }
__device__ __forceinline__ float xsum32(float v) { auto r = __builtin_amdgcn_permlane32_swap(__float_as_uint(v), __float_as_uint(v), false, false); return __uint_as_float(r[0]) + __uint_as_float(r[1]); }
__device__ __forceinline__ float bf2f(unsigned short b) { return __uint_as_float(((unsigned)b) << 16); }
__device__ __forceinline__ float wave_sum(float v) {
#pragma unroll
    for (int o = 1; o < 64; o <<= 1) v += __shfl_xor(v, o);
    return v;
}

namespace pg8 {
constexpr int BM = 256, BK = 64, HALF = 128, HTB = HALF * BK * 2, STAGE_BYTES = 8 * HTB, NXCD = 8, WGM = 4;
__host__ __device__ __forceinline__ int lds_byte(int r, int c) { const int st = (r >> 4) * 2 + (c >> 5), rr = r & 15, cc = c & 31, ob = rr * 64 + cc * 2; return st * 1024 + (ob ^ (((ob >> 9) & 1) << 5)); }
__host__ __device__ __forceinline__ void stage_rc(int b, int& R, int& C) { const int st = b / 1024, sb = b % 1024, swz = sb ^ (((sb >> 9) & 1) << 5); R = (st >> 1) * 16 + swz / 64; C = (st & 1) * 32 + (swz % 64) / 2; }
__host__ __device__ __forceinline__ int perm32(int rho) { const int n = rho >> 4, i = rho & 15; return 8 * (i >> 2) + 4 * n + (i & 3); }

struct Unit { int pm, pn; };
struct Gemm { const bf16_t* A; const bf16_t* Bt; int M, N, K; int lda = 0, ldb = 0, mode = 0; size_t s1 = 0; };
__device__ __forceinline__ void unit_ptrs(const Gemm& g, const Unit& u, const char*& cA, const char*& cB) {
    const int lda = g.lda ? g.lda : g.K, ldb = g.ldb ? g.ldb : g.K;
    if (g.mode <= 1) { cA = (const char*)g.A + (size_t)u.pm * BM * lda * 2; cB = (const char*)g.Bt + (size_t)u.pn * BM * ldb * 2 + (g.mode == 1 ? (size_t)(u.pm >> 4) * g.s1 : 0); }
    else if (g.mode == 2) { cA = (const char*)g.A + (size_t)(u.pm >> 2) * 256 * lda * 2 + (size_t)(u.pm & 3) * 512; cB = (const char*)g.Bt + (size_t)u.pn * BM * ldb * 2 + (size_t)(u.pm & 3) * 512; }
    else { cA = (const char*)g.A + (size_t)u.pn * BM * lda * 2 + (size_t)(u.pm & 3) * 512; cB = (const char*)g.Bt + (size_t)(u.pm >> 2) * 256 * ldb * 2 + (size_t)(u.pm & 3) * 512; }
}

struct StaticOrder {
    int nM, nN, nwg, G, c, rev;
    __device__ void init(int M, int N, int G_, int c_, int rev_ = 0) { nM = M / BM; nN = N / BM; nwg = nM * nN; G = G_; c = c_; rev = rev_; }
    __device__ bool next(int i, Unit& u) const {
        const long L = (long)i * G + c; if (L >= nwg) return false;
        int wgid = (int)L; { const int q = nwg / NXCD, r = nwg % NXCD, xcd = wgid % NXCD; int off = wgid / NXCD; if (rev && r == 0) off = q - 1 - off; wgid = (xcd < r ? xcd * (q + 1) : r * (q + 1) + (xcd - r) * q) + off; }
        const int nig = WGM * nN, gid = wgid / nig, fm = gid * WGM, gsz = (nM - fm) < WGM ? (nM - fm) : WGM;
        u.pm = fm + ((wgid % nig) % gsz); u.pn = (wgid % nig) / gsz; return true;
    }
};

struct EpiBf16 {
    static constexpr bool PERM = true;
    bf16_t* O; int ldc; float* km = nullptr;
    __device__ __forceinline__ void operator()(const f32x4 (&acc)[2][2][4][2], const Unit& u, int wr, int wc, int fr, int fq) const {
        const int row0 = u.pm * BM + wr * 64 + fr; const int col0 = u.pn * BM + wc * 32 + 8 * fq;
#pragma unroll
        for (int ai = 0; ai < 2; ++ai)
#pragma unroll
            for (int m = 0; m < 4; ++m) { bf16_t* rowp = O + (size_t)(row0 + ai * HALF + m * 16) * ldc + col0;
#pragma unroll
                for (int bj = 0; bj < 2; ++bj) { const f32x4 v0 = acc[ai][bj][m][0], v1 = acc[ai][bj][m][1];
                    u32x4 w; w.x = cvt_pk_bf16(v0[0], v0[1]); w.y = cvt_pk_bf16(v0[2], v0[3]); w.z = cvt_pk_bf16(v1[0], v1[1]); w.w = cvt_pk_bf16(v1[2], v1[3]);
                    *(u32x4*)(rowp + bj * HALF) = w; } }
        if (km && (u.pn == 4 || u.pn == 5)) {
#pragma unroll
            for (int bj = 0; bj < 2; ++bj)
#pragma unroll
                for (int n = 0; n < 2; ++n) { f32x4 cs = (f32x4){0.f, 0.f, 0.f, 0.f};
#pragma unroll
                    for (int ai = 0; ai < 2; ++ai)
#pragma unroll
                        for (int m = 0; m < 4; ++m) cs = cs + acc[ai][bj][m][n];
#pragma unroll
                    for (int j = 0; j < 4; ++j) { float v = cs[j]; v += __shfl_xor(v, 1); v += __shfl_xor(v, 2); v += __shfl_xor(v, 4); v += __shfl_xor(v, 8);
                        if (fr == 0) { const int kc = (u.pn - 4) * 256 + bj * HALF + wc * 32 + 8 * fq + 4 * n + j;
                            __hip_atomic_fetch_add(km + (size_t)(((u.pm >> 4) * 8 + (kc >> 6)) * 16 + (u.pm & 15)) * 64 + (kc & 63), v * (1.0f / 256.0f), __ATOMIC_RELAXED, __HIP_MEMORY_SCOPE_AGENT); } } }
        }
    }
};
__device__ __forceinline__ void row_stats(const float* pst, int row, int fq, float& mu, float& rstd) {
    const f32x4 a = *(const f32x4*)(pst + (size_t)row * 32 + 8 * fq), b = *(const f32x4*)(pst + (size_t)row * 32 + 8 * fq + 4);
    float s1 = (a[0] + a[2]) + (b[0] + b[2]), s2 = (a[1] + a[3]) + (b[1] + b[3]);
    s1 = xsum32(xsum16(s1)); s2 = xsum32(xsum16(s2));
    mu = s1 * (1.0f / 1024.0f); const float var = s2 * (1.0f / 1024.0f) - mu * mu; rstd = 1.0f / sqrtf(var + LN_EPS);
}
template <bool HAS_LN, bool HAS_OUT> struct EpiResStat {
    static constexpr bool PERM = true;
    const bf16_t* R; bf16_t* YB; int ldc; float alpha; const float* st_in; const float* g; const float* b; float* st_out;
    __device__ __forceinline__ void operator()(const f32x4 (&acc)[2][2][4][2], const Unit& u, int wr, int wc, int fr, int fq) const {
        const int row0 = u.pm * BM + wr * 64 + fr; const int col0 = u.pn * BM + wc * 32 + 8 * fq;
        f32x4 gv[2][2], bv[2][2];
        if (HAS_LN) {
#pragma unroll
            for (int bj = 0; bj < 2; ++bj)
#pragma unroll
                for (int n = 0; n < 2; ++n) { gv[bj][n] = *(const f32x4*)(g + col0 + bj * HALF + 4 * n); bv[bj][n] = *(const f32x4*)(b + col0 + bj * HALF + 4 * n); }
        }
#pragma unroll
        for (int ai = 0; ai < 2; ++ai)
#pragma unroll
            for (int m = 0; m < 4; ++m) { const int row = row0 + ai * HALF + m * 16; const size_t off = (size_t)row * ldc + col0;
                float mu = 0.f, rs = 1.f; if (HAS_LN) row_stats(st_in, row, fq, mu, rs);
                float s1 = 0.f, s2 = 0.f;
#pragma unroll
                for (int bj = 0; bj < 2; ++bj) { const u32x4 rr = *(const u32x4*)(R + off + bj * HALF);
                    f32x4 v0 = (f32x4){__uint_as_float(rr.x << 16), __uint_as_float(rr.x & 0xffff0000u), __uint_as_float(rr.y << 16), __uint_as_float(rr.y & 0xffff0000u)};
                    f32x4 v1 = (f32x4){__uint_as_float(rr.z << 16), __uint_as_float(rr.z & 0xffff0000u), __uint_as_float(rr.w << 16), __uint_as_float(rr.w & 0xffff0000u)};
                    if (HAS_LN) { v0 = (v0 - mu) * rs * gv[bj][0] + bv[bj][0]; v1 = (v1 - mu) * rs * gv[bj][1] + bv[bj][1]; }
                    const f32x4 y0 = v0 * alpha + acc[ai][bj][m][0], y1 = v1 * alpha + acc[ai][bj][m][1];
                    u32x4 w; w.x = cvt_pk_bf16(y0[0], y0[1]); w.y = cvt_pk_bf16(y0[2], y0[3]); w.z = cvt_pk_bf16(y1[0], y1[1]); w.w = cvt_pk_bf16(y1[2], y1[3]);
                    *(u32x4*)(YB + off + bj * HALF) = w;
                    s1 += ((y0[0] + y0[1]) + (y0[2] + y0[3])) + ((y1[0] + y1[1]) + (y1[2] + y1[3]));
                    s2 += ((y0[0] * y0[0] + y0[1] * y0[1]) + (y0[2] * y0[2] + y0[3] * y0[3])) + ((y1[0] * y1[0] + y1[1] * y1[1]) + (y1[2] * y1[2] + y1[3] * y1[3])); }
                if (HAS_OUT) { s1 = xsum32(xsum16(s1)); s2 = xsum32(xsum16(s2));
                    if (fq == 0) *(f32x2*)(st_out + (size_t)row * 32 + (u.pn * 4 + wc) * 2) = (f32x2){s1, s2}; } }
    }
};
struct EpiLnBf16 {
    static constexpr bool PERM = true;
    bf16_t* O; int ldc; const float* st_in; const float* cvec; const float* dvec;
    __device__ __forceinline__ void operator()(const f32x4 (&acc)[2][2][4][2], const Unit& u, int wr, int wc, int fr, int fq) const {
        const int row0 = u.pm * BM + wr * 64 + fr; const int col0 = u.pn * BM + wc * 32 + 8 * fq;
        f32x4 cv[2][2], dv[2][2];
#pragma unroll
        for (int bj = 0; bj < 2; ++bj)
#pragma unroll
            for (int n = 0; n < 2; ++n) { cv[bj][n] = *(const f32x4*)(cvec + col0 + bj * HALF + 4 * n); dv[bj][n] = *(const f32x4*)(dvec + col0 + bj * HALF + 4 * n); }
#pragma unroll
        for (int ai = 0; ai < 2; ++ai)
#pragma unroll
            for (int m = 0; m < 4; ++m) { const int row = row0 + ai * HALF + m * 16; bf16_t* rowp = O + (size_t)row * ldc + col0;
                float mu, rs; row_stats(st_in, row, fq, mu, rs);
#pragma unroll
                for (int bj = 0; bj < 2; ++bj) { const f32x4 v0 = (acc[ai][bj][m][0] - cv[bj][0] * mu) * rs + dv[bj][0], v1 = (acc[ai][bj][m][1] - cv[bj][1] * mu) * rs + dv[bj][1];
                    u32x4 w; w.x = cvt_pk_bf16(v0[0], v0[1]); w.y = cvt_pk_bf16(v0[2], v0[3]); w.z = cvt_pk_bf16(v1[0], v1[1]); w.w = cvt_pk_bf16(v1[2], v1[3]);
                    *(u32x4*)(rowp + bj * HALF) = w; } }
    }
};
struct EpiLnSwiGLU {
    static constexpr bool PERM = false;
    bf16_t* O; int ldc; const float* st_in; const float* cvec; const float* dvec;
    __device__ __forceinline__ void operator()(const f32x4 (&acc)[2][2][4][2], const Unit& u, int wr, int wc, int fr, int fq) const {
        const int row0 = u.pm * BM + wr * 64 + fr; const int col0 = u.pn * HALF + wc * 16 + 4 * fq; const int gcol0 = u.pn * BM + wc * 32 + 4 * fq;
        f32x4 cv[2][2], dv[2][2];
#pragma unroll
        for (int bj = 0; bj < 2; ++bj)
#pragma unroll
            for (int n = 0; n < 2; ++n) { cv[bj][n] = *(const f32x4*)(cvec + gcol0 + bj * HALF + 16 * n); dv[bj][n] = *(const f32x4*)(dvec + gcol0 + bj * HALF + 16 * n); }
#pragma unroll
        for (int ai = 0; ai < 2; ++ai)
#pragma unroll
            for (int m = 0; m < 4; ++m) { const int row = row0 + ai * HALF + m * 16; bf16_t* rowp = O + (size_t)row * ldc + col0;
                float mu, rs; row_stats(st_in, row, fq, mu, rs);
#pragma unroll
                for (int bj = 0; bj < 2; ++bj) { const f32x4 g = (acc[ai][bj][m][0] - cv[bj][0] * mu) * rs + dv[bj][0], up = (acc[ai][bj][m][1] - cv[bj][1] * mu) * rs + dv[bj][1]; float h[4];
#pragma unroll
                    for (int j = 0; j < 4; ++j) { const float s = g[j] * __builtin_amdgcn_rcpf(1.0f + __builtin_amdgcn_exp2f(-g[j] * LOG2E)); h[j] = s * up[j]; }
                    u32x2 w; w.x = cvt_pk_bf16(h[0], h[1]); w.y = cvt_pk_bf16(h[2], h[3]);
                    *(u32x2*)(rowp + bj * 64) = w; } }
    }
};

struct EpiPrep {
    static constexpr bool PERM = true;
    bf16_t* O; float scale; int omode;
    __device__ __forceinline__ void operator()(const f32x4 (&acc)[2][2][4][2], const Unit& u, int wr, int wc, int fr, int fq) const {
        bf16_t* base = (omode == 0) ? O + (size_t)u.pm * 256 * 1024 + u.pn * 256 : O + (size_t)(u.pm >> 2) * 1048576 + (size_t)u.pn * 256 * 1024 + (u.pm & 3) * 256;
        base += (size_t)(wr * 64 + fr) * 1024 + wc * 32 + 8 * fq;
#pragma unroll
        for (int ai = 0; ai < 2; ++ai)
#pragma unroll
            for (int m = 0; m < 4; ++m) { bf16_t* rowp = base + (size_t)(ai * HALF + m * 16) * 1024;
#pragma unroll
                for (int bj = 0; bj < 2; ++bj) { const f32x4 v0 = acc[ai][bj][m][0] * scale, v1 = acc[ai][bj][m][1] * scale;
                    u32x4 w; w.x = cvt_pk_bf16(v0[0], v0[1]); w.y = cvt_pk_bf16(v0[2], v0[3]); w.z = cvt_pk_bf16(v1[0], v1[1]); w.w = cvt_pk_bf16(v1[2], v1[3]);
                    *(u32x4*)(rowp + bj * HALF) = w; } }
    }
};
struct EpiSoftmaxP {
    static constexpr bool PERM = true;
    bf16_t* P; const float* st_in; const float* cb; const float* db; LAS float* xb;
    __device__ __forceinline__ void operator()(f32x4 (&acc)[2][2][4][2], const Unit& u, int wr, int wc, int fr, int fq) const {
        const int rl0 = wr * 64 + fr; const int col0 = u.pn * BM + wc * 32 + 8 * fq; const int bt = u.pm >> 4;
        {
            f32x4 cv[2][2], dv[2][2];
#pragma unroll
            for (int bj = 0; bj < 2; ++bj)
#pragma unroll
                for (int n = 0; n < 2; ++n) { cv[bj][n] = *(const f32x4*)(cb + bt * 1024 + col0 + bj * HALF + 4 * n); dv[bj][n] = *(const f32x4*)(db + bt * 1024 + col0 + bj * HALF + 4 * n); }
#pragma unroll
            for (int ai = 0; ai < 2; ++ai)
#pragma unroll
                for (int m = 0; m < 4; ++m) { const int rl = rl0 + ai * HALF + m * 16;
                    float mu, rs; row_stats(st_in, u.pm * BM + rl, fq, mu, rs);
                    float mx = -INFINITY;
#pragma unroll
                    for (int bj = 0; bj < 2; ++bj)
#pragma unroll
                        for (int n = 0; n < 2; ++n) { const f32x4 s = (acc[ai][bj][m][n] - cv[bj][n] * mu) * rs + dv[bj][n]; acc[ai][bj][m][n] = s;
                            mx = fmaxf(fmaxf(mx, s[0]), fmaxf(s[1], fmaxf(s[2], s[3]))); }
                    mx = xmax32(xmax16(mx));
                    if (fq == 0) xb[rl * 4 + wc] = mx; }
        }
        asm volatile("s_waitcnt lgkmcnt(0)" ::: "memory"); __builtin_amdgcn_s_barrier(); asm volatile("" ::: "memory");
#pragma unroll
        for (int ai = 0; ai < 2; ++ai)
#pragma unroll
            for (int m = 0; m < 4; ++m) { const int rl = rl0 + ai * HALF + m * 16;
                const f32x4 mm = *(const LAS f32x4*)(xb + rl * 4); const float rmax = fmaxf(fmaxf(mm[0], mm[1]), fmaxf(mm[2], mm[3])) * LOG2E;
                float sm = 0.f;
#pragma unroll
                for (int bj = 0; bj < 2; ++bj)
#pragma unroll
                    for (int n = 0; n < 2; ++n) { f32x4 p;
#pragma unroll
                        for (int j = 0; j < 4; ++j) p[j] = __builtin_amdgcn_exp2f(__builtin_fmaf(acc[ai][bj][m][n][j], LOG2E, -rmax));
                        acc[ai][bj][m][n] = p; sm += (p[0] + p[1]) + (p[2] + p[3]); }
                sm = xsum32(xsum16(sm));
                if (fq == 0) xb[1024 + rl * 4 + wc] = sm; }
        asm volatile("s_waitcnt lgkmcnt(0)" ::: "memory"); __builtin_amdgcn_s_barrier(); asm volatile("" ::: "memory");
#pragma unroll
        for (int ai = 0; ai < 2; ++ai)
#pragma unroll
            for (int m = 0; m < 4; ++m) { const int rl = rl0 + ai * HALF + m * 16;
                const f32x4 ss = *(const LAS f32x4*)(xb + 1024 + rl * 4); const float inv = 1.0f / ((ss[0] + ss[1]) + (ss[2] + ss[3]));
                bf16_t* rowp = P + (size_t)(u.pm * BM + rl) * 1024 + col0;
#pragma unroll
                for (int bj = 0; bj < 2; ++bj) { const f32x4 v0 = acc[ai][bj][m][0] * inv, v1 = acc[ai][bj][m][1] * inv;
                    u32x4 w; w.x = cvt_pk_bf16(v0[0], v0[1]); w.y = cvt_pk_bf16(v0[2], v0[3]); w.z = cvt_pk_bf16(v1[0], v1[1]); w.w = cvt_pk_bf16(v1[2], v1[3]);
                    *(u32x4*)(rowp + bj * HALF) = w; } }
    }
};

template <class Epi, class Sched>
__device__ __forceinline__ void gemm_phase(LAS unsigned char* lds, const Gemm g, const Sched S, const Epi E) {
    const int tid = threadIdx.x, wid = __builtin_amdgcn_readfirstlane(tid >> 6), lane = tid & 63, wr = wid >> 2, wc = wid & 3, fr = lane & 15, fq = lane >> 4;
    const int K = g.K, nt = K / BK;
    const int lda = g.lda ? g.lda : K, ldb = g.ldb ? g.ldb : K;
    unsigned voffA[2], voffB[2];
#pragma unroll
    for (int i = 0; i < 2; ++i) { int R, C; stage_rc(tid * 16 + i * 8192, R, C); const int Rb = Epi::PERM ? ((R & ~31) + perm32(R & 31)) : R;
        voffA[i] = (unsigned)(R * lda + C) * 2u; voffB[i] = (unsigned)(Rb * ldb + C) * 2u; }
    const size_t kstep = (size_t)(BK * 2);
    const size_t hstepA = (size_t)HALF * lda * 2, hstepB = (size_t)HALF * ldb * 2;
    const unsigned ldsw = (unsigned)wid * 1024u;
    const int aoff = lds_byte(wr * 64 + fr, fq * 8), boff = lds_byte(wc * 32 + fr, fq * 8);
#define PG8_SA(b, h) (((b) * 2 + (h)) * HTB)
#define PG8_SB(b, h) ((4 + (b) * 2 + (h)) * HTB)
#define PG8_STAGE(bufoff, gbase, voff) do { _Pragma("unroll") for (int _i = 0; _i < 2; ++_i) \
        __builtin_amdgcn_global_load_lds((const unsigned*)((const char*)(gbase) + (voff)[_i]), (LAS unsigned*)(lds + (bufoff) + ldsw + _i * 8192), 16, 0, 0); } while (0)
#define PG8_LDA(dst, b, h) do { _Pragma("unroll") for (int m = 0; m < 4; ++m) _Pragma("unroll") for (int k = 0; k < 2; ++k) dst[m][k] = *(const LAS bf16x8*)(lds + PG8_SA(b, h) + aoff + m * 2048 + k * 1024); } while (0)
#define PG8_LDB(dst, b, h) do { _Pragma("unroll") for (int n = 0; n < 2; ++n) _Pragma("unroll") for (int k = 0; k < 2; ++k) dst[n][k] = *(const LAS bf16x8*)(lds + PG8_SB(b, h) + boff + n * 2048 + k * 1024); } while (0)
#define PG8_MMA(ai, bj, At, Bt) do { __builtin_amdgcn_s_setprio(1); _Pragma("unroll") for (int m = 0; m < 4; ++m) _Pragma("unroll") for (int n = 0; n < 2; ++n) _Pragma("unroll") for (int k = 0; k < 2; ++k) \
        acc[ai][bj][m][n] = __builtin_amdgcn_mfma_f32_16x16x32_bf16(Bt[n][k], At[m][k], acc[ai][bj][m][n], 0, 0, 0); __builtin_amdgcn_s_setprio(0); } while (0)
#define PG8_WAIT_V(n) asm volatile("s_waitcnt vmcnt(" #n ")" ::: "memory")
#define PG8_WAIT_L(n) asm volatile("s_waitcnt lgkmcnt(" #n ")" ::: "memory")
#define PG8_BAR __builtin_amdgcn_s_barrier()
#define PG8_SCHED __builtin_amdgcn_sched_barrier(0)
    Unit cur, nxt; int ui = 0;
    if (!S.next(0, cur)) return;
    f32x4 acc[2][2][4][2];
#pragma unroll
    for (int a = 0; a < 2; ++a)
#pragma unroll
        for (int b = 0; b < 2; ++b)
#pragma unroll
            for (int m = 0; m < 4; ++m)
#pragma unroll
                for (int n = 0; n < 2; ++n) acc[a][b][m][n] = (f32x4){0.f, 0.f, 0.f, 0.f};
    bf16x8 At[4][2], B0[2][2], B1[2][2];
    const char* cA; const char* cB; unit_ptrs(g, cur, cA, cB);
    PG8_STAGE(PG8_SB(0, 0), cB, voffB); PG8_STAGE(PG8_SB(0, 1), cB + hstepB, voffB); PG8_STAGE(PG8_SA(0, 0), cA, voffA); PG8_STAGE(PG8_SA(0, 1), cA + hstepA, voffA);
    if (wr == 1) PG8_BAR;
    PG8_WAIT_V(2); PG8_BAR;
    PG8_STAGE(PG8_SB(1, 0), cB + kstep, voffB); PG8_STAGE(PG8_SA(1, 0), cA + kstep, voffA); PG8_STAGE(PG8_SB(1, 1), cB + hstepB + kstep, voffB);
    PG8_WAIT_V(6); PG8_BAR;
    for (;;) {
        const bool has_next = S.next(ui + 1, nxt);
        const char* nA = cA; const char* nB = cB; if (has_next) unit_ptrs(g, nxt, nA, nB);
#pragma unroll 1
        for (int t = 0; t < nt; t += 2) {
            const bool last = (t == nt - 2);
            const char* a1 = cA + (size_t)(t + 1) * kstep;
            const char* a2 = last ? nA : cA + (size_t)(t + 2) * kstep; const char* b2 = last ? nB : cB + (size_t)(t + 2) * kstep;
            const char* a3 = a2 + kstep; const char* b3 = b2 + kstep;
            PG8_LDB(B0, 0, 0); PG8_LDB(B1, 0, 1); PG8_SCHED; PG8_LDA(At, 0, 0); PG8_STAGE(PG8_SA(1, 1), a1 + hstepA, voffA);
            PG8_WAIT_V(8); PG8_WAIT_L(0); PG8_BAR; PG8_MMA(0, 0, At, B0); PG8_MMA(0, 1, At, B1); PG8_BAR; PG8_SCHED;
            PG8_LDA(At, 0, 1); PG8_STAGE(PG8_SB(0, 0), b2, voffB); PG8_STAGE(PG8_SB(0, 1), b2 + hstepB, voffB); PG8_STAGE(PG8_SA(0, 0), a2, voffA);
            PG8_WAIT_V(8); PG8_WAIT_L(0); PG8_BAR; PG8_MMA(1, 0, At, B0); PG8_MMA(1, 1, At, B1); PG8_BAR; PG8_SCHED;
            PG8_LDB(B0, 1, 0); PG8_LDB(B1, 1, 1); PG8_SCHED; PG8_LDA(At, 1, 0); PG8_STAGE(PG8_SA(0, 1), a2 + hstepA, voffA);
            PG8_WAIT_V(8); PG8_WAIT_L(0); PG8_BAR; PG8_MMA(0, 0, At, B0); PG8_MMA(0, 1, At, B1); PG8_BAR; PG8_SCHED;
            PG8_LDA(At, 1, 1); PG8_STAGE(PG8_SB(1, 0), b3, voffB); PG8_STAGE(PG8_SB(1, 1), b3 + hstepB, voffB); PG8_STAGE(PG8_SA(1, 0), a3, voffA);
            PG8_WAIT_V(8); PG8_WAIT_L(0); PG8_BAR; PG8_MMA(1, 0, At, B0); PG8_MMA(1, 1, At, B1); PG8_BAR; PG8_SCHED;
        }
        if (wr == 0) PG8_BAR;
        E(acc, cur, wr, wc, fr, fq);
        if (!has_next) break;
#pragma unroll
        for (int a = 0; a < 2; ++a)
#pragma unroll
            for (int b = 0; b < 2; ++b)
#pragma unroll
                for (int m = 0; m < 4; ++m)
#pragma unroll
                    for (int n = 0; n < 2; ++n) acc[a][b][m][n] = (f32x4){0.f, 0.f, 0.f, 0.f};
        cur = nxt; cA = nA; cB = nB; ++ui;
        if (wr == 1) PG8_BAR;
    }
    PG8_WAIT_V(0);
    PG8_BAR;
#undef PG8_SA
#undef PG8_SB
#undef PG8_STAGE
#undef PG8_LDA
#undef PG8_LDB
#undef PG8_MMA
#undef PG8_WAIT_V
#undef PG8_WAIT_L
#undef PG8_BAR
#undef PG8_SCHED
}
}

__device__ __forceinline__ s16x4 tr_read(const LAS unsigned char* p) { return __builtin_bit_cast(s16x4, __builtin_amdgcn_ds_read_tr16_b64_v4i16((LAS s16x4*)p)); }

template <int HD, int QI, int KT16 = 4>
__device__ __forceinline__ void attn_tile(const LAS unsigned char* Ks, const LAS unsigned char* Vs, const bf16x8 (&qf)[QI][HD / 32],
                                          float (&m)[QI], float (&l)[QI], f32x4 (&o)[QI][HD / 16], float sc,
                                          int maskmode, const int (&qloc)[QI], int kbase, const bool (&keep)[QI], int fr, int fq) {
    constexpr int KP = 2 * HD + 32;
    f32x4 s[QI][KT16];
#pragma unroll
    for (int qi = 0; qi < QI; ++qi)
#pragma unroll
        for (int kt = 0; kt < KT16; ++kt) s[qi][kt] = (f32x4){0.f, 0.f, 0.f, 0.f};
#pragma unroll
    for (int kt = 0; kt < KT16; ++kt)
#pragma unroll
        for (int dk = 0; dk < HD / 32; ++dk) {
            const bf16x8 kf = *(const LAS bf16x8*)(Ks + (16 * kt + fr) * KP + (32 * dk + 8 * fq) * 2);
#pragma unroll
            for (int qi = 0; qi < QI; ++qi) s[qi][kt] = __builtin_amdgcn_mfma_f32_16x16x32_bf16(kf, qf[qi][dk], s[qi][kt], 0, 0, 0);
        }
    float mxs[QI]; bool need = false;
#pragma unroll
    for (int qi = 0; qi < QI; ++qi) {
        if (maskmode == 1) {
#pragma unroll
            for (int kt = 0; kt < KT16; ++kt)
#pragma unroll
                for (int r = 0; r < 4; ++r) if (kbase + 16 * kt + 4 * fq + r > qloc[qi]) s[qi][kt][r] = -INFINITY;
        }
        float mx = fmaxf(fmaxf(s[qi][0][0], s[qi][0][1]), fmaxf(s[qi][0][2], s[qi][0][3]));
#pragma unroll
        for (int kt = 1; kt < KT16; ++kt) { mx = fmaxf(fmaxf(mx, s[qi][kt][0]), s[qi][kt][1]); mx = fmaxf(fmaxf(mx, s[qi][kt][2]), s[qi][kt][3]); }
        mx = xmax32(xmax16(mx));
        mxs[qi] = mx * sc;
        need = need || (keep[qi] && mxs[qi] > m[qi] + 8.0f);
    }
    if (__ballot(need) != 0ull) {
#pragma unroll
        for (int qi = 0; qi < QI; ++qi) {
            const bool upd = keep[qi] && mxs[qi] > m[qi] + 8.0f;
            const float mn = upd ? mxs[qi] : m[qi];
            const float al = __builtin_amdgcn_exp2f(m[qi] - mn); m[qi] = mn; l[qi] *= al;
#pragma unroll
            for (int dt = 0; dt < HD / 16; ++dt) o[qi][dt] = o[qi][dt] * al;
        }
    }
    bf16x8 pf[QI][KT16 / 2];
#pragma unroll
    for (int qi = 0; qi < QI; ++qi) {
        const float moff = keep[qi] ? -m[qi] : -INFINITY;
        float rs = 0.f;
#pragma unroll
        for (int kt = 0; kt < KT16; ++kt)
#pragma unroll
            for (int r = 0; r < 4; ++r) { const float p = __builtin_amdgcn_exp2f(__builtin_fmaf(s[qi][kt][r], sc, moff)); s[qi][kt][r] = p; rs += p; }
        l[qi] += rs;
#pragma unroll
        for (int p2 = 0; p2 < KT16 / 2; ++p2) {
            u32x4 w; w.x = cvt_pk_bf16(s[qi][2 * p2][0], s[qi][2 * p2][1]); w.y = cvt_pk_bf16(s[qi][2 * p2][2], s[qi][2 * p2][3]);
            w.z = cvt_pk_bf16(s[qi][2 * p2 + 1][0], s[qi][2 * p2 + 1][1]); w.w = cvt_pk_bf16(s[qi][2 * p2 + 1][2], s[qi][2 * p2 + 1][3]);
            pf[qi][p2] = __builtin_bit_cast(bf16x8, w);
        }
    }
    const LAS unsigned char* vb = Vs + (4 * fq + (fr >> 2)) * KP + (4 * (fr & 3)) * 2;
#pragma unroll
    for (int dt = 0; dt < HD / 16; ++dt)
#pragma unroll
        for (int p2 = 0; p2 < KT16 / 2; ++p2) {
            const s16x4 lo = tr_read(vb + (32 * p2) * KP + 32 * dt);
            const s16x4 hi = tr_read(vb + (32 * p2 + 16) * KP + 32 * dt);
            const bf16x8 vf = (bf16x8){lo[0], lo[1], lo[2], lo[3], hi[0], hi[1], hi[2], hi[3]};
#pragma unroll
            for (int qi = 0; qi < QI; ++qi) o[qi][dt] = __builtin_amdgcn_mfma_f32_16x16x32_bf16(vf, pf[qi][p2], o[qi][dt], 0, 0, 0);
        }
}

template <int HD, int QI, int KT16 = 4>
__device__ __forceinline__ void attn_tile_pl(const LAS unsigned char* Ks, const LAS unsigned char* Vs, const bf16x8 (&qf)[QI][HD / 32],
                                          float (&m)[QI], float (&l)[QI], f32x4 (&o)[QI][HD / 16], float sc,
                                          int maskmode, const int (&qloc)[QI], int kbase, const bool (&keep)[QI], int fr, int fq) {
    constexpr int KP = 2 * HD + 32;
    constexpr int NF = (HD / 32) * KT16, CH = 4, NCH = NF / CH;
    static_assert(NF % CH == 0, "fragment chunking");
    f32x4 s[QI][KT16];
#pragma unroll
    for (int qi = 0; qi < QI; ++qi)
#pragma unroll
        for (int kt = 0; kt < KT16; ++kt) s[qi][kt] = (f32x4){0.f, 0.f, 0.f, 0.f};
    const LAS unsigned char* kb = Ks + fr * KP + 16 * fq;
#define KFRAG(f) (*(const LAS bf16x8*)(kb + (16 * ((f) % KT16)) * KP + 64 * ((f) / KT16)))
    bf16x8 kf[2][CH];
#pragma unroll
    for (int i = 0; i < CH; ++i) kf[0][i] = KFRAG(i);
#pragma unroll
    for (int c = 0; c < NCH; ++c) {
        if (c + 1 < NCH) {
#pragma unroll
            for (int i = 0; i < CH; ++i) kf[(c + 1) & 1][i] = KFRAG((c + 1) * CH + i);
        }
        __builtin_amdgcn_sched_barrier(0);
#pragma unroll
        for (int i = 0; i < CH; ++i) { const int f = c * CH + i, kt = f % KT16, dk = f / KT16;
#pragma unroll
            for (int qi = 0; qi < QI; ++qi) s[qi][kt] = __builtin_amdgcn_mfma_f32_16x16x32_bf16(kf[c & 1][i], qf[qi][dk], s[qi][kt], 0, 0, 0); }
        __builtin_amdgcn_sched_barrier(0);
    }
#undef KFRAG
    constexpr int NV = (KT16 / 2) * (HD / 16), NVC = NV / CH;
    static_assert(NV % CH == 0, "V fragment chunking");
    const LAS unsigned char* vb = Vs + (4 * fq + (fr >> 2)) * KP + (4 * (fr & 3)) * 2;
#define VLO(g) tr_read(vb + (32 * ((g) / (HD / 16))) * KP + 32 * ((g) % (HD / 16)))
#define VHI(g) tr_read(vb + (32 * ((g) / (HD / 16)) + 16) * KP + 32 * ((g) % (HD / 16)))
    s16x4 vlo[2][CH], vhi[2][CH];
#pragma unroll
    for (int i = 0; i < CH; ++i) { vlo[0][i] = VLO(i); vhi[0][i] = VHI(i); }
    __builtin_amdgcn_sched_barrier(0);
    float mxs[QI]; bool need = false;
#pragma unroll
    for (int qi = 0; qi < QI; ++qi) {
        if (maskmode == 1) {
#pragma unroll
            for (int kt = 0; kt < KT16; ++kt)
#pragma unroll
                for (int r = 0; r < 4; ++r) if (kbase + 16 * kt + 4 * fq + r > qloc[qi]) s[qi][kt][r] = -INFINITY;
        }
        float mx = fmaxf(fmaxf(s[qi][0][0], s[qi][0][1]), fmaxf(s[qi][0][2], s[qi][0][3]));
#pragma unroll
        for (int kt = 1; kt < KT16; ++kt) { mx = fmaxf(fmaxf(mx, s[qi][kt][0]), s[qi][kt][1]); mx = fmaxf(fmaxf(mx, s[qi][kt][2]), s[qi][kt][3]); }
        mx = xmax32(xmax16(mx));
        mxs[qi] = mx * sc;
        need = need || (keep[qi] && mxs[qi] > m[qi] + 8.0f);
    }
    if (__ballot(need) != 0ull) {
#pragma unroll
        for (int qi = 0; qi < QI; ++qi) {
            const bool upd = keep[qi] && mxs[qi] > m[qi] + 8.0f;
            const float mn = upd ? mxs[qi] : m[qi];
            const float al = __builtin_amdgcn_exp2f(m[qi] - mn); m[qi] = mn; l[qi] *= al;
#pragma unroll
            for (int dt = 0; dt < HD / 16; ++dt) o[qi][dt] = o[qi][dt] * al;
        }
    }
    bf16x8 pf[QI][KT16 / 2];
#pragma unroll
    for (int qi = 0; qi < QI; ++qi) {
        const float moff = keep[qi] ? -m[qi] : -INFINITY;
        float rs = 0.f;
#pragma unroll
        for (int kt = 0; kt < KT16; ++kt)
#pragma unroll
            for (int r = 0; r < 4; ++r) { const float p = __builtin_amdgcn_exp2f(__builtin_fmaf(s[qi][kt][r], sc, moff)); s[qi][kt][r] = p; rs += p; }
        l[qi] += rs;
#pragma unroll
        for (int p2 = 0; p2 < KT16 / 2; ++p2) {
            u32x4 w; w.x = cvt_pk_bf16(s[qi][2 * p2][0], s[qi][2 * p2][1]); w.y = cvt_pk_bf16(s[qi][2 * p2][2], s[qi][2 * p2][3]);
            w.z = cvt_pk_bf16(s[qi][2 * p2 + 1][0], s[qi][2 * p2 + 1][1]); w.w = cvt_pk_bf16(s[qi][2 * p2 + 1][2], s[qi][2 * p2 + 1][3]);
            pf[qi][p2] = __builtin_bit_cast(bf16x8, w);
        }
    }
    __builtin_amdgcn_sched_barrier(0);
#pragma unroll
    for (int c = 0; c < NVC; ++c) {
        if (c + 1 < NVC) {
#pragma unroll
            for (int i = 0; i < CH; ++i) { vlo[(c + 1) & 1][i] = VLO((c + 1) * CH + i); vhi[(c + 1) & 1][i] = VHI((c + 1) * CH + i); }
        }
        __builtin_amdgcn_sched_barrier(0);
#pragma unroll
        for (int i = 0; i < CH; ++i) { const int g = c * CH + i, p2 = g / (HD / 16), dt = g % (HD / 16);
            const s16x4 lo = vlo[c & 1][i], hi = vhi[c & 1][i];
            const bf16x8 vf = (bf16x8){lo[0], lo[1], lo[2], lo[3], hi[0], hi[1], hi[2], hi[3]};
#pragma unroll
            for (int qi = 0; qi < QI; ++qi) o[qi][dt] = __builtin_amdgcn_mfma_f32_16x16x32_bf16(vf, pf[qi][p2], o[qi][dt], 0, 0, 0); }
        __builtin_amdgcn_sched_barrier(0);
    }
#undef VLO
#undef VHI
}

template <int HD> struct Stage { static constexpr int CH = HD / 8, NLD = 64 * CH / 512, KP = 2 * HD + 32, TILE_B = 64 * KP; u32x4 k[NLD], v[NLD]; };
template <int HD>
__device__ __forceinline__ void stage_load(Stage<HD>& st, const bf16_t* Kg, const bf16_t* Vg, int gp, int tid) {
#pragma unroll
    for (int i = 0; i < Stage<HD>::NLD; ++i) { const int idx = tid + 512 * i, row = idx / Stage<HD>::CH, ch = idx % Stage<HD>::CH;
        st.k[i] = *(const u32x4*)(Kg + (size_t)row * gp + ch * 8); st.v[i] = *(const u32x4*)(Vg + (size_t)row * gp + ch * 8); }
}
template <int HD>
__device__ __forceinline__ void stage_store(const Stage<HD>& st, LAS unsigned char* buf, int tid) {
#pragma unroll
    for (int i = 0; i < Stage<HD>::NLD; ++i) { const int idx = tid + 512 * i, row = idx / Stage<HD>::CH, ch = idx % Stage<HD>::CH;
        *(LAS u32x4*)(buf + row * Stage<HD>::KP + ch * 16) = st.k[i]; *(LAS u32x4*)(buf + Stage<HD>::TILE_B + row * Stage<HD>::KP + ch * 16) = st.v[i]; }
}

namespace moba {
constexpr int HD = 64, KP = 2 * HD + 32, BLKB = 256 * KP;
constexpr int L_K = 0, L_V = BLKB, L_O = 2 * BLKB, L_M = L_O + 256 * 128, L_L = L_M + 1024, L_LIST = L_L + 1024, L_CNT = L_LIST + 15 * 256, L_Q = L_CNT + 64, L_END = L_Q + 256 * 128;
struct BlkStage { u32x4 k[4], v[4]; };
__device__ __forceinline__ void blk_load(BlkStage& st, const bf16_t* Kg, const bf16_t* Vg, int tid) {
#pragma unroll
    for (int i = 0; i < 4; ++i) { const int idx = tid + 512 * i, row = idx >> 3, ch = idx & 7;
        st.k[i] = *(const u32x4*)(Kg + (size_t)row * INW + ch * 8); st.v[i] = *(const u32x4*)(Vg + (size_t)row * INW + ch * 8); }
}
__device__ __forceinline__ void blk_store(const BlkStage& st, LAS unsigned char* lds, int tid) {
#pragma unroll
    for (int i = 0; i < 4; ++i) { const int idx = tid + 512 * i, row = idx >> 3, ch = idx & 7;
        *(LAS u32x4*)(lds + L_K + row * KP + ch * 16) = st.k[i]; *(LAS u32x4*)(lds + L_V + row * KP + ch * 16) = st.v[i]; }
}
template <int QI>
__device__ __forceinline__ void past_tiles(LAS unsigned char* lds, const int (&rows)[QI], const bool (&valid)[QI], float sc, int fr, int fq) {
    bf16x8 qf[QI][2]; float m[QI], l[QI]; f32x4 o[QI][4]; int qloc[QI];
#pragma unroll
    for (int qi = 0; qi < QI; ++qi) {
#pragma unroll
        for (int dk = 0; dk < 2; ++dk) qf[qi][dk] = *(const LAS bf16x8*)(lds + L_Q + rows[qi] * 128 + (32 * dk + 8 * fq) * 2);
        m[qi] = *(const LAS float*)(lds + L_M + rows[qi] * 4);
        l[qi] = (fq == 0) ? *(const LAS float*)(lds + L_L + rows[qi] * 4) : 0.f;
        qloc[qi] = 0;
#pragma unroll
        for (int dt = 0; dt < 4; ++dt) { const u32x2 ov = *(const LAS u32x2*)(lds + L_O + rows[qi] * 128 + (16 * dt + 4 * fq) * 2);
            o[qi][dt] = (f32x4){__uint_as_float(ov.x << 16), __uint_as_float(ov.x & 0xffff0000u), __uint_as_float(ov.y << 16), __uint_as_float(ov.y & 0xffff0000u)}; }
    }
    if constexpr (QI == 1) attn_tile_pl<HD, 1, 16>(lds + L_K, lds + L_V, qf, m, l, o, sc, 0, qloc, 0, valid, fr, fq);
    else {
#pragma unroll 1
        for (int half = 0; half < 2; ++half)
            attn_tile<HD, QI, 8>(lds + L_K + half * 128 * KP, lds + L_V + half * 128 * KP, qf, m, l, o, sc, 0, qloc, 0, valid, fr, fq);
    }
#pragma unroll
    for (int qi = 0; qi < QI; ++qi) {
        const float lt = xsum32(xsum16(l[qi]));
        if (valid[qi]) {
            if (fq == 0) { *(LAS float*)(lds + L_M + rows[qi] * 4) = m[qi]; *(LAS float*)(lds + L_L + rows[qi] * 4) = lt; }
#pragma unroll
            for (int dt = 0; dt < 4; ++dt) { u32x2 ov; ov.x = cvt_pk_bf16(o[qi][dt][0], o[qi][dt][1]); ov.y = cvt_pk_bf16(o[qi][dt][2], o[qi][dt][3]);
                *(LAS u32x2*)(lds + L_O + rows[qi] * 128 + (16 * dt + 4 * fq) * 2) = ov; }
        }
    }
}
}

__device__ __forceinline__ void moba_unit(int b, int h, int blk, const bf16_t* Z, const float* KM, bf16_t* MIX, LAS unsigned char* lds) {
    using namespace moba;
    constexpr int QI = 2;
    const int tid = threadIdx.x, lane = tid & 63, w = __builtin_amdgcn_readfirstlane(tid >> 6), fr = lane & 15, fq = lane >> 4;
    const size_t rowb = (size_t)b * SEQ;
    const int q0 = 256 * blk + 32 * w;
    const bf16_t* Kh = Z + rowb * INW + 1024 + h * 64; const bf16_t* Vh = Z + rowb * INW + 1536 + h * 64;
    const bf16_t* Qblk = Z + (rowb + 256 * blk) * INW + 512 + h * 64;
    BlkStage st;
    blk_load(st, Kh + (size_t)(256 * blk) * INW, Vh + (size_t)(256 * blk) * INW, tid);
    bf16x8 qf[QI][2];
#pragma unroll
    for (int qi = 0; qi < QI; ++qi)
#pragma unroll
        for (int dk = 0; dk < 2; ++dk) qf[qi][dk] = *(const bf16x8*)(Qblk + (size_t)(32 * w + 16 * qi + fr) * INW + 32 * dk + 8 * fq);
    __syncthreads();
    if (tid < 16) *(LAS unsigned*)(lds + L_CNT + tid * 4) = 0u;
    if (blk > 0) {
#pragma unroll
        for (int i = 0; i < 4; ++i) { const int idx = tid + 512 * i, row = idx >> 3, ch = idx & 7;
            *(LAS u32x4*)(lds + L_Q + row * 128 + ch * 16) = *(const u32x4*)(Qblk + (size_t)row * INW + ch * 8); }
    }
    __syncthreads();
    {
        float v1[QI], v2[QI], v3[QI]; int i1[QI], i2[QI], i3[QI];
#pragma unroll
        for (int qi = 0; qi < QI; ++qi) { v1[qi] = v2[qi] = v3[qi] = -INFINITY; i1[qi] = i2[qi] = i3[qi] = -1; }
        const float* kmb = KM + (size_t)((b * 8 + h) * NBLK) * 64;
        for (int j = 0; j < blk; ++j) {
            f32x4 km[2][2];
#pragma unroll
            for (int dk = 0; dk < 2; ++dk) { km[dk][0] = *(const f32x4*)(kmb + j * 64 + 32 * dk + 8 * fq); km[dk][1] = *(const f32x4*)(kmb + j * 64 + 32 * dk + 8 * fq + 4); }
#pragma unroll
            for (int qi = 0; qi < QI; ++qi) {
                float g = 0.f;
#pragma unroll
                for (int dk = 0; dk < 2; ++dk)
#pragma unroll
                    for (int e = 0; e < 8; ++e) g += bf2f((unsigned short)qf[qi][dk][e]) * km[dk][e >> 2][e & 3];
                g = xsum32(xsum16(g));
                if (g > v1[qi]) { v3[qi] = v2[qi]; i3[qi] = i2[qi]; v2[qi] = v1[qi]; i2[qi] = i1[qi]; v1[qi] = g; i1[qi] = j; }
                else if (g > v2[qi]) { v3[qi] = v2[qi]; i3[qi] = i2[qi]; v2[qi] = g; i2[qi] = j; }
                else if (g > v3[qi]) { v3[qi] = g; i3[qi] = j; }
            }
        }
        if (fq == 0) {
#pragma unroll
            for (int qi = 0; qi < QI; ++qi) { const int row = 32 * w + 16 * qi + fr; const int ids[3] = {i1[qi], i2[qi], i3[qi]};
#pragma unroll
                for (int k3 = 0; k3 < 3; ++k3) if (ids[k3] >= 0) {
                    const unsigned pos = __hip_atomic_fetch_add((LAS unsigned*)(lds + L_CNT + ids[k3] * 4), 1u, __ATOMIC_RELAXED, __HIP_MEMORY_SCOPE_WORKGROUP);
                    *(LAS unsigned char*)(lds + L_LIST + ids[k3] * 256 + pos) = (unsigned char)row; } }
        }
    }
    blk_store(st, lds, tid);
    __syncthreads();
    { const int jn = blk > 0 ? 0 : blk; blk_load(st, Kh + (size_t)(256 * jn) * INW, Vh + (size_t)(256 * jn) * INW, tid); }
    const float sc = 0.125f * LOG2E;
    {
        float m[QI], l[QI]; f32x4 o[QI][4]; int qloc[QI]; bool keep[QI];
#pragma unroll
        for (int qi = 0; qi < QI; ++qi) { m[qi] = -1e30f; l[qi] = 0.f; qloc[qi] = 32 * w + 16 * qi + fr; keep[qi] = true;
#pragma unroll
            for (int dt = 0; dt < 4; ++dt) o[qi][dt] = (f32x4){0.f, 0.f, 0.f, 0.f}; }
#pragma unroll 1
        for (int half = 0; half < 2; ++half)
            if (128 * half <= 32 * w) attn_tile<HD, QI, 8>(lds + L_K + half * 128 * KP, lds + L_V + half * 128 * KP, qf, m, l, o, sc, 1, qloc, 128 * half, keep, fr, fq);
#pragma unroll
        for (int qi = 0; qi < QI; ++qi) {
            const float lt = xsum32(xsum16(l[qi])); const int row = 32 * w + 16 * qi + fr;
            if (blk == 0) {
                const float inv = 1.0f / lt; bf16_t* op = MIX + (rowb + q0 + 16 * qi + fr) * DM + 512 + h * 64 + 4 * fq;
#pragma unroll
                for (int dt = 0; dt < 4; ++dt) { const f32x4 v = o[qi][dt] * inv; u32x2 wv; wv.x = cvt_pk_bf16(v[0], v[1]); wv.y = cvt_pk_bf16(v[2], v[3]); *(u32x2*)(op + 16 * dt) = wv; }
            } else {
                if (fq == 0) { *(LAS float*)(lds + L_M + row * 4) = m[qi]; *(LAS float*)(lds + L_L + row * 4) = lt; }
#pragma unroll
                for (int dt = 0; dt < 4; ++dt) { u32x2 ov; ov.x = cvt_pk_bf16(o[qi][dt][0], o[qi][dt][1]); ov.y = cvt_pk_bf16(o[qi][dt][2], o[qi][dt][3]);
                    *(LAS u32x2*)(lds + L_O + row * 128 + (16 * dt + 4 * fq) * 2) = ov; }
            }
        }
    }
    for (int j = 0; j < blk; ++j) {
        __syncthreads();
        blk_store(st, lds, tid);
        __syncthreads();
        { const int jn = (j + 1 < blk) ? j + 1 : j; blk_load(st, Kh + (size_t)(256 * jn) * INW, Vh + (size_t)(256 * jn) * INW, tid); }
        const int n = (int)*(const LAS unsigned*)(lds + L_CNT + j * 4);
        const int tiles = (n + 15) >> 4;
        for (int tw = w; tw < tiles; tw += 8) {
            int rows[1]; bool valid[1];
            { const int idx = 16 * tw + fr; valid[0] = idx < n; rows[0] = *(const LAS unsigned char*)(lds + L_LIST + j * 256 + (valid[0] ? idx : 0)); }
            past_tiles<1>(lds, rows, valid, sc, fr, fq);
        }
    }
    if (blk > 0) {
        __syncthreads();
#pragma unroll
        for (int qi = 0; qi < QI; ++qi) {
            const int row = 32 * w + 16 * qi + fr;
            const float inv = 1.0f / *(const LAS float*)(lds + L_L + row * 4);
            bf16_t* op = MIX + (rowb + q0 + 16 * qi + fr) * DM + 512 + h * 64 + 4 * fq;
#pragma unroll
            for (int dt = 0; dt < 4; ++dt) { const u32x2 ov = *(const LAS u32x2*)(lds + L_O + row * 128 + (16 * dt + 4 * fq) * 2);
                const f32x4 v = (f32x4){__uint_as_float(ov.x << 16), __uint_as_float(ov.x & 0xffff0000u), __uint_as_float(ov.y << 16), __uint_as_float(ov.y & 0xffff0000u)} * inv;
                u32x2 wv; wv.x = cvt_pk_bf16(v[0], v[1]); wv.y = cvt_pk_bf16(v[2], v[3]); *(u32x2*)(op + 16 * dt) = wv; }
        }
    }
}

__device__ __forceinline__ void xattn_unit(int qt, int hd, const bf16_t* XQ, const bf16_t* MEMKV, bf16_t* XO, LAS unsigned char* lds) {
    constexpr int HD = 256, QI = 1, TB = Stage<HD>::TILE_B;
    const int tid = threadIdx.x, lane = tid & 63, w = __builtin_amdgcn_readfirstlane(tid >> 6), fr = lane & 15, fq = lane >> 4;
    const int b = qt >> 5;
    const size_t qrow = (size_t)qt * 128 + 16 * w + fr;
    bf16x8 qf[QI][HD / 32];
#pragma unroll
    for (int dk = 0; dk < HD / 32; ++dk) qf[0][dk] = *(const bf16x8*)(XQ + qrow * DM + hd * 256 + 32 * dk + 8 * fq);
    float m[QI] = {-1e30f}, l[QI] = {0.f}; f32x4 o[QI][HD / 16]; int qloc[QI] = {0}; bool keep[QI] = {true};
#pragma unroll
    for (int dt = 0; dt < HD / 16; ++dt) o[0][dt] = (f32x4){0.f, 0.f, 0.f, 0.f};
    const float sc = 0.0625f * LOG2E;
    const bf16_t* Kh = MEMKV + (size_t)b * MEMLEN * 2048 + hd * 256; const bf16_t* Vh = Kh + 1024;
    Stage<HD> st;
    __syncthreads();
    stage_load<HD>(st, Kh, Vh, 2048, tid);
    stage_store<HD>(st, lds, tid);
    __syncthreads();
    for (int t = 0; t < 4; ++t) {
        if (t + 1 < 4) stage_load<HD>(st, Kh + (size_t)(64 * (t + 1)) * 2048, Vh + (size_t)(64 * (t + 1)) * 2048, 2048, tid);
        const LAS unsigned char* buf = lds + (t & 1) * 2 * TB;
        attn_tile<HD, QI>(buf, buf + TB, qf, m, l, o, sc, 0, qloc, 0, keep, fr, fq);
        if (t + 1 < 4) stage_store<HD>(st, lds + ((t + 1) & 1) * 2 * TB, tid);
        __syncthreads();
    }
    float ls = xsum32(xsum16(l[0]));
    const float inv = 1.0f / ls;
    bf16_t* op = XO + qrow * DM + hd * 256 + 4 * fq;
#pragma unroll
    for (int dt = 0; dt < HD / 16; ++dt) { const f32x4 v = o[0][dt] * inv; u32x2 wv; wv.x = cvt_pk_bf16(v[0], v[1]); wv.y = cvt_pk_bf16(v[2], v[3]); *(u32x2*)(op + 16 * dt) = wv; }
}

__device__ __forceinline__ void p0_transpose_item(const float* W, int K, int N, bf16_t* WT, int mode, LAS float* scr, int item, int lane, const float* ks = nullptr) {
    const int nblk = N / 32, kb = item / nblk, nb = item % nblk, k0 = 64 * kb, n0 = 32 * nb;
    float wv[32];
#pragma unroll
    for (int i = 0; i < 32; ++i) wv[i] = W[(size_t)(k0 + 2 * i + (lane >> 5)) * N + n0 + (lane & 31)];
#pragma unroll
    for (int i = 0; i < 32; ++i) { const int kk = 2 * i + (lane >> 5); scr[kk * 33 + (lane & 31)] = ks ? wv[i] * ks[k0 + kk] : wv[i]; }
    asm volatile("s_waitcnt lgkmcnt(0)" ::: "memory");
    const int c = lane & 7;
#pragma unroll
    for (int j = 0; j < 4; ++j) { const int n = (lane >> 3) + 8 * j; const LAS float* s = scr + (8 * c) * 33 + n;
        u32x4 o; o.x = cvt_pk_bf16(s[0 * 33], s[1 * 33]); o.y = cvt_pk_bf16(s[2 * 33], s[3 * 33]); o.z = cvt_pk_bf16(s[4 * 33], s[5 * 33]); o.w = cvt_pk_bf16(s[6 * 33], s[7 * 33]);
        const int gn = n0 + n; const int row = (mode == 0) ? gn : (32 * (gn >> 4) + (gn & 15) + (mode == 2 ? 16 : 0));
        *(u32x4*)(WT + (size_t)row * K + k0 + 8 * c) = o; }
    asm volatile("s_waitcnt lgkmcnt(0)" ::: "memory");
}
__device__ __forceinline__ void cvt_rows_bf16(const float* src, bf16_t* dst, size_t n8, size_t gtid, size_t nthr) {
    size_t i = gtid;
    for (; i + 3 * nthr < n8; i += 4 * nthr) {
        f32x4 a[4], b[4];
#pragma unroll
        for (int q = 0; q < 4; ++q) { a[q] = *(const f32x4*)(src + (i + q * nthr) * 8); b[q] = *(const f32x4*)(src + (i + q * nthr) * 8 + 4); }
#pragma unroll
        for (int q = 0; q < 4; ++q) { u32x4 o; o.x = cvt_pk_bf16(a[q][0], a[q][1]); o.y = cvt_pk_bf16(a[q][2], a[q][3]); o.z = cvt_pk_bf16(b[q][0], b[q][1]); o.w = cvt_pk_bf16(b[q][2], b[q][3]); *(u32x4*)(dst + (i + q * nthr) * 8) = o; }
    }
    for (; i < n8; i += nthr) { const f32x4 a = *(const f32x4*)(src + i * 8), b = *(const f32x4*)(src + i * 8 + 4);
        u32x4 o; o.x = cvt_pk_bf16(a[0], a[1]); o.y = cvt_pk_bf16(a[2], a[3]); o.z = cvt_pk_bf16(b[0], b[1]); o.w = cvt_pk_bf16(b[2], b[3]); *(u32x4*)(dst + i * 8) = o; }
}
__device__ __forceinline__ void ln_row(const float* yrow, const float* g, const float* bta, float* hrow, bf16_t* brow, int lane) {
    f32x4 v[4]; float s = 0.f;
#pragma unroll
    for (int j = 0; j < 4; ++j) { v[j] = *((const f32x4*)yrow + lane + 64 * j); s += (v[j][0] + v[j][1]) + (v[j][2] + v[j][3]); }
    const float mean = wave_sum(s) * (1.f / DM); float s2 = 0.f;
#pragma unroll
    for (int j = 0; j < 4; ++j) { v[j] = v[j] - mean; s2 += (v[j][0] * v[j][0] + v[j][1] * v[j][1]) + (v[j][2] * v[j][2] + v[j][3] * v[j][3]); }
    const float rstd = 1.f / sqrtf(wave_sum(s2) * (1.f / DM) + LN_EPS);
#pragma unroll
    for (int j = 0; j < 4; ++j) { const f32x4 gg = *((const f32x4*)g + lane + 64 * j), bb = *((const f32x4*)bta + lane + 64 * j);
        const f32x4 r = v[j] * rstd * gg + bb; *((f32x4*)hrow + lane + 64 * j) = r;
        if (brow) { u32x2 wv; wv.x = cvt_pk_bf16(r[0], r[1]); wv.y = cvt_pk_bf16(r[2], r[3]); *((u32x2*)brow + lane + 64 * j) = wv; } }
}

__device__ __forceinline__ void ln_row_bf16in(const bf16_t* yrow, const float* g, const float* bta, float* orow, int lane) {
    f32x4 v[4]; float s = 0.f;
#pragma unroll
    for (int j = 0; j < 2; ++j) { const u32x4 rr = *((const u32x4*)yrow + lane + 64 * j);
        v[2 * j] = (f32x4){__uint_as_float(rr.x << 16), __uint_as_float(rr.x & 0xffff0000u), __uint_as_float(rr.y << 16), __uint_as_float(rr.y & 0xffff0000u)};
        v[2 * j + 1] = (f32x4){__uint_as_float(rr.z << 16), __uint_as_float(rr.z & 0xffff0000u), __uint_as_float(rr.w << 16), __uint_as_float(rr.w & 0xffff0000u)};
        s += ((v[2 * j][0] + v[2 * j][1]) + (v[2 * j][2] + v[2 * j][3])) + ((v[2 * j + 1][0] + v[2 * j + 1][1]) + (v[2 * j + 1][2] + v[2 * j + 1][3])); }
    const float mean = wave_sum(s) * (1.f / DM); float s2 = 0.f;
#pragma unroll
    for (int j = 0; j < 4; ++j) { v[j] = v[j] - mean; s2 += (v[j][0] * v[j][0] + v[j][1] * v[j][1]) + (v[j][2] * v[j][2] + v[j][3] * v[j][3]); }
    const float rstd = 1.f / sqrtf(wave_sum(s2) * (1.f / DM) + LN_EPS);
#pragma unroll
    for (int q = 0; q < 4; ++q) { const int ci = 512 * (q >> 1) + 8 * lane + 4 * (q & 1);
        const f32x4 gg = *(const f32x4*)(g + ci), bb = *(const f32x4*)(bta + ci);
        *(f32x4*)(orow + ci) = v[q] * rstd * gg + bb; }
}

__device__ __forceinline__ void ln_rows4_bf16in(const bf16_t* y, const float* g, const float* bta, float* o, int ld, int lane) {
    u32x4 rr[4][2];
#pragma unroll
    for (int q = 0; q < 4; ++q)
#pragma unroll
        for (int j = 0; j < 2; ++j) rr[q][j] = *((const u32x4*)(y + (size_t)q * ld) + lane + 64 * j);
    f32x4 gg[4], bb[4];
#pragma unroll
    for (int c4 = 0; c4 < 4; ++c4) { const int ci = 512 * (c4 >> 1) + 8 * lane + 4 * (c4 & 1); gg[c4] = *(const f32x4*)(g + ci); bb[c4] = *(const f32x4*)(bta + ci); }
#pragma unroll
    for (int q = 0; q < 4; ++q) {
        f32x4 v[4]; float s = 0.f;
#pragma unroll
        for (int j = 0; j < 2; ++j) { const u32x4 w = rr[q][j];
            v[2 * j] = (f32x4){__uint_as_float(w.x << 16), __uint_as_float(w.x & 0xffff0000u), __uint_as_float(w.y << 16), __uint_as_float(w.y & 0xffff0000u)};
            v[2 * j + 1] = (f32x4){__uint_as_float(w.z << 16), __uint_as_float(w.z & 0xffff0000u), __uint_as_float(w.w << 16), __uint_as_float(w.w & 0xffff0000u)}; }
#pragma unroll
        for (int c4 = 0; c4 < 4; ++c4) s += (v[c4][0] + v[c4][1]) + (v[c4][2] + v[c4][3]);
        const float mean = wave_sum(s) * (1.f / DM); float s2 = 0.f;
#pragma unroll
        for (int c4 = 0; c4 < 4; ++c4) { v[c4] = v[c4] - mean; s2 += (v[c4][0] * v[c4][0] + v[c4][1] * v[c4][1]) + (v[c4][2] * v[c4][2] + v[c4][3] * v[c4][3]); }
        const float rstd = 1.f / sqrtf(wave_sum(s2) * (1.f / DM) + LN_EPS);
#pragma unroll
        for (int c4 = 0; c4 < 4; ++c4) { const int ci = 512 * (c4 >> 1) + 8 * lane + 4 * (c4 & 1); *(f32x4*)(o + (size_t)q * ld + ci) = v[c4] * rstd * gg[c4] + bb[c4]; }
    }
}

#define XB_TMO      128
#define XB_XCNT(j)  (256  + 64 * (j))
#define XB_XSUB(j)  (1280 + 64 * (j))
#define XB_XGEN(j)  (2304 + 64 * (j))
#define XB_TOP      3328
#define XB_TOPGEN   3392
#define XCD_BAR_WORDS 3456
#define XB_SPIN_CAP (1u << 20)
__device__ __forceinline__ unsigned xb_ld(unsigned* p)              { return __hip_atomic_load(p, __ATOMIC_RELAXED, __HIP_MEMORY_SCOPE_AGENT); }
__device__ __forceinline__ unsigned xb_add(unsigned* p, unsigned v) { return __hip_atomic_fetch_add(p, v, __ATOMIC_RELAXED, __HIP_MEMORY_SCOPE_AGENT); }
__device__ __forceinline__ unsigned xb_xcc_id() { return (unsigned)__builtin_amdgcn_s_getreg((3 << 11) | 20) & 0xFu; }
#define XB_SPIN(cond, bar) do { unsigned _sp = 0; while (cond) { __builtin_amdgcn_s_sleep(1); \
    if ((++_sp & 255u) == 0u) { if (xb_ld(&(bar)[XB_TMO])) break; if (_sp > XB_SPIN_CAP) { atomicAdd(&(bar)[XB_TMO], 1u); break; } } } } while (0)
struct XcdBarrier { unsigned* bar; unsigned x; volatile LAS unsigned* st; };
__device__ __forceinline__ XcdBarrier xcd_barrier_post(unsigned* bar, volatile LAS unsigned* st) {
    XcdBarrier b; b.bar = bar; b.x = xb_xcc_id(); b.st = st;
    if (threadIdx.x == 0) (void)xb_add(&bar[XB_XCNT(b.x)], 1u);
    return b;
}
__device__ __forceinline__ void xcd_barrier_complete(unsigned* bar, unsigned x, unsigned& nloc, unsigned& nx) {
    const unsigned G = gridDim.x * gridDim.y * gridDim.z;
    unsigned sum, cnt, mine, sp = 0u;
    for (;;) {
        sum = 0u; cnt = 0u; mine = 0u;
#pragma unroll
        for (unsigned j = 0; j < 16; ++j) { const unsigned c = xb_ld(&bar[XB_XCNT(j)]); sum += c; cnt += (c > 0u) ? 1u : 0u; mine = (j == x) ? c : mine; }
        if (sum == G) break;
        __builtin_amdgcn_s_sleep(1);
        if ((++sp & 255u) == 0u) { if (xb_ld(&bar[XB_TMO])) break; if (sp > XB_SPIN_CAP) { atomicAdd(&bar[XB_TMO], 1u); break; } }
    }
    nloc = mine > 0u ? mine : 1u; nx = cnt > 0u ? cnt : 1u;
}
__device__ __forceinline__ void xcd_barrier(const XcdBarrier& b) {
    asm volatile("s_waitcnt vmcnt(0)" ::: "memory");
    __syncthreads();
    if (threadIdx.x == 0) {
        unsigned* bar = b.bar;
        __builtin_amdgcn_s_waitcnt(0);
        unsigned nloc = b.st[0], nx = b.st[1];
        if (nloc == 0u) { xcd_barrier_complete(bar, b.x, nloc, nx); b.st[0] = nloc; b.st[1] = nx; }
        const unsigned old = xb_add(&bar[XB_XSUB(b.x)], 1u);
        const unsigned gen = old / nloc;
        if (old + 1u == (gen + 1u) * nloc) {
            __builtin_amdgcn_fence(__ATOMIC_RELEASE, "agent");
            asm volatile("s_waitcnt vmcnt(0)" ::: "memory");
            const unsigned og = xb_add(&bar[XB_TOP], 1u);
            const unsigned tg = og / nx;
            if (og + 1u == (tg + 1u) * nx) xb_add(&bar[XB_TOPGEN], 1u);
            else XB_SPIN(xb_ld(&bar[XB_TOPGEN]) == tg, bar);
            __builtin_amdgcn_fence(__ATOMIC_ACQUIRE, "agent");
            xb_add(&bar[XB_XGEN(b.x)], 1u);
            asm volatile("s_waitcnt vmcnt(0)" ::: "memory");
        } else {
            XB_SPIN(xb_ld(&bar[XB_XGEN(b.x)]) == gen, bar);
            __builtin_amdgcn_fence(__ATOMIC_ACQUIRE, "agent");
            asm volatile("s_waitcnt vmcnt(0)" ::: "memory");
        }
    }
    __syncthreads();
}

#ifndef PROBE_PHASE
#define PROBE_PHASE -1
#endif
constexpr int LDS_BYTES = 159744;
constexpr int LDS_MISC = 159744 - 256;
struct Args { const float* in[18]; float* out; unsigned char* ws; int ph_lo, ph_hi; };
enum { I_X = 0, I_MEM, I_WIN, I_WPOOL, I_PSCALE, I_WOUT, I_LN1G, I_LN1B, I_WXQ, I_WXKV, I_WXO, I_LN2G, I_LN2B, I_WGATE, I_WUP, I_WDOWN, I_LN3G, I_LN3B };
constexpr int N_PHASES = 13;

struct Ctx {
    const float* const* in; LAS unsigned char* lds; unsigned char* ws; float* H;
    int tid, lane, wave, G, bx, vcu, gw, NGW;
};
#define WSP(T, off) ((T*)(c.ws + (off)))

template <int PH> __device__ __forceinline__ void run_phase(const Ctx& c) {
    const int lane = c.lane, wave = c.wave, G = c.G, bx = c.bx, vcu = c.vcu, gw = c.gw, NGW = c.NGW, tid = c.tid;
    LAS unsigned char* lds = c.lds;
    float* KM = WSP(float, WS_KM);
    bf16_t* Win_t = WSP(bf16_t, WS_WIN); bf16_t* Wout_t = WSP(bf16_t, WS_WOUT); bf16_t* Wxq_t = WSP(bf16_t, WS_WXQ); bf16_t* Wxkv_t = WSP(bf16_t, WS_WXKV);
    bf16_t* Wxo_t = WSP(bf16_t, WS_WXO); bf16_t* Wgu_t = WSP(bf16_t, WS_WGU); bf16_t* Wdn_t = WSP(bf16_t, WS_WDN); bf16_t* Wpool_t = WSP(bf16_t, WS_WPOOL);
    bf16_t* MEMB = WSP(bf16_t, WS_MEMB); bf16_t* MEMKV = WSP(bf16_t, WS_MEMKV);
    bf16_t* XB = WSP(bf16_t, WS_XB); bf16_t* Z = WSP(bf16_t, WS_Z); bf16_t* MIX = WSP(bf16_t, WS_MIX); bf16_t* HF = WSP(bf16_t, WS_HF);
    bf16_t* XQ = MIX; bf16_t* XO = Z;
    float* H = c.H; float* PST1 = WSP(float, WS_PST1); float* PST2 = WSP(float, WS_PST2);
    if constexpr (PH == 0) {
        if (bx < 208) {
            const float* W; int N, n0, mode; const float* gg; const float* bb; float* cd; int cdn;
            if (bx < 32) { W = c.in[I_WXQ]; N = DM; n0 = 32 * bx; mode = 0; gg = c.in[I_LN1G]; bb = c.in[I_LN1B]; cd = WSP(float, WS_CDX); cdn = DM; }
            else if (bx < 120) { W = c.in[I_WGATE]; N = DFF; n0 = 32 * (bx - 32); mode = 1; gg = c.in[I_LN2G]; bb = c.in[I_LN2B]; cd = WSP(float, WS_CDG); cdn = 2 * DFF; }
            else { W = c.in[I_WUP]; N = DFF; n0 = 32 * (bx - 120); mode = 2; gg = c.in[I_LN2G]; bb = c.in[I_LN2B]; cd = WSP(float, WS_CDG); cdn = 2 * DFF; }
            const int col = n0 + (lane & 31), kbeg = wave * 128 + (lane >> 5) * 64;
            float cs = 0.f, ds = 0.f;
#pragma unroll 8
            for (int k = kbeg; k < kbeg + 64; ++k) { const float wv = W[(size_t)k * N + col]; cs += gg[k] * wv; ds += bb[k] * wv; }
            cs += __shfl_xor(cs, 32); ds += __shfl_xor(ds, 32);
            LAS float* red = (LAS float*)(lds + 131072);
            if (lane < 32) { red[(wave * 32 + lane) * 2] = cs; red[(wave * 32 + lane) * 2 + 1] = ds; }
            __syncthreads();
            if (tid < 32) { float ct = 0.f, dt = 0.f;
#pragma unroll
                for (int w8 = 0; w8 < 8; ++w8) { ct += red[(w8 * 32 + tid) * 2]; dt += red[(w8 * 32 + tid) * 2 + 1]; }
                const int oi = (mode == 0) ? col : (32 * (col >> 4) + (col & 15) + (mode == 2 ? 16 : 0));
                cd[oi] = ct; cd[cdn + oi] = dt; }
        }
        LAS float* scr = (LAS float*)(lds + wave * 16384);
        constexpr int I_IN = (DM / 64) * (INW / 32), I_SQ = (DM / 64) * (DM / 32), I_KV = (DM / 64) * (2048 / 32), I_GU = (DM / 64) * (DFF / 32), I_DN = (DFF / 64) * (DM / 32), I_PL = 2 * 4;
        constexpr int NITEMS = I_IN + 3 * I_SQ + I_KV + 2 * I_GU + I_DN + 4 * I_PL;
        for (int it = gw; it < NITEMS; it += NGW) {
            int r = it;
            if (r < I_IN) { p0_transpose_item(c.in[I_WIN], DM, INW, Win_t, 0, scr, r, lane); continue; } r -= I_IN;
            if (r < I_SQ) { if (r >= 8 * (DM / 32)) p0_transpose_item(c.in[I_WOUT], DM, DM, Wout_t, 0, scr, r, lane); continue; } r -= I_SQ;
            if (r < I_SQ) { continue; } r -= I_SQ;
            if (r < I_SQ) { p0_transpose_item(c.in[I_WXO], DM, DM, Wxo_t, 0, scr, r, lane); continue; } r -= I_SQ;
            if (r < I_KV) { p0_transpose_item(c.in[I_WXKV], DM, 2048, Wxkv_t, 0, scr, r, lane); continue; } r -= I_KV;
            if (r < I_GU) { p0_transpose_item(c.in[I_WGATE], DM, DFF, Wgu_t, 1, scr, r, lane, c.in[I_LN2G]); continue; } r -= I_GU;
            if (r < I_GU) { p0_transpose_item(c.in[I_WUP], DM, DFF, Wgu_t, 2, scr, r, lane, c.in[I_LN2G]); continue; } r -= I_GU;
            if (r < I_DN) { p0_transpose_item(c.in[I_WDOWN], DFF, DM, Wdn_t, 0, scr, r, lane); continue; } r -= I_DN;
            { const int gidx = r / I_PL; p0_transpose_item(c.in[I_WPOOL] + gidx * 16384, 128, 128, Wpool_t + gidx * 16384, 0, scr, r % I_PL, lane); }
        }
        const size_t gtid = (size_t)vcu * 512 + tid, nthr = (size_t)G * 512;
        for (size_t idx = gtid; idx < (size_t)512 * DM; idx += nthr) {
            const int n = (int)(idx & (DM - 1)), k = (int)(idx >> 10), gidx = k >> 7;
            const float* wp = c.in[I_WPOOL] + (size_t)k * 128;
            const float* ps = c.in[I_PSCALE] + gidx * 128;
            const float* wo = c.in[I_WOUT] + (size_t)(gidx * 128) * DM + n;
            float a = 0.f;
#pragma unroll 8
            for (int d = 0; d < 128; ++d) a += wp[d] * ps[d] * wo[(size_t)d * DM];
            const unsigned pk = cvt_pk_bf16(a, 0.f);
            Wout_t[(size_t)n * DM + k] = (bf16_t)(pk & 0xffffu);
        }
        for (size_t i8 = gtid; i8 < (size_t)DM * DM / 8; i8 += nthr) {
            const float gsc = c.in[I_LN1G][(i8 * 8) >> 10]; const f32x4 a = *(const f32x4*)(c.in[I_WXQ] + i8 * 8) * gsc, b4 = *(const f32x4*)(c.in[I_WXQ] + i8 * 8 + 4) * gsc;
            u32x4 o; o.x = cvt_pk_bf16(a[0], a[1]); o.y = cvt_pk_bf16(a[2], a[3]); o.z = cvt_pk_bf16(b4[0], b4[1]); o.w = cvt_pk_bf16(b4[2], b4[3]); *(u32x4*)(Wxq_t + i8 * 8) = o; }
        for (size_t i4 = gtid; i4 < (size_t)BATCH * 8 * NBLK * 64 / 4; i4 += nthr) *((f32x4*)KM + i4) = (f32x4){0.f, 0.f, 0.f, 0.f};
        cvt_rows_bf16(c.in[I_X], XB, (size_t)TOK * DM / 8, gtid, nthr);
        cvt_rows_bf16(c.in[I_MEM], MEMB, (size_t)MEMROWS * DM / 8, gtid, nthr);
    }
    if constexpr (PH == 1) {
        { pg8::Gemm g{XB, Win_t, TOK, INW, DM}; pg8::StaticOrder S; S.init(TOK, INW, G, bx); pg8::EpiBf16 E{Z, INW, KM}; pg8::gemm_phase(lds, g, S, E); }
        { pg8::Gemm g{MEMB, Wxkv_t, MEMROWS, 2048, DM}; pg8::StaticOrder S; S.init(MEMROWS, 2048, G, bx); pg8::EpiBf16 E{MEMKV, 2048}; pg8::gemm_phase(lds, g, S, E); }
    }
    if constexpr (PH == 2) {
        for (int run = gw; run < TOK / 32; run += NGW) {
            const int wdw = 2 << (lane >> 4);
            const size_t t0 = (size_t)run * 32; const int tpos0 = (int)(t0 & (SEQ - 1));
            const bf16_t* up = Z + t0 * INW + lane * 8;
            bf16_t* op = MIX + t0 * DM + lane * 8;
            float sacc[8] = {0.f, 0.f, 0.f, 0.f, 0.f, 0.f, 0.f, 0.f};
#pragma unroll 1
            for (int ib = 1; ib <= 16; ib += 8) { bf16x8 ui[8]; bool ok[8];
#pragma unroll
                for (int q = 0; q < 8; ++q) { const int i = ib + q; ok[q] = (i <= wdw && tpos0 - i >= 0); ui[q] = *(const bf16x8*)(up - (size_t)(ok[q] ? i : 0) * INW); }
#pragma unroll
                for (int q = 0; q < 8; ++q) if (ok[q]) {
#pragma unroll
                    for (int e8 = 0; e8 < 8; ++e8) sacc[e8] += bf2f((unsigned short)ui[q][e8]); } }
#pragma unroll 1
            for (int tb = 0; tb < 32; tb += 8) {
                bf16x8 un[8], uo[8];
#pragma unroll
                for (int i = 0; i < 8; ++i) { un[i] = *(const bf16x8*)(up + (size_t)(tb + i) * INW);
                    const int told = tpos0 + tb + i - wdw; uo[i] = *(const bf16x8*)(up + (size_t)(tb + i - (told >= 0 ? wdw : 0)) * INW); }
#pragma unroll
                for (int i = 0; i < 8; ++i) { const int tpos = tpos0 + tb + i; const bool sub = tpos - wdw >= 0;
                    const float rc = 1.0f / (float)((tpos + 1 < wdw) ? tpos + 1 : wdw); float p[8];
#pragma unroll
                    for (int e8 = 0; e8 < 8; ++e8) { const float uv = bf2f((unsigned short)un[i][e8]); sacc[e8] += uv; if (sub) sacc[e8] -= bf2f((unsigned short)uo[i][e8]); p[e8] = sacc[e8] * rc - uv; }
                    u32x4 pw; pw.x = cvt_pk_bf16(p[0], p[1]); pw.y = cvt_pk_bf16(p[2], p[3]); pw.z = cvt_pk_bf16(p[4], p[5]); pw.w = cvt_pk_bf16(p[6], p[7]);
                    *(u32x4*)(op + (size_t)(tb + i) * DM) = pw; }
            }
        }
    }
    if constexpr (PH == 2) {
        bf16_t* BtM = WSP(bf16_t, WS_BTM); bf16_t* BtN = WSP(bf16_t, WS_BTN); float* CB = WSP(float, WS_CDB); float* DB = CB + 16 * 1024;
        { pg8::Gemm g{MEMKV, Wxq_t, 64 * 256, 1024, 256, 2048, 1024, 2}; pg8::StaticOrder S; S.init(64 * 256, 1024, G, bx); pg8::EpiPrep E{BtM, 0.0625f, 0}; pg8::gemm_phase(lds, g, S, E); }
        { pg8::Gemm g{Wxo_t, MEMKV + 1024, 64 * 256, 1024, 256, 1024, 2048, 3}; pg8::StaticOrder S; S.init(64 * 256, 1024, G, bx); pg8::EpiPrep E{BtN, 1.0f, 1}; pg8::gemm_phase(lds, g, S, E); }
        const float* cx = WSP(float, WS_CDX); const float* dx = cx + DM;
        for (int o8 = vcu * 512 + tid; o8 < 16 * 1024 * 8; o8 += G * 512) {
            const int o = o8 >> 3, part = o8 & 7;
            const int bt = o >> 10, hm = o & 1023, hh = hm >> 8, mm = hm & 255;
            const bf16_t* kr = MEMKV + (size_t)(bt * 256 + mm) * 2048 + hh * 256; float ca = 0.f, da = 0.f;
#pragma unroll
            for (int it = 0; it < 4; ++it) { const int d8 = part + 8 * it; const bf16x8 kv = *(const bf16x8*)(kr + d8 * 8);
                const f32x4 c0 = *(const f32x4*)(cx + hh * 256 + d8 * 8), c1 = *(const f32x4*)(cx + hh * 256 + d8 * 8 + 4), d0 = *(const f32x4*)(dx + hh * 256 + d8 * 8), d1 = *(const f32x4*)(dx + hh * 256 + d8 * 8 + 4);
#pragma unroll
                for (int e8 = 0; e8 < 8; ++e8) { const float kf = bf2f((unsigned short)kv[e8]); ca += (e8 < 4 ? c0[e8 & 3] : c1[e8 & 3]) * kf; da += (e8 < 4 ? d0[e8 & 3] : d1[e8 & 3]) * kf; } }
            ca += __shfl_xor(ca, 1); ca += __shfl_xor(ca, 2); ca += __shfl_xor(ca, 4); da += __shfl_xor(da, 1); da += __shfl_xor(da, 2); da += __shfl_xor(da, 4);
            if (part == 0) { CB[o] = ca * 0.0625f; DB[o] = da * 0.0625f; }
        }
    }
    if constexpr (PH == 3) {
        for (int it = 0; it * G < BATCH * 8 * NBLK; ++it) {
            const int u = it * G + vcu; if (u >= BATCH * 8 * NBLK) break;
            int bh = u >> 4, blk = u & 15;
            if (G == 256) { bh = it * 16 + (vcu >> 4); blk = ((vcu & 15) + 2 * it) & 15; }
            moba_unit(bh >> 3, bh & 7, blk, Z, KM, MIX, lds);
        }
    }
    if constexpr (PH == 4) { pg8::Gemm g{MIX, Wout_t, TOK, DM, DM}; pg8::StaticOrder S; S.init(TOK, DM, G, bx); pg8::EpiResStat<false, true> E{XB, XB, DM, ALPHA, nullptr, nullptr, nullptr, PST1}; pg8::gemm_phase(lds, g, S, E); }
    if constexpr (PH == 5) { }
    if constexpr (PH == 6) { pg8::Gemm g{XB, WSP(bf16_t, WS_BTM), TOK, DM, DM, 0, 0, 1, (size_t)DM * DM * 2}; pg8::StaticOrder S; S.init(TOK, DM, G, bx); pg8::EpiSoftmaxP E{XQ, PST1, WSP(float, WS_CDB), WSP(float, WS_CDB) + 16 * 1024, (LAS float*)(lds + 131072)}; pg8::gemm_phase(lds, g, S, E); }
    if constexpr (PH == 7) { for (int u = vcu; u < (TOK / 128) * 4; u += G) xattn_unit(u >> 2, u & 3, XQ, MEMKV, XO, lds); }
    if constexpr (PH == 8) { pg8::Gemm g{XQ, WSP(bf16_t, WS_BTN), TOK, DM, DM, 0, 0, 1, (size_t)DM * DM * 2}; pg8::StaticOrder S; S.init(TOK, DM, G, bx); pg8::EpiResStat<true, true> E{XB, XB, DM, ALPHA, PST1, c.in[I_LN1G], c.in[I_LN1B], PST2}; pg8::gemm_phase(lds, g, S, E); }
    if constexpr (PH == 9) { }
    if constexpr (PH == 10) { pg8::Gemm g{XB, Wgu_t, TOK, 2 * DFF, DM}; pg8::StaticOrder S; S.init(TOK, 2 * DFF, G, bx); pg8::EpiLnSwiGLU E{HF, DFF, PST2, WSP(float, WS_CDG), WSP(float, WS_CDG) + 2 * DFF}; pg8::gemm_phase(lds, g, S, E); }
    if constexpr (PH == 11) { pg8::Gemm g{HF, Wdn_t, TOK, DM, DFF}; pg8::StaticOrder S; S.init(TOK, DM, G, bx, 1); pg8::EpiResStat<true, false> E{XB, XB, DM, ALPHA, PST2, c.in[I_LN2G], c.in[I_LN2B], nullptr}; pg8::gemm_phase(lds, g, S, E); }
    if constexpr (PH == 12) { for (int r = gw * 4; r < TOK; r += NGW * 4) ln_rows4_bf16in(XB + (size_t)r * DM, c.in[I_LN3G], c.in[I_LN3B], H + (size_t)r * DM, DM, lane); }
}

__global__ void __launch_bounds__(512, 2) fwd_kernel(Args args) {
    extern __shared__ __attribute__((aligned(16))) unsigned char lds_raw[];
    Ctx c;
    c.in = args.in; c.lds = (LAS unsigned char*)lds_raw; c.ws = args.ws; c.H = args.out;
    c.tid = threadIdx.x; c.lane = c.tid & 63; c.wave = __builtin_amdgcn_readfirstlane(c.tid >> 6);
    c.G = gridDim.x; c.bx = blockIdx.x;
    c.vcu = (c.G % 8 == 0) ? (c.bx % 8) * (c.G / 8) + c.bx / 8 : c.bx;
    c.gw = c.vcu * 8 + c.wave; c.NGW = c.G * 8;
    const int lo = args.ph_lo, hi = args.ph_hi;
    volatile LAS unsigned* MISC = (volatile LAS unsigned*)(c.lds + LDS_MISC);
    if (c.tid < 2) MISC[c.tid] = 0u;
    __syncthreads();
    XcdBarrier bar; bar.bar = (unsigned*)(args.ws + WS_CTL); bar.x = 0; bar.st = MISC;
    if (hi - lo > 1) bar = xcd_barrier_post((unsigned*)(args.ws + WS_CTL), MISC);
    if (hi < 0) cg::this_grid().sync();
#define IN(k) (lo <= (k) && (k) < hi)
#define PHASE(k) do { if (IN(k)) { run_phase<k>(c); if (PROBE_PHASE == (k)) { xcd_barrier(bar); run_phase<k>(c); } } \
        if (IN(k) && IN((k) + 1)) { xcd_barrier(bar); } } while (0)
    PHASE(0); PHASE(1);
    if (IN(3)) run_phase<3>(c);
    __syncthreads();
    if (IN(2)) run_phase<2>(c);
    if (IN(3) && IN(4)) xcd_barrier(bar);
    PHASE(4); PHASE(6); PHASE(8); PHASE(10); PHASE(11); PHASE(12);
#undef IN
#undef PHASE
}

extern "C" void kernel_launch(void* const* d_in, const int* in_sizes, int n_in, void* d_out, int out_size, void* d_ws, size_t ws_size, hipStream_t stream) {
    static int grid = 0;
    if (grid == 0) {
        if (n_in != 18 || out_size != TOK * DM || ws_size < WS_END) { fprintf(stderr, "kernel_launch: unexpected shapes (n_in %d, out %d, ws %zu)\n", n_in, out_size, ws_size); grid = -1; return; }
        int dev = 0, cus = 0, per_cu = 0;
        (void)hipGetDevice(&dev); (void)hipDeviceGetAttribute(&cus, hipDeviceAttributeMultiprocessorCount, dev);
        if (hipFuncSetAttribute((const void*)fwd_kernel, hipFuncAttributeMaxDynamicSharedMemorySize, LDS_BYTES) != hipSuccess) { fprintf(stderr, "kernel_launch: hipFuncSetAttribute failed\n"); grid = -1; return; }
        if (hipOccupancyMaxActiveBlocksPerMultiprocessor(&per_cu, (const void*)fwd_kernel, 512, LDS_BYTES) != hipSuccess || per_cu < 1) { fprintf(stderr, "kernel_launch: occupancy query says %d\n", per_cu); per_cu = 1; }
        (void)hipGetLastError();
        grid = cus * 1;
        if (grid <= 0) grid = 256;
    }
    if (grid < 0) return;
    Args a{};
    for (int i = 0; i < 18; ++i) a.in[i] = (const float*)d_in[i];
    a.out = (float*)d_out; a.ws = (unsigned char*)d_ws;
#if N_LAUNCH_MODE == 1
    for (int p = 0; p < N_PHASES; ++p) { a.ph_lo = p; a.ph_hi = p + 1; hipLaunchKernelGGL(fwd_kernel, dim3(grid), dim3(512), LDS_BYTES, stream, a); }
#else
    a.ph_lo = 0; a.ph_hi = N_PHASES;
    (void)hipMemsetAsync((unsigned char*)d_ws + WS_CTL, 0, CTL_BYTES, stream);
    void* kargs[] = {&a};
    hipError_t e = hipLaunchCooperativeKernel((const void*)fwd_kernel, dim3(grid), dim3(512), kargs, LDS_BYTES, stream);
    if (e != hipSuccess) fprintf(stderr, "kernel_launch: cooperative launch failed: %s (grid %d)\n", hipGetErrorString(e), grid);
#endif
}
```

```cpp
#include <hip/hip_runtime.h>
#include <hip/hip_cooperative_groups.h>
#include <cstdio>
#include <cstdint>
namespace cg = cooperative_groups;

#ifndef N_LAUNCH_MODE
#define N_LAUNCH_MODE 0
#endif

#define LAS __attribute__((address_space(3)))
typedef unsigned short bf16_t;
typedef short bf16x8 __attribute__((ext_vector_type(8)));
typedef short s16x4 __attribute__((ext_vector_type(4)));
typedef float f32x4 __attribute__((ext_vector_type(4)));
typedef float f32x2 __attribute__((ext_vector_type(2)));
typedef unsigned u32x4 __attribute__((ext_vector_type(4)));
typedef unsigned u32x2 __attribute__((ext_vector_type(2)));

constexpr int BATCH = 16, SEQ = 4096, DM = 1024, TOK = BATCH * SEQ;
constexpr int MEMLEN = 256, MEMROWS = BATCH * MEMLEN;
constexpr int INW = 2048, DFF = 2816, NBLK = SEQ / 256;
constexpr float ALPHA = 1.189207115002721f;
constexpr float LN_EPS = 1e-5f;
constexpr float LOG2E = 1.4426950408889634f;

constexpr size_t MiB = 1u << 20;
constexpr size_t WS_KM = 0;
constexpr size_t WS_CTL = 1 * MiB, CTL_BYTES = 16384;
constexpr size_t WS_WIN = 2 * MiB, WS_WOUT = 6 * MiB, WS_WXQ = 8 * MiB, WS_WXKV = 10 * MiB, WS_WXO = 14 * MiB, WS_WGU = 16 * MiB, WS_WDN = 27 * MiB, WS_WPOOL = 33 * MiB;
constexpr size_t WS_MEMB = 34 * MiB, WS_MEMKV = 42 * MiB;
constexpr size_t WS_XB = 64 * MiB;
constexpr size_t WS_Z = 192 * MiB;
constexpr size_t WS_MIX = 448 * MiB;
constexpr size_t WS_HF = 192 * MiB;
constexpr size_t WS_PST1 = 576 * MiB, WS_PST2 = 584 * MiB;
constexpr size_t WS_CDX = 60 * MiB, WS_CDG = 60 * MiB + 65536;
constexpr size_t WS_CDB = 60 * MiB + 131072;
constexpr size_t WS_BTM = 592 * MiB, WS_BTN = 624 * MiB;
constexpr size_t WS_END = 656 * MiB;

typedef __bf16 bf16x2_t __attribute__((ext_vector_type(2)));
__device__ __forceinline__ unsigned cvt_pk_bf16(float lo, float hi) { f32x2 v = {lo, hi}; bf16x2_t b = __builtin_convertvector(v, bf16x2_t); return __builtin_bit_cast(unsigned, b); }
__device__ __forceinline__ float xmax16(float v) { auto r = __builtin_amdgcn_permlane16_swap(__float_as_uint(v), __float_as_uint(v), false, false); return fmaxf(__uint_as_float(r[0]), __uint_as_float(r[1])); }
__device__ __forceinline__ float xmax32(float v) { auto r = __builtin_amdgcn_permlane32_swap(__float_as_uint(v), __float_as_uint(v), false, false); return fmaxf(__uint_as_float(r[0]), __uint_as_float(r[1])); }
__device__ __forceinline__ float xsum16(float v) { auto r = __builtin_amdgcn_permlane16_swap(__float_as_uint(v), __float_as_uint(v), false, false); return __uint_as_float(r[0]) + __uint_as_float(r[1]); }
__device__ __forceinline__ float xsum32(float v) { auto r = __builtin_amdgcn_permlane32_swap(__float_as_uint(v), __float_as_uint(v), false, false); return __uint_as_float(r[0]) + __uint_as_float(r[1]); }
__device__ __forceinline__ float bf2f(unsigned short b) { return __uint_as_float(((unsigned)b) << 16); }
__device__ __forceinline__ float wave_sum(float v) {
#pragma unroll
    for (int o = 1; o < 64; o <<= 1) v += __shfl_xor(v, o);
    return v;
}

namespace pg8 {
constexpr int BM = 256, BK = 64, HALF = 128, HTB = HALF * BK * 2, STAGE_BYTES = 8 * HTB, NXCD = 8, WGM = 4;
__host__ __device__ __forceinline__ int lds_byte(int r, int c) { const int st = (r >> 4) * 2 + (c >> 5), rr = r & 15, cc = c & 31, ob = rr * 64 + cc * 2; return st * 1024 + (ob ^ (((ob >> 9) & 1) << 5)); }
__host__ __device__ __forceinline__ void stage_rc(int b, int& R, int& C) { const int st = b / 1024, sb = b % 1024, swz = sb ^ (((sb >> 9) & 1) << 5); R = (st >> 1) * 16 + swz / 64; C = (st & 1) * 32 + (swz % 64) / 2; }
__host__ __device__ __forceinline__ int perm32(int rho) { const int n = rho >> 4, i = rho & 15; return 8 * (i >> 2) + 4 * n + (i & 3); }

struct Unit { int pm, pn; };
struct Gemm { const bf16_t* A; const bf16_t* Bt; int M, N, K; int lda = 0, ldb = 0, mode = 0; size_t s1 = 0; };
__device__ __forceinline__ void unit_ptrs(const Gemm& g, const Unit& u, const char*& cA, const char*& cB) {
    const int lda = g.lda ? g.lda : g.K, ldb = g.ldb ? g.ldb : g.K;
    if (g.mode <= 1) { cA = (const char*)g.A + (size_t)u.pm * BM * lda * 2; cB = (const char*)g.Bt + (size_t)u.pn * BM * ldb * 2 + (g.mode == 1 ? (size_t)(u.pm >> 4) * g.s1 : 0); }
    else if (g.mode == 2) { cA = (const char*)g.A + (size_t)(u.pm >> 2) * 256 * lda * 2 + (size_t)(u.pm & 3) * 512; cB = (const char*)g.Bt + (size_t)u.pn * BM * ldb * 2 + (size_t)(u.pm & 3) * 512; }
    else { cA = (const char*)g.A + (size_t)u.pn * BM * lda * 2 + (size_t)(u.pm & 3) * 512; cB = (const char*)g.Bt + (size_t)(u.pm >> 2) * 256 * ldb * 2 + (size_t)(u.pm & 3) * 512; }
}

struct StaticOrder {
    int nM, nN, nwg, G, c, rev;
    __device__ void init(int M, int N, int G_, int c_, int rev_ = 0) { nM = M / BM; nN = N / BM; nwg = nM * nN; G = G_; c = c_; rev = rev_; }
    __device__ bool next(int i, Unit& u) const {
        const long L = (long)i * G + c; if (L >= nwg) return false;
        int wgid = (int)L; { const int q = nwg / NXCD, r = nwg % NXCD, xcd = wgid % NXCD; int off = wgid / NXCD; if (rev && r == 0) off = q - 1 - off; wgid = (xcd < r ? xcd * (q + 1) : r * (q + 1) + (xcd - r) * q) + off; }
        const int nig = WGM * nN, gid = wgid / nig, fm = gid * WGM, gsz = (nM - fm) < WGM ? (nM - fm) : WGM;
        u.pm = fm + ((wgid % nig) % gsz); u.pn = (wgid % nig) / gsz; return true;
    }
};

struct EpiBf16 {
    static constexpr bool PERM = true;
    bf16_t* O; int ldc; float* km = nullptr;
    __device__ __forceinline__ void operator()(const f32x4 (&acc)[2][2][4][2], const Unit& u, int wr, int wc, int fr, int fq) const {
        const int row0 = u.pm * BM + wr * 64 + fr; const int col0 = u.pn * BM + wc * 32 + 8 * fq;
#pragma unroll
        for (int ai = 0; ai < 2; ++ai)
#pragma unroll
            for (int m = 0; m < 4; ++m) { bf16_t* rowp = O + (size_t)(row0 + ai * HALF + m * 16) * ldc + col0;
#pragma unroll
                for (int bj = 0; bj < 2; ++bj) { const f32x4 v0 = acc[ai][bj][m][0], v1 = acc[ai][bj][m][1];
                    u32x4 w; w.x = cvt_pk_bf16(v0[0], v0[1]); w.y = cvt_pk_bf16(v0[2], v0[3]); w.z = cvt_pk_bf16(v1[0], v1[1]); w.w = cvt_pk_bf16(v1[2], v1[3]);
                    *(u32x4*)(rowp + bj * HALF) = w; } }
        if (km && (u.pn == 4 || u.pn == 5)) {
#pragma unroll
            for (int bj = 0; bj < 2; ++bj)
#pragma unroll
                for (int n = 0; n < 2; ++n) { f32x4 cs = (f32x4){0.f, 0.f, 0.f, 0.f};
#pragma unroll
                    for (int ai = 0; ai < 2; ++ai)
#pragma unroll
                        for (int m = 0; m < 4; ++m) cs = cs + acc[ai][bj][m][n];
#pragma unroll
                    for (int j = 0; j < 4; ++j) { float v = cs[j]; v += __shfl_xor(v, 1); v += __shfl_xor(v, 2); v += __shfl_xor(v, 4); v += __shfl_xor(v, 8);
                        if (fr == 0) { const int kc = (u.pn - 4) * 256 + bj * HALF + wc * 32 + 8 * fq + 4 * n + j;
                            __hip_atomic_fetch_add(km + (size_t)(((u.pm >> 4) * 8 + (kc >> 6)) * 16 + (u.pm & 15)) * 64 + (kc & 63), v * (1.0f / 256.0f), __ATOMIC_RELAXED, __HIP_MEMORY_SCOPE_AGENT); } } }
        }
    }
};
__device__ __forceinline__ void row_stats(const float* pst, int row, int fq, float& mu, float& rstd) {
    const f32x4 a = *(const f32x4*)(pst + (size_t)row * 32 + 8 * fq), b = *(const f32x4*)(pst + (size_t)row * 32 + 8 * fq + 4);
    float s1 = (a[0] + a[2]) + (b[0] + b[2]), s2 = (a[1] + a[3]) + (b[1] + b[3]);
    s1 = xsum32(xsum16(s1)); s2 = xsum32(xsum16(s2));
    mu = s1 * (1.0f / 1024.0f); const float var = s2 * (1.0f / 1024.0f) - mu * mu; rstd = 1.0f / sqrtf(var + LN_EPS);
}
template <bool HAS_LN, bool HAS_OUT> struct EpiResStat {
    static constexpr bool PERM = true;
    const bf16_t* R; bf16_t* YB; int ldc; float alpha; const float* st_in; const float* g; const float* b; float* st_out;
    __device__ __forceinline__ void operator()(const f32x4 (&acc)[2][2][4][2], const Unit& u, int wr, int wc, int fr, int fq) const {
        const int row0 = u.pm * BM + wr * 64 + fr; const int col0 = u.pn * BM + wc * 32 + 8 * fq;
        f32x4 gv[2][2], bv[2][2];
        if (HAS_LN) {
#pragma unroll
            for (int bj = 0; bj < 2; ++bj)
#pragma unroll
                for (int n = 0; n < 2; ++n) { gv[bj][n] = *(const f32x4*)(g + col0 + bj * HALF + 4 * n); bv[bj][n] = *(const f32x4*)(b + col0 + bj * HALF + 4 * n); }
        }
#pragma unroll
        for (int ai = 0; ai < 2; ++ai)
#pragma unroll
            for (int m = 0; m < 4; ++m) { const int row = row0 + ai * HALF + m * 16; const size_t off = (size_t)row * ldc + col0;
                float mu = 0.f, rs = 1.f; if (HAS_LN) row_stats(st_in, row, fq, mu, rs);
                float s1 = 0.f, s2 = 0.f;
#pragma unroll
                for (int bj = 0; bj < 2; ++bj) { const u32x4 rr = *(const u32x4*)(R + off + bj * HALF);
                    f32x4 v0 = (f32x4){__uint_as_float(rr.x << 16), __uint_as_float(rr.x & 0xffff0000u), __uint_as_float(rr.y << 16), __uint_as_float(rr.y & 0xffff0000u)};
                    f32x4 v1 = (f32x4){__uint_as_float(rr.z << 16), __uint_as_float(rr.z & 0xffff0000u), __uint_as_float(rr.w << 16), __uint_as_float(rr.w & 0xffff0000u)};
                    if (HAS_LN) { v0 = (v0 - mu) * rs * gv[bj][0] + bv[bj][0]; v1 = (v1 - mu) * rs * gv[bj][1] + bv[bj][1]; }
                    const f32x4 y0 = v0 * alpha + acc[ai][bj][m][0], y1 = v1 * alpha + acc[ai][bj][m][1];
                    u32x4 w; w.x = cvt_pk_bf16(y0[0], y0[1]); w.y = cvt_pk_bf16(y0[2], y0[3]); w.z = cvt_pk_bf16(y1[0], y1[1]); w.w = cvt_pk_bf16(y1[2], y1[3]);
                    *(u32x4*)(YB + off + bj * HALF) = w;
                    s1 += ((y0[0] + y0[1]) + (y0[2] + y0[3])) + ((y1[0] + y1[1]) + (y1[2] + y1[3]));
                    s2 += ((y0[0] * y0[0] + y0[1] * y0[1]) + (y0[2] * y0[2] + y0[3] * y0[3])) + ((y1[0] * y1[0] + y1[1] * y1[1]) + (y1[2] * y1[2] + y1[3] * y1[3])); }
                if (HAS_OUT) { s1 = xsum32(xsum16(s1)); s2 = xsum32(xsum16(s2));
                    if (fq == 0) *(f32x2*)(st_out + (size_t)row * 32 + (u.pn * 4 + wc) * 2) = (f32x2){s1, s2}; } }
    }
};
struct EpiLnBf16 {
    static constexpr bool PERM = true;
    bf16_t* O; int ldc; const float* st_in; const float* cvec; const float* dvec;
    __device__ __forceinline__ void operator()(const f32x4 (&acc)[2][2][4][2], const Unit& u, int wr, int wc, int fr, int fq) const {
        const int row0 = u.pm * BM + wr * 64 + fr; const int col0 = u.pn * BM + wc * 32 + 8 * fq;
        f32x4 cv[2][2], dv[2][2];
#pragma unroll
        for (int bj = 0; bj < 2; ++bj)
#pragma unroll
            for (int n = 0; n < 2; ++n) { cv[bj][n] = *(const f32x4*)(cvec + col0 + bj * HALF + 4 * n); dv[bj][n] = *(const f32x4*)(dvec + col0 + bj * HALF + 4 * n); }
#pragma unroll
        for (int ai = 0; ai < 2; ++ai)
#pragma unroll
            for (int m = 0; m < 4; ++m) { const int row = row0 + ai * HALF + m * 16; bf16_t* rowp = O + (size_t)row * ldc + col0;
                float mu, rs; row_stats(st_in, row, fq, mu, rs);
#pragma unroll
                for (int bj = 0; bj < 2; ++bj) { const f32x4 v0 = (acc[ai][bj][m][0] - cv[bj][0] * mu) * rs + dv[bj][0], v1 = (acc[ai][bj][m][1] - cv[bj][1] * mu) * rs + dv[bj][1];
                    u32x4 w; w.x = cvt_pk_bf16(v0[0], v0[1]); w.y = cvt_pk_bf16(v0[2], v0[3]); w.z = cvt_pk_bf16(v1[0], v1[1]); w.w = cvt_pk_bf16(v1[2], v1[3]);
                    *(u32x4*)(rowp + bj * HALF) = w; } }
    }
};
struct EpiLnSwiGLU {
    static constexpr bool PERM = false;
    bf16_t* O; int ldc; const float* st_in; const float* cvec; const float* dvec;
    __device__ __forceinline__ void operator()(const f32x4 (&acc)[2][2][4][2], const Unit& u, int wr, int wc, int fr, int fq) const {
        const int row0 = u.pm * BM + wr * 64 + fr; const int col0 = u.pn * HALF + wc * 16 + 4 * fq; const int gcol0 = u.pn * BM + wc * 32 + 4 * fq;
        f32x4 cv[2][2], dv[2][2];
#pragma unroll
        for (int bj = 0; bj < 2; ++bj)
#pragma unroll
            for (int n = 0; n < 2; ++n) { cv[bj][n] = *(const f32x4*)(cvec + gcol0 + bj * HALF + 16 * n); dv[bj][n] = *(const f32x4*)(dvec + gcol0 + bj * HALF + 16 * n); }
#pragma unroll
        for (int ai = 0; ai < 2; ++ai)
#pragma unroll
            for (int m = 0; m < 4; ++m) { const int row = row0 + ai * HALF + m * 16; bf16_t* rowp = O + (size_t)row * ldc + col0;
                float mu, rs; row_stats(st_in, row, fq, mu, rs);
#pragma unroll
                for (int bj = 0; bj < 2; ++bj) { const f32x4 g = (acc[ai][bj][m][0] - cv[bj][0] * mu) * rs + dv[bj][0], up = (acc[ai][bj][m][1] - cv[bj][1] * mu) * rs + dv[bj][1]; float h[4];
#pragma unroll
                    for (int j = 0; j < 4; ++j) { const float s = g[j] * __builtin_amdgcn_rcpf(1.0f + __builtin_amdgcn_exp2f(-g[j] * LOG2E)); h[j] = s * up[j]; }
                    u32x2 w; w.x = cvt_pk_bf16(h[0], h[1]); w.y = cvt_pk_bf16(h[2], h[3]);
                    *(u32x2*)(rowp + bj * 64) = w; } }
    }
};

struct EpiPrep {
    static constexpr bool PERM = true;
    bf16_t* O; float scale; int omode;
    __device__ __forceinline__ void operator()(const f32x4 (&acc)[2][2][4][2], const Unit& u, int wr, int wc, int fr, int fq) const {
        bf16_t* base = (omode == 0) ? O + (size_t)u.pm * 256 * 1024 + u.pn * 256 : O + (size_t)(u.pm >> 2) * 1048576 + (size_t)u.pn * 256 * 1024 + (u.pm & 3) * 256;
        base += (size_t)(wr * 64 + fr) * 1024 + wc * 32 + 8 * fq;
#pragma unroll
        for (int ai = 0; ai < 2; ++ai)
#pragma unroll
            for (int m = 0; m < 4; ++m) { bf16_t* rowp = base + (size_t)(ai * HALF + m * 16) * 1024;
#pragma unroll
                for (int bj = 0; bj < 2; ++bj) { const f32x4 v0 = acc[ai][bj][m][0] * scale, v1 = acc[ai][bj][m][1] * scale;
                    u32x4 w; w.x = cvt_pk_bf16(v0[0], v0[1]); w.y = cvt_pk_bf16(v0[2], v0[3]); w.z = cvt_pk_bf16(v1[0], v1[1]); w.w = cvt_pk_bf16(v1[2], v1[3]);
                    *(u32x4*)(rowp + bj * HALF) = w; } }
    }
};
struct EpiSoftmaxP {
    static constexpr bool PERM = true;
    bf16_t* P; const float* st_in; const float* cb; const float* db; LAS float* xb;
    __device__ __forceinline__ void operator()(f32x4 (&acc)[2][2][4][2], const Unit& u, int wr, int wc, int fr, int fq) const {
        const int rl0 = wr * 64 + fr; const int col0 = u.pn * BM + wc * 32 + 8 * fq; const int bt = u.pm >> 4;
        {
            f32x4 cv[2][2], dv[2][2];
#pragma unroll
            for (int bj = 0; bj < 2; ++bj)
#pragma unroll
                for (int n = 0; n < 2; ++n) { cv[bj][n] = *(const f32x4*)(cb + bt * 1024 + col0 + bj * HALF + 4 * n); dv[bj][n] = *(const f32x4*)(db + bt * 1024 + col0 + bj * HALF + 4 * n); }
#pragma unroll
            for (int ai = 0; ai < 2; ++ai)
#pragma unroll
                for (int m = 0; m < 4; ++m) { const int rl = rl0 + ai * HALF + m * 16;
                    float mu, rs; row_stats(st_in, u.pm * BM + rl, fq, mu, rs);
                    float mx = -INFINITY;
#pragma unroll
                    for (int bj = 0; bj < 2; ++bj)
#pragma unroll
                        for (int n = 0; n < 2; ++n) { const f32x4 s = (acc[ai][bj][m][n] - cv[bj][n] * mu) * rs + dv[bj][n]; acc[ai][bj][m][n] = s;
                            mx = fmaxf(fmaxf(mx, s[0]), fmaxf(s[1], fmaxf(s[2], s[3]))); }
                    mx = xmax32(xmax16(mx));
                    if (fq == 0) xb[rl * 4 + wc] = mx; }
        }
        asm volatile("s_waitcnt lgkmcnt(0)" ::: "memory"); __builtin_amdgcn_s_barrier(); asm volatile("" ::: "memory");
#pragma unroll
        for (int ai = 0; ai < 2; ++ai)
#pragma unroll
            for (int m = 0; m < 4; ++m) { const int rl = rl0 + ai * HALF + m * 16;
                const f32x4 mm = *(const LAS f32x4*)(xb + rl * 4); const float rmax = fmaxf(fmaxf(mm[0], mm[1]), fmaxf(mm[2], mm[3])) * LOG2E;
                float sm = 0.f;
#pragma unroll
                for (int bj = 0; bj < 2; ++bj)
#pragma unroll
                    for (int n = 0; n < 2; ++n) { f32x4 p;
#pragma unroll
                        for (int j = 0; j < 4; ++j) p[j] = __builtin_amdgcn_exp2f(__builtin_fmaf(acc[ai][bj][m][n][j], LOG2E, -rmax));
                        acc[ai][bj][m][n] = p; sm += (p[0] + p[1]) + (p[2] + p[3]); }
                sm = xsum32(xsum16(sm));
                if (fq == 0) xb[1024 + rl * 4 + wc] = sm; }
        asm volatile("s_waitcnt lgkmcnt(0)" ::: "memory"); __builtin_amdgcn_s_barrier(); asm volatile("" ::: "memory");
#pragma unroll
        for (int ai = 0; ai < 2; ++ai)
#pragma unroll
            for (int m = 0; m < 4; ++m) { const int rl = rl0 + ai * HALF + m * 16;
                const f32x4 ss = *(const LAS f32x4*)(xb + 1024 + rl * 4); const float inv = 1.0f / ((ss[0] + ss[1]) + (ss[2] + ss[3]));
                bf16_t* rowp = P + (size_t)(u.pm * BM + rl) * 1024 + col0;
#pragma unroll
                for (int bj = 0; bj < 2; ++bj) { const f32x4 v0 = acc[ai][bj][m][0] * inv, v1 = acc[ai][bj][m][1] * inv;
                    u32x4 w; w.x = cvt_pk_bf16(v0[0], v0[1]); w.y = cvt_pk_bf16(v0[2], v0[3]); w.z = cvt_pk_bf16(v1[0], v1[1]); w.w = cvt_pk_bf16(v1[2], v1[3]);
                    *(u32x4*)(rowp + bj * HALF) = w; } }
    }
};

template <class Epi, class Sched>
__device__ __forceinline__ void gemm_phase(LAS unsigned char* lds, const Gemm g, const Sched S, const Epi E) {
    const int tid = threadIdx.x, wid = __builtin_amdgcn_readfirstlane(tid >> 6), lane = tid & 63, wr = wid >> 2, wc = wid & 3, fr = lane & 15, fq = lane >> 4;
    const int K = g.K, nt = K / BK;
    const int lda = g.lda ? g.lda : K, ldb = g.ldb ? g.ldb : K;
    unsigned voffA[2], voffB[2];
#pragma unroll
    for (int i = 0; i < 2; ++i) { int R, C; stage_rc(tid * 16 + i * 8192, R, C); const int Rb = Epi::PERM ? ((R & ~31) + perm32(R & 31)) : R;
        voffA[i] = (unsigned)(R * lda + C) * 2u; voffB[i] = (unsigned)(Rb * ldb + C) * 2u; }
    const size_t kstep = (size_t)(BK * 2);
    const size_t hstepA = (size_t)HALF * lda * 2, hstepB = (size_t)HALF * ldb * 2;
    const unsigned ldsw = (unsigned)wid * 1024u;
    const int aoff = lds_byte(wr * 64 + fr, fq * 8), boff = lds_byte(wc * 32 + fr, fq * 8);
#define PG8_SA(b, h) (((b) * 2 + (h)) * HTB)
#define PG8_SB(b, h) ((4 + (b) * 2 + (h)) * HTB)
#define PG8_STAGE(bufoff, gbase, voff) do { _Pragma("unroll") for (int _i = 0; _i < 2; ++_i) \
        __builtin_amdgcn_global_load_lds((const unsigned*)((const char*)(gbase) + (voff)[_i]), (LAS unsigned*)(lds + (bufoff) + ldsw + _i * 8192), 16, 0, 0); } while (0)
#define PG8_LDA(dst, b, h) do { _Pragma("unroll") for (int m = 0; m < 4; ++m) _Pragma("unroll") for (int k = 0; k < 2; ++k) dst[m][k] = *(const LAS bf16x8*)(lds + PG8_SA(b, h) + aoff + m * 2048 + k * 1024); } while (0)
#define PG8_LDB(dst, b, h) do { _Pragma("unroll") for (int n = 0; n < 2; ++n) _Pragma("unroll") for (int k = 0; k < 2; ++k) dst[n][k] = *(const LAS bf16x8*)(lds + PG8_SB(b, h) + boff + n * 2048 + k * 1024); } while (0)
#define PG8_MMA(ai, bj, At, Bt) do { __builtin_amdgcn_s_setprio(1); _Pragma("unroll") for (int m = 0; m < 4; ++m) _Pragma("unroll") for (int n = 0; n < 2; ++n) _Pragma("unroll") for (int k = 0; k < 2; ++k) \
        acc[ai][bj][m][n] = __builtin_amdgcn_mfma_f32_16x16x32_bf16(Bt[n][k], At[m][k], acc[ai][bj][m][n], 0, 0, 0); __builtin_amdgcn_s_setprio(0); } while (0)
#define PG8_WAIT_V(n) asm volatile("s_waitcnt vmcnt(" #n ")" ::: "memory")
#define PG8_WAIT_L(n) asm volatile("s_waitcnt lgkmcnt(" #n ")" ::: "memory")
#define PG8_BAR __builtin_amdgcn_s_barrier()
#define PG8_SCHED __builtin_amdgcn_sched_barrier(0)
    Unit cur, nxt; int ui = 0;
    if (!S.next(0, cur)) return;
    f32x4 acc[2][2][4][2];
#pragma unroll
    for (int a = 0; a < 2; ++a)
#pragma unroll
        for (int b = 0; b < 2; ++b)
#pragma unroll
            for (int m = 0; m < 4; ++m)
#pragma unroll
                for (int n = 0; n < 2; ++n) acc[a][b][m][n] = (f32x4){0.f, 0.f, 0.f, 0.f};
    bf16x8 At[4][2], B0[2][2], B1[2][2];
    const char* cA; const char* cB; unit_ptrs(g, cur, cA, cB);
    PG8_STAGE(PG8_SB(0, 0), cB, voffB); PG8_STAGE(PG8_SB(0, 1), cB + hstepB, voffB); PG8_STAGE(PG8_SA(0, 0), cA, voffA); PG8_STAGE(PG8_SA(0, 1), cA + hstepA, voffA);
    if (wr == 1) PG8_BAR;
    PG8_WAIT_V(2); PG8_BAR;
    PG8_STAGE(PG8_SB(1, 0), cB + kstep, voffB); PG8_STAGE(PG8_SA(1, 0), cA + kstep, voffA); PG8_STAGE(PG8_SB(1, 1), cB + hstepB + kstep, voffB);
    PG8_WAIT_V(6); PG8_BAR;
    for (;;) {
        const bool has_next = S.next(ui + 1, nxt);
        const char* nA = cA; const char* nB = cB; if (has_next) unit_ptrs(g, nxt, nA, nB);
#pragma unroll 1
        for (int t = 0; t < nt; t += 2) {
            const bool last = (t == nt - 2);
            const char* a1 = cA + (size_t)(t + 1) * kstep;
            const char* a2 = last ? nA : cA + (size_t)(t + 2) * kstep; const char* b2 = last ? nB : cB + (size_t)(t + 2) * kstep;
            const char* a3 = a2 + kstep; const char* b3 = b2 + kstep;
            PG8_LDB(B0, 0, 0); PG8_LDB(B1, 0, 1); PG8_SCHED; PG8_LDA(At, 0, 0); PG8_STAGE(PG8_SA(1, 1), a1 + hstepA, voffA);
            PG8_WAIT_V(8); PG8_WAIT_L(0); PG8_BAR; PG8_MMA(0, 0, At, B0); PG8_MMA(0, 1, At, B1); PG8_BAR; PG8_SCHED;
            PG8_LDA(At, 0, 1); PG8_STAGE(PG8_SB(0, 0), b2, voffB); PG8_STAGE(PG8_SB(0, 1), b2 + hstepB, voffB); PG8_STAGE(PG8_SA(0, 0), a2, voffA);
            PG8_WAIT_V(8); PG8_WAIT_L(0); PG8_BAR; PG8_MMA(1, 0, At, B0); PG8_MMA(1, 1, At, B1); PG8_BAR; PG8_SCHED;
            PG8_LDB(B0, 1, 0); PG8_LDB(B1, 1, 1); PG8_SCHED; PG8_LDA(At, 1, 0); PG8_STAGE(PG8_SA(0, 1), a2 + hstepA, voffA);
            PG8_WAIT_V(8); PG8_WAIT_L(0); PG8_BAR; PG8_MMA(0, 0, At, B0); PG8_MMA(0, 1, At, B1); PG8_BAR; PG8_SCHED;
            PG8_LDA(At, 1, 1); PG8_STAGE(PG8_SB(1, 0), b3, voffB); PG8_STAGE(PG8_SB(1, 1), b3 + hstepB, voffB); PG8_STAGE(PG8_SA(1, 0), a3, voffA);
            PG8_WAIT_V(8); PG8_WAIT_L(0); PG8_BAR; PG8_MMA(1, 0, At, B0); PG8_MMA(1, 1, At, B1); PG8_BAR; PG8_SCHED;
        }
        if (wr == 0) PG8_BAR;
        E(acc, cur, wr, wc, fr, fq);
        if (!has_next) break;
#pragma unroll
        for (int a = 0; a < 2; ++a)
#pragma unroll
            for (int b = 0; b < 2; ++b)
#pragma unroll
                for (int m = 0; m < 4; ++m)
#pragma unroll
                    for (int n = 0; n < 2; ++n) acc[a][b][m][n] = (f32x4){0.f, 0.f, 0.f, 0.f};
        cur = nxt; cA = nA; cB = nB; ++ui;
        if (wr == 1) PG8_BAR;
    }
    PG8_WAIT_V(0);
    PG8_BAR;
#undef PG8_SA
#undef PG8_SB
#undef PG8_STAGE
#undef PG8_LDA
#undef PG8_LDB
#undef PG8_MMA
#undef PG8_WAIT_V
#undef PG8_WAIT_L
#undef PG8_BAR
#undef PG8_SCHED
}
}

__device__ __forceinline__ s16x4 tr_read(const LAS unsigned char* p) { return __builtin_bit_cast(s16x4, __builtin_amdgcn_ds_read_tr16_b64_v4i16((LAS s16x4*)p)); }

template <int HD, int QI, int KT16 = 4>
__device__ __forceinline__ void attn_tile(const LAS unsigned char* Ks, const LAS unsigned char* Vs, const bf16x8 (&qf)[QI][HD / 32],
                                          float (&m)[QI], float (&l)[QI], f32x4 (&o)[QI][HD / 16], float sc,
                                          int maskmode, const int (&qloc)[QI], int kbase, const bool (&keep)[QI], int fr, int fq) {
    constexpr int KP = 2 * HD + 32;
    f32x4 s[QI][KT16];
#pragma unroll
    for (int qi = 0; qi < QI; ++qi)
#pragma unroll
        for (int kt = 0; kt < KT16; ++kt) s[qi][kt] = (f32x4){0.f, 0.f, 0.f, 0.f};
#pragma unroll
    for (int kt = 0; kt < KT16; ++kt)
#pragma unroll
        for (int dk = 0; dk < HD / 32; ++dk) {
            const bf16x8 kf = *(const LAS bf16x8*)(Ks + (16 * kt + fr) * KP + (32 * dk + 8 * fq) * 2);
#pragma unroll
            for (int qi = 0; qi < QI; ++qi) s[qi][kt] = __builtin_amdgcn_mfma_f32_16x16x32_bf16(kf, qf[qi][dk], s[qi][kt], 0, 0, 0);
        }
    float mxs[QI]; bool need = false;
#pragma unroll
    for (int qi = 0; qi < QI; ++qi) {
        if (maskmode == 1) {
#pragma unroll
            for (int kt = 0; kt < KT16; ++kt)
#pragma unroll
                for (int r = 0; r < 4; ++r) if (kbase + 16 * kt + 4 * fq + r > qloc[qi]) s[qi][kt][r] = -INFINITY;
        }
        float mx = fmaxf(fmaxf(s[qi][0][0], s[qi][0][1]), fmaxf(s[qi][0][2], s[qi][0][3]));
#pragma unroll
        for (int kt = 1; kt < KT16; ++kt) { mx = fmaxf(fmaxf(mx, s[qi][kt][0]), s[qi][kt][1]); mx = fmaxf(fmaxf(mx, s[qi][kt][2]), s[qi][kt][3]); }
        mx = xmax32(xmax16(mx));
        mxs[qi] = mx * sc;
        need = need || (keep[qi] && mxs[qi] > m[qi] + 8.0f);
    }
    if (__ballot(need) != 0ull) {
#pragma unroll
        for (int qi = 0; qi < QI; ++qi) {
            const bool upd = keep[qi] && mxs[qi] > m[qi] + 8.0f;
            const float mn = upd ? mxs[qi] : m[qi];
            const float al = __builtin_amdgcn_exp2f(m[qi] - mn); m[qi] = mn; l[qi] *= al;
#pragma unroll
            for (int dt = 0; dt < HD / 16; ++dt) o[qi][dt] = o[qi][dt] * al;
        }
    }
    bf16x8 pf[QI][KT16 / 2];
#pragma unroll
    for (int qi = 0; qi < QI; ++qi) {
        const float moff = keep[qi] ? -m[qi] : -INFINITY;
        float rs = 0.f;
#pragma unroll
        for (int kt = 0; kt < KT16; ++kt)
#pragma unroll
            for (int r = 0; r < 4; ++r) { const float p = __builtin_amdgcn_exp2f(__builtin_fmaf(s[qi][kt][r], sc, moff)); s[qi][kt][r] = p; rs += p; }
        l[qi] += rs;
#pragma unroll
        for (int p2 = 0; p2 < KT16 / 2; ++p2) {
            u32x4 w; w.x = cvt_pk_bf16(s[qi][2 * p2][0], s[qi][2 * p2][1]); w.y = cvt_pk_bf16(s[qi][2 * p2][2], s[qi][2 * p2][3]);
            w.z = cvt_pk_bf16(s[qi][2 * p2 + 1][0], s[qi][2 * p2 + 1][1]); w.w = cvt_pk_bf16(s[qi][2 * p2 + 1][2], s[qi][2 * p2 + 1][3]);
            pf[qi][p2] = __builtin_bit_cast(bf16x8, w);
        }
    }
    const LAS unsigned char* vb = Vs + (4 * fq + (fr >> 2)) * KP + (4 * (fr & 3)) * 2;
#pragma unroll
    for (int dt = 0; dt < HD / 16; ++dt)
#pragma unroll
        for (int p2 = 0; p2 < KT16 / 2; ++p2) {
            const s16x4 lo = tr_read(vb + (32 * p2) * KP + 32 * dt);
            const s16x4 hi = tr_read(vb + (32 * p2 + 16) * KP + 32 * dt);
            const bf16x8 vf = (bf16x8){lo[0], lo[1], lo[2], lo[3], hi[0], hi[1], hi[2], hi[3]};
#pragma unroll
            for (int qi = 0; qi < QI; ++qi) o[qi][dt] = __builtin_amdgcn_mfma_f32_16x16x32_bf16(vf, pf[qi][p2], o[qi][dt], 0, 0, 0);
        }
}

template <int HD, int QI, int KT16 = 4>
__device__ __forceinline__ void attn_tile_pl(const LAS unsigned char* Ks, const LAS unsigned char* Vs, const bf16x8 (&qf)[QI][HD / 32],
                                          float (&m)[QI], float (&l)[QI], f32x4 (&o)[QI][HD / 16], float sc,
                                          int maskmode, const int (&qloc)[QI], int kbase, const bool (&keep)[QI], int fr, int fq) {
    constexpr int KP = 2 * HD + 32;
    constexpr int NF = (HD / 32) * KT16, CH = 4, NCH = NF / CH;
    static_assert(NF % CH == 0, "fragment chunking");
    f32x4 s[QI][KT16];
#pragma unroll
    for (int qi = 0; qi < QI; ++qi)
#pragma unroll
        for (int kt = 0; kt < KT16; ++kt) s[qi][kt] = (f32x4){0.f, 0.f, 0.f, 0.f};
    const LAS unsigned char* kb = Ks + fr * KP + 16 * fq;
#define KFRAG(f) (*(const LAS bf16x8*)(kb + (16 * ((f) % KT16)) * KP + 64 * ((f) / KT16)))
    bf16x8 kf[2][CH];
#pragma unroll
    for (int i = 0; i < CH; ++i) kf[0][i] = KFRAG(i);
#pragma unroll
    for (int c = 0; c < NCH; ++c) {
        if (c + 1 < NCH) {
#pragma unroll
            for (int i = 0; i < CH; ++i) kf[(c + 1) & 1][i] = KFRAG((c + 1) * CH + i);
        }
        __builtin_amdgcn_sched_barrier(0);
#pragma unroll
        for (int i = 0; i < CH; ++i) { const int f = c * CH + i, kt = f % KT16, dk = f / KT16;
#pragma unroll
            for (int qi = 0; qi < QI; ++qi) s[qi][kt] = __builtin_amdgcn_mfma_f32_16x16x32_bf16(kf[c & 1][i], qf[qi][dk], s[qi][kt], 0, 0, 0); }
        __builtin_amdgcn_sched_barrier(0);
    }
#undef KFRAG
    constexpr int NV = (KT16 / 2) * (HD / 16), NVC = NV / CH;
    static_assert(NV % CH == 0, "V fragment chunking");
    const LAS unsigned char* vb = Vs + (4 * fq + (fr >> 2)) * KP + (4 * (fr & 3)) * 2;
#define VLO(g) tr_read(vb + (32 * ((g) / (HD / 16))) * KP + 32 * ((g) % (HD / 16)))
#define VHI(g) tr_read(vb + (32 * ((g) / (HD / 16)) + 16) * KP + 32 * ((g) % (HD / 16)))
    s16x4 vlo[2][CH], vhi[2][CH];
#pragma unroll
    for (int i = 0; i < CH; ++i) { vlo[0][i] = VLO(i); vhi[0][i] = VHI(i); }
    __builtin_amdgcn_sched_barrier(0);
    float mxs[QI]; bool need = false;
#pragma unroll
    for (int qi = 0; qi < QI; ++qi) {
        if (maskmode == 1) {
#pragma unroll
            for (int kt = 0; kt < KT16; ++kt)
#pragma unroll
                for (int r = 0; r < 4; ++r) if (kbase + 16 * kt + 4 * fq + r > qloc[qi]) s[qi][kt][r] = -INFINITY;
        }
        float mx = fmaxf(fmaxf(s[qi][0][0], s[qi][0][1]), fmaxf(s[qi][0][2], s[qi][0][3]));
#pragma unroll
        for (int kt = 1; kt < KT16; ++kt) { mx = fmaxf(fmaxf(mx, s[qi][kt][0]), s[qi][kt][1]); mx = fmaxf(fmaxf(mx, s[qi][kt][2]), s[qi][kt][3]); }
        mx = xmax32(xmax16(mx));
        mxs[qi] = mx * sc;
        need = need || (keep[qi] && mxs[qi] > m[qi] + 8.0f);
    }
    if (__ballot(need) != 0ull) {
#pragma unroll
        for (int qi = 0; qi < QI; ++qi) {
            const bool upd = keep[qi] && mxs[qi] > m[qi] + 8.0f;
            const float mn = upd ? mxs[qi] : m[qi];
            const float al = __builtin_amdgcn_exp2f(m[qi] - mn); m[qi] = mn; l[qi] *= al;
#pragma unroll
            for (int dt = 0; dt < HD / 16; ++dt) o[qi][dt] = o[qi][dt] * al;
        }
    }
    bf16x8 pf[QI][KT16 / 2];
#pragma unroll
    for (int qi = 0; qi < QI; ++qi) {
        const float moff = keep[qi] ? -m[qi] : -INFINITY;
        float rs = 0.f;
#pragma unroll
        for (int kt = 0; kt < KT16; ++kt)
#pragma unroll
            for (int r = 0; r < 4; ++r) { const float p = __builtin_amdgcn_exp2f(__builtin_fmaf(s[qi][kt][r], sc, moff)); s[qi][kt][r] = p; rs += p; }
        l[qi] += rs;
#pragma unroll
        for (int p2 = 0; p2 < KT16 / 2; ++p2) {
            u32x4 w; w.x = cvt_pk_bf16(s[qi][2 * p2][0], s[qi][2 * p2][1]); w.y = cvt_pk_bf16(s[qi][2 * p2][2], s[qi][2 * p2][3]);
            w.z = cvt_pk_bf16(s[qi][2 * p2 + 1][0], s[qi][2 * p2 + 1][1]); w.w = cvt_pk_bf16(s[qi][2 * p2 + 1][2], s[qi][2 * p2 + 1][3]);
            pf[qi][p2] = __builtin_bit_cast(bf16x8, w);
        }
    }
    __builtin_amdgcn_sched_barrier(0);
#pragma unroll
    for (int c = 0; c < NVC; ++c) {
        if (c + 1 < NVC) {
#pragma unroll
            for (int i = 0; i < CH; ++i) { vlo[(c + 1) & 1][i] = VLO((c + 1) * CH + i); vhi[(c + 1) & 1][i] = VHI((c + 1) * CH + i); }
        }
        __builtin_amdgcn_sched_barrier(0);
#pragma unroll
        for (int i = 0; i < CH; ++i) { const int g = c * CH + i, p2 = g / (HD / 16), dt = g % (HD / 16);
            const s16x4 lo = vlo[c & 1][i], hi = vhi[c & 1][i];
            const bf16x8 vf = (bf16x8){lo[0], lo[1], lo[2], lo[3], hi[0], hi[1], hi[2], hi[3]};
#pragma unroll
            for (int qi = 0; qi < QI; ++qi) o[qi][dt] = __builtin_amdgcn_mfma_f32_16x16x32_bf16(vf, pf[qi][p2], o[qi][dt], 0, 0, 0); }
        __builtin_amdgcn_sched_barrier(0);
    }
#undef VLO
#undef VHI
}

template <int HD> struct Stage { static constexpr int CH = HD / 8, NLD = 64 * CH / 512, KP = 2 * HD + 32, TILE_B = 64 * KP; u32x4 k[NLD], v[NLD]; };
template <int HD>
__device__ __forceinline__ void stage_load(Stage<HD>& st, const bf16_t* Kg, const bf16_t* Vg, int gp, int tid) {
#pragma unroll
    for (int i = 0; i < Stage<HD>::NLD; ++i) { const int idx = tid + 512 * i, row = idx / Stage<HD>::CH, ch = idx % Stage<HD>::CH;
        st.k[i] = *(const u32x4*)(Kg + (size_t)row * gp + ch * 8); st.v[i] = *(const u32x4*)(Vg + (size_t)row * gp + ch * 8); }
}
template <int HD>
__device__ __forceinline__ void stage_store(const Stage<HD>& st, LAS unsigned char* buf, int tid) {
#pragma unroll
    for (int i = 0; i < Stage<HD>::NLD; ++i) { const int idx = tid + 512 * i, row = idx / Stage<HD>::CH, ch = idx % Stage<HD>::CH;
        *(LAS u32x4*)(buf + row * Stage<HD>::KP + ch * 16) = st.k[i]; *(LAS u32x4*)(buf + Stage<HD>::TILE_B + row * Stage<HD>::KP + ch * 16) = st.v[i]; }
}

namespace moba {
constexpr int HD = 64, KP = 2 * HD + 32, BLKB = 256 * KP;
constexpr int L_K = 0, L_V = BLKB, L_O = 2 * BLKB, L_M = L_O + 256 * 128, L_L = L_M + 1024, L_LIST = L_L + 1024, L_CNT = L_LIST + 15 * 256, L_Q = L_CNT + 64, L_END = L_Q + 256 * 128;
struct BlkStage { u32x4 k[4], v[4]; };
__device__ __forceinline__ void blk_load(BlkStage& st, const bf16_t* Kg, const bf16_t* Vg, int tid) {
#pragma unroll
    for (int i = 0; i < 4; ++i) { const int idx = tid + 512 * i, row = idx >> 3, ch = idx & 7;
        st.k[i] = *(const u32x4*)(Kg + (size_t)row * INW + ch * 8); st.v[i] = *(const u32x4*)(Vg + (size_t)row * INW + ch * 8); }
}
__device__ __forceinline__ void blk_store(const BlkStage& st, LAS unsigned char* lds, int tid) {
#pragma unroll
    for (int i = 0; i < 4; ++i) { const int idx = tid + 512 * i, row = idx >> 3, ch = idx & 7;
        *(LAS u32x4*)(lds + L_K + row * KP + ch * 16) = st.k[i]; *(LAS u32x4*)(lds + L_V + row * KP + ch * 16) = st.v[i]; }
}
template <int QI>
__device__ __forceinline__ void past_tiles(LAS unsigned char* lds, const int (&rows)[QI], const bool (&valid)[QI], float sc, int fr, int fq) {
    bf16x8 qf[QI][2]; float m[QI], l[QI]; f32x4 o[QI][4]; int qloc[QI];
#pragma unroll
    for (int qi = 0; qi < QI; ++qi) {
#pragma unroll
        for (int dk = 0; dk < 2; ++dk) qf[qi][dk] = *(const LAS bf16x8*)(lds + L_Q + rows[qi] * 128 + (32 * dk + 8 * fq) * 2);
        m[qi] = *(const LAS float*)(lds + L_M + rows[qi] * 4);
        l[qi] = (fq == 0) ? *(const LAS float*)(lds + L_L + rows[qi] * 4) : 0.f;
        qloc[qi] = 0;
#pragma unroll
        for (int dt = 0; dt < 4; ++dt) { const u32x2 ov = *(const LAS u32x2*)(lds + L_O + rows[qi] * 128 + (16 * dt + 4 * fq) * 2);
            o[qi][dt] = (f32x4){__uint_as_float(ov.x << 16), __uint_as_float(ov.x & 0xffff0000u), __uint_as_float(ov.y << 16), __uint_as_float(ov.y & 0xffff0000u)}; }
    }
    if constexpr (QI == 1) attn_tile_pl<HD, 1, 16>(lds + L_K, lds + L_V, qf, m, l, o, sc, 0, qloc, 0, valid, fr, fq);
    else {
#pragma unroll 1
        for (int half = 0; half < 2; ++half)
            attn_tile<HD, QI, 8>(lds + L_K + half * 128 * KP, lds + L_V + half * 128 * KP, qf, m, l, o, sc, 0, qloc, 0, valid, fr, fq);
    }
#pragma unroll
    for (int qi = 0; qi < QI; ++qi) {
        const float lt = xsum32(xsum16(l[qi]));
        if (valid[qi]) {
            if (fq == 0) { *(LAS float*)(lds + L_M + rows[qi] * 4) = m[qi]; *(LAS float*)(lds + L_L + rows[qi] * 4) = lt; }
#pragma unroll
            for (int dt = 0; dt < 4; ++dt) { u32x2 ov; ov.x = cvt_pk_bf16(o[qi][dt][0], o[qi][dt][1]); ov.y = cvt_pk_bf16(o[qi][dt][2], o[qi][dt][3]);
                *(LAS u32x2*)(lds + L_O + rows[qi] * 128 + (16 * dt + 4 * fq) * 2) = ov; }
        }
    }
}
}

__device__ __forceinline__ void moba_unit(int b, int h, int blk, const bf16_t* Z, const float* KM, bf16_t* MIX, LAS unsigned char* lds) {
    using namespace moba;
    constexpr int QI = 2;
    const int tid = threadIdx.x, lane = tid & 63, w = __builtin_amdgcn_readfirstlane(tid >> 6), fr = lane & 15, fq = lane >> 4;
    const size_t rowb = (size_t)b * SEQ;
    const int q0 = 256 * blk + 32 * w;
    const bf16_t* Kh = Z + rowb * INW + 1024 + h * 64; const bf16_t* Vh = Z + rowb * INW + 1536 + h * 64;
    const bf16_t* Qblk = Z + (rowb + 256 * blk) * INW + 512 + h * 64;
    BlkStage st;
    blk_load(st, Kh + (size_t)(256 * blk) * INW, Vh + (size_t)(256 * blk) * INW, tid);
    bf16x8 qf[QI][2];
#pragma unroll
    for (int qi = 0; qi < QI; ++qi)
#pragma unroll
        for (int dk = 0; dk < 2; ++dk) qf[qi][dk] = *(const bf16x8*)(Qblk + (size_t)(32 * w + 16 * qi + fr) * INW + 32 * dk + 8 * fq);
    __syncthreads();
    if (tid < 16) *(LAS unsigned*)(lds + L_CNT + tid * 4) = 0u;
    if (blk > 0) {
#pragma unroll
        for (int i = 0; i < 4; ++i) { const int idx = tid + 512 * i, row = idx >> 3, ch = idx & 7;
            *(LAS u32x4*)(lds + L_Q + row * 128 + ch * 16) = *(const u32x4*)(Qblk + (size_t)row * INW + ch * 8); }
    }
    __syncthreads();
    {
        float v1[QI], v2[QI], v3[QI]; int i1[QI], i2[QI], i3[QI];
#pragma unroll
        for (int qi = 0; qi < QI; ++qi) { v1[qi] = v2[qi] = v3[qi] = -INFINITY; i1[qi] = i2[qi] = i3[qi] = -1; }
        const float* kmb = KM + (size_t)((b * 8 + h) * NBLK) * 64;
        for (int j = 0; j < blk; ++j) {
            f32x4 km[2][2];
#pragma unroll
            for (int dk = 0; dk < 2; ++dk) { km[dk][0] = *(const f32x4*)(kmb + j * 64 + 32 * dk + 8 * fq); km[dk][1] = *(const f32x4*)(kmb + j * 64 + 32 * dk + 8 * fq + 4); }
#pragma unroll
            for (int qi = 0; qi < QI; ++qi) {
                float g = 0.f;
#pragma unroll
                for (int dk = 0; dk < 2; ++dk)
#pragma unroll
                    for (int e = 0; e < 8; ++e) g += bf2f((unsigned short)qf[qi][dk][e]) * km[dk][e >> 2][e & 3];
                g = xsum32(xsum16(g));
                if (g > v1[qi]) { v3[qi] = v2[qi]; i3[qi] = i2[qi]; v2[qi] = v1[qi]; i2[qi] = i1[qi]; v1[qi] = g; i1[qi] = j; }
                else if (g > v2[qi]) { v3[qi] = v2[qi]; i3[qi] = i2[qi]; v2[qi] = g; i2[qi] = j; }
                else if (g > v3[qi]) { v3[qi] = g; i3[qi] = j; }
            }
        }
        if (fq == 0) {
#pragma unroll
            for (int qi = 0; qi < QI; ++qi) { const int row = 32 * w + 16 * qi + fr; const int ids[3] = {i1[qi], i2[qi], i3[qi]};
#pragma unroll
                for (int k3 = 0; k3 < 3; ++k3) if (ids[k3] >= 0) {
                    const unsigned pos = __hip_atomic_fetch_add((LAS unsigned*)(lds + L_CNT + ids[k3] * 4), 1u, __ATOMIC_RELAXED, __HIP_MEMORY_SCOPE_WORKGROUP);
                    *(LAS unsigned char*)(lds + L_LIST + ids[k3] * 256 + pos) = (unsigned char)row; } }
        }
    }
    blk_store(st, lds, tid);
    __syncthreads();
    { const int jn = blk > 0 ? 0 : blk; blk_load(st, Kh + (size_t)(256 * jn) * INW, Vh + (size_t)(256 * jn) * INW, tid); }
    const float sc = 0.125f * LOG2E;
    {
        float m[QI], l[QI]; f32x4 o[QI][4]; int qloc[QI]; bool keep[QI];
#pragma unroll
        for (int qi = 0; qi < QI; ++qi) { m[qi] = -1e30f; l[qi] = 0.f; qloc[qi] = 32 * w + 16 * qi + fr; keep[qi] = true;
#pragma unroll
            for (int dt = 0; dt < 4; ++dt) o[qi][dt] = (f32x4){0.f, 0.f, 0.f, 0.f}; }
#pragma unroll 1
        for (int half = 0; half < 2; ++half)
            if (128 * half <= 32 * w) attn_tile<HD, QI, 8>(lds + L_K + half * 128 * KP, lds + L_V + half * 128 * KP, qf, m, l, o, sc, 1, qloc, 128 * half, keep, fr, fq);
#pragma unroll
        for (int qi = 0; qi < QI; ++qi) {
            const float lt = xsum32(xsum16(l[qi])); const int row = 32 * w + 16 * qi + fr;
            if (blk == 0) {
                const float inv = 1.0f / lt; bf16_t* op = MIX + (rowb + q0 + 16 * qi + fr) * DM + 512 + h * 64 + 4 * fq;
#pragma unroll
                for (int dt = 0; dt < 4; ++dt) { const f32x4 v = o[qi][dt] * inv; u32x2 wv; wv.x = cvt_pk_bf16(v[0], v[1]); wv.y = cvt_pk_bf16(v[2], v[3]); *(u32x2*)(op + 16 * dt) = wv; }
            } else {
                if (fq == 0) { *(LAS float*)(lds + L_M + row * 4) = m[qi]; *(LAS float*)(lds + L_L + row * 4) = lt; }
#pragma unroll
                for (int dt = 0; dt < 4; ++dt) { u32x2 ov; ov.x = cvt_pk_bf16(o[qi][dt][0], o[qi][dt][1]); ov.y = cvt_pk_bf16(o[qi][dt][2], o[qi][dt][3]);
                    *(LAS u32x2*)(lds + L_O + row * 128 + (16 * dt + 4 * fq) * 2) = ov; }
            }
        }
    }
    for (int j = 0; j < blk; ++j) {
        __syncthreads();
        blk_store(st, lds, tid);
        __syncthreads();
        { const int jn = (j + 1 < blk) ? j + 1 : j; blk_load(st, Kh + (size_t)(256 * jn) * INW, Vh + (size_t)(256 * jn) * INW, tid); }
        const int n = (int)*(const LAS unsigned*)(lds + L_CNT + j * 4);
        const int tiles = (n + 15) >> 4;
        for (int tw = w; tw < tiles; tw += 8) {
            int rows[1]; bool valid[1];
            { const int idx = 16 * tw + fr; valid[0] = idx < n; rows[0] = *(const LAS unsigned char*)(lds + L_LIST + j * 256 + (valid[0] ? idx : 0)); }
            past_tiles<1>(lds, rows, valid, sc, fr, fq);
        }
    }
    if (blk > 0) {
        __syncthreads();
#pragma unroll
        for (int qi = 0; qi < QI; ++qi) {
            const int row = 32 * w + 16 * qi + fr;
            const float inv = 1.0f / *(const LAS float*)(lds + L_L + row * 4);
            bf16_t* op = MIX + (rowb + q0 + 16 * qi + fr) * DM + 512 + h * 64 + 4 * fq;
#pragma unroll
            for (int dt = 0; dt < 4; ++dt) { const u32x2 ov = *(const LAS u32x2*)(lds + L_O + row * 128 + (16 * dt + 4 * fq) * 2);
                const f32x4 v = (f32x4){__uint_as_float(ov.x << 16), __uint_as_float(ov.x & 0xffff0000u), __uint_as_float(ov.y << 16), __uint_as_float(ov.y & 0xffff0000u)} * inv;
                u32x2 wv; wv.x = cvt_pk_bf16(v[0], v[1]); wv.y = cvt_pk_bf16(v[2], v[3]); *(u32x2*)(op + 16 * dt) = wv; }
        }
    }
}

__device__ __forceinline__ void xattn_unit(int qt, int hd, const bf16_t* XQ, const bf16_t* MEMKV, bf16_t* XO, LAS unsigned char* lds) {
    constexpr int HD = 256, QI = 1, TB = Stage<HD>::TILE_B;
    const int tid = threadIdx.x, lane = tid & 63, w = __builtin_amdgcn_readfirstlane(tid >> 6), fr = lane & 15, fq = lane >> 4;
    const int b = qt >> 5;
    const size_t qrow = (size_t)qt * 128 + 16 * w + fr;
    bf16x8 qf[QI][HD / 32];
#pragma unroll
    for (int dk = 0; dk < HD / 32; ++dk) qf[0][dk] = *(const bf16x8*)(XQ + qrow * DM + hd * 256 + 32 * dk + 8 * fq);
    float m[QI] = {-1e30f}, l[QI] = {0.f}; f32x4 o[QI][HD / 16]; int qloc[QI] = {0}; bool keep[QI] = {true};
#pragma unroll
    for (int dt = 0; dt < HD / 16; ++dt) o[0][dt] = (f32x4){0.f, 0.f, 0.f, 0.f};
    const float sc = 0.0625f * LOG2E;
    const bf16_t* Kh = MEMKV + (size_t)b * MEMLEN * 2048 + hd * 256; const bf16_t* Vh = Kh + 1024;
    Stage<HD> st;
    __syncthreads();
    stage_load<HD>(st, Kh, Vh, 2048, tid);
    stage_store<HD>(st, lds, tid);
    __syncthreads();
    for (int t = 0; t < 4; ++t) {
        if (t + 1 < 4) stage_load<HD>(st, Kh + (size_t)(64 * (t + 1)) * 2048, Vh + (size_t)(64 * (t + 1)) * 2048, 2048, tid);
        const LAS unsigned char* buf = lds + (t & 1) * 2 * TB;
        attn_tile<HD, QI>(buf, buf + TB, qf, m, l, o, sc, 0, qloc, 0, keep, fr, fq);
        if (t + 1 < 4) stage_store<HD>(st, lds + ((t + 1) & 1) * 2 * TB, tid);
        __syncthreads();
    }
    float ls = xsum32(xsum16(l[0]));
    const float inv = 1.0f / ls;
    bf16_t* op = XO + qrow * DM + hd * 256 + 4 * fq;
#pragma unroll
    for (int dt = 0; dt < HD / 16; ++dt) { const f32x4 v = o[0][dt] * inv; u32x2 wv; wv.x = cvt_pk_bf16(v[0], v[1]); wv.y = cvt_pk_bf16(v[2], v[3]); *(u32x2*)(op + 16 * dt) = wv; }
}

__device__ __forceinline__ void p0_transpose_item(const float* W, int K, int N, bf16_t* WT, int mode, LAS float* scr, int item, int lane, const float* ks = nullptr) {
    const int nblk = N / 32, kb = item / nblk, nb = item % nblk, k0 = 64 * kb, n0 = 32 * nb;
    float wv[32];
#pragma unroll
    for (int i = 0; i < 32; ++i) wv[i] = W[(size_t)(k0 + 2 * i + (lane >> 5)) * N + n0 + (lane & 31)];
#pragma unroll
    for (int i = 0; i < 32; ++i) { const int kk = 2 * i + (lane >> 5); scr[kk * 33 + (lane & 31)] = ks ? wv[i] * ks[k0 + kk] : wv[i]; }
    asm volatile("s_waitcnt lgkmcnt(0)" ::: "memory");
    const int c = lane & 7;
#pragma unroll
    for (int j = 0; j < 4; ++j) { const int n = (lane >> 3) + 8 * j; const LAS float* s = scr + (8 * c) * 33 + n;
        u32x4 o; o.x = cvt_pk_bf16(s[0 * 33], s[1 * 33]); o.y = cvt_pk_bf16(s[2 * 33], s[3 * 33]); o.z = cvt_pk_bf16(s[4 * 33], s[5 * 33]); o.w = cvt_pk_bf16(s[6 * 33], s[7 * 33]);
        const int gn = n0 + n; const int row = (mode == 0) ? gn : (32 * (gn >> 4) + (gn & 15) + (mode == 2 ? 16 : 0));
        *(u32x4*)(WT + (size_t)row * K + k0 + 8 * c) = o; }
    asm volatile("s_waitcnt lgkmcnt(0)" ::: "memory");
}
__device__ __forceinline__ void cvt_rows_bf16(const float* src, bf16_t* dst, size_t n8, size_t gtid, size_t nthr) {
    size_t i = gtid;
    for (; i + 3 * nthr < n8; i += 4 * nthr) {
        f32x4 a[4], b[4];
#pragma unroll
        for (int q = 0; q < 4; ++q) { a[q] = __builtin_nontemporal_load((const f32x4*)(src + (i + q * nthr) * 8)); b[q] = __builtin_nontemporal_load((const f32x4*)(src + (i + q * nthr) * 8 + 4)); }
#pragma unroll
        for (int q = 0; q < 4; ++q) { u32x4 o; o.x = cvt_pk_bf16(a[q][0], a[q][1]); o.y = cvt_pk_bf16(a[q][2], a[q][3]); o.z = cvt_pk_bf16(b[q][0], b[q][1]); o.w = cvt_pk_bf16(b[q][2], b[q][3]); *(u32x4*)(dst + (i + q * nthr) * 8) = o; }
    }
    for (; i < n8; i += nthr) { const f32x4 a = *(const f32x4*)(src + i * 8), b = *(const f32x4*)(src + i * 8 + 4);
        u32x4 o; o.x = cvt_pk_bf16(a[0], a[1]); o.y = cvt_pk_bf16(a[2], a[3]); o.z = cvt_pk_bf16(b[0], b[1]); o.w = cvt_pk_bf16(b[2], b[3]); *(u32x4*)(dst + i * 8) = o; }
}
__device__ __forceinline__ void ln_row(const float* yrow, const float* g, const float* bta, float* hrow, bf16_t* brow, int lane) {
    f32x4 v[4]; float s = 0.f;
#pragma unroll
    for (int j = 0; j < 4; ++j) { v[j] = *((const f32x4*)yrow + lane + 64 * j); s += (v[j][0] + v[j][1]) + (v[j][2] + v[j][3]); }
    const float mean = wave_sum(s) * (1.f / DM); float s2 = 0.f;
#pragma unroll
    for (int j = 0; j < 4; ++j) { v[j] = v[j] - mean; s2 += (v[j][0] * v[j][0] + v[j][1] * v[j][1]) + (v[j][2] * v[j][2] + v[j][3] * v[j][3]); }
    const float rstd = 1.f / sqrtf(wave_sum(s2) * (1.f / DM) + LN_EPS);
#pragma unroll
    for (int j = 0; j < 4; ++j) { const f32x4 gg = *((const f32x4*)g + lane + 64 * j), bb = *((const f32x4*)bta + lane + 64 * j);
        const f32x4 r = v[j] * rstd * gg + bb; *((f32x4*)hrow + lane + 64 * j) = r;
        if (brow) { u32x2 wv; wv.x = cvt_pk_bf16(r[0], r[1]); wv.y = cvt_pk_bf16(r[2], r[3]); *((u32x2*)brow + lane + 64 * j) = wv; } }
}

__device__ __forceinline__ void ln_row_bf16in(const bf16_t* yrow, const float* g, const float* bta, float* orow, int lane) {
    f32x4 v[4]; float s = 0.f;
#pragma unroll
    for (int j = 0; j < 2; ++j) { const u32x4 rr = *((const u32x4*)yrow + lane + 64 * j);
        v[2 * j] = (f32x4){__uint_as_float(rr.x << 16), __uint_as_float(rr.x & 0xffff0000u), __uint_as_float(rr.y << 16), __uint_as_float(rr.y & 0xffff0000u)};
        v[2 * j + 1] = (f32x4){__uint_as_float(rr.z << 16), __uint_as_float(rr.z & 0xffff0000u), __uint_as_float(rr.w << 16), __uint_as_float(rr.w & 0xffff0000u)};
        s += ((v[2 * j][0] + v[2 * j][1]) + (v[2 * j][2] + v[2 * j][3])) + ((v[2 * j + 1][0] + v[2 * j + 1][1]) + (v[2 * j + 1][2] + v[2 * j + 1][3])); }
    const float mean = wave_sum(s) * (1.f / DM); float s2 = 0.f;
#pragma unroll
    for (int j = 0; j < 4; ++j) { v[j] = v[j] - mean; s2 += (v[j][0] * v[j][0] + v[j][1] * v[j][1]) + (v[j][2] * v[j][2] + v[j][3] * v[j][3]); }
    const float rstd = 1.f / sqrtf(wave_sum(s2) * (1.f / DM) + LN_EPS);
#pragma unroll
    for (int q = 0; q < 4; ++q) { const int ci = 512 * (q >> 1) + 8 * lane + 4 * (q & 1);
        const f32x4 gg = *(const f32x4*)(g + ci), bb = *(const f32x4*)(bta + ci);
        *(f32x4*)(orow + ci) = v[q] * rstd * gg + bb; }
}

__device__ __forceinline__ void ln_rows4_bf16in(const bf16_t* y, const float* g, const float* bta, float* o, int ld, int lane) {
    u32x4 rr[4][2];
#pragma unroll
    for (int q = 0; q < 4; ++q)
#pragma unroll
        for (int j = 0; j < 2; ++j) rr[q][j] = *((const u32x4*)(y + (size_t)q * ld) + lane + 64 * j);
    f32x4 gg[4], bb[4];
#pragma unroll
    for (int c4 = 0; c4 < 4; ++c4) { const int ci = 512 * (c4 >> 1) + 8 * lane + 4 * (c4 & 1); gg[c4] = *(const f32x4*)(g + ci); bb[c4] = *(const f32x4*)(bta + ci); }
#pragma unroll
    for (int q = 0; q < 4; ++q) {
        f32x4 v[4]; float s = 0.f;
#pragma unroll
        for (int j = 0; j < 2; ++j) { const u32x4 w = rr[q][j];
            v[2 * j] = (f32x4){__uint_as_float(w.x << 16), __uint_as_float(w.x & 0xffff0000u), __uint_as_float(w.y << 16), __uint_as_float(w.y & 0xffff0000u)};
            v[2 * j + 1] = (f32x4){__uint_as_float(w.z << 16), __uint_as_float(w.z & 0xffff0000u), __uint_as_float(w.w << 16), __uint_as_float(w.w & 0xffff0000u)}; }
#pragma unroll
        for (int c4 = 0; c4 < 4; ++c4) s += (v[c4][0] + v[c4][1]) + (v[c4][2] + v[c4][3]);
        const float mean = wave_sum(s) * (1.f / DM); float s2 = 0.f;
#pragma unroll
        for (int c4 = 0; c4 < 4; ++c4) { v[c4] = v[c4] - mean; s2 += (v[c4][0] * v[c4][0] + v[c4][1] * v[c4][1]) + (v[c4][2] * v[c4][2] + v[c4][3] * v[c4][3]); }
        const float rstd = 1.f / sqrtf(wave_sum(s2) * (1.f / DM) + LN_EPS);
#pragma unroll
        for (int c4 = 0; c4 < 4; ++c4) { const int ci = 512 * (c4 >> 1) + 8 * lane + 4 * (c4 & 1); *(f32x4*)(o + (size_t)q * ld + ci) = v[c4] * rstd * gg[c4] + bb[c4]; }
    }
}

#define XB_TMO      128
#define XB_XCNT(j)  (256  + 64 * (j))
#define XB_XSUB(j)  (1280 + 64 * (j))
#define XB_XGEN(j)  (2304 + 64 * (j))
#define XB_TOP      3328
#define XB_TOPGEN   3392
#define XCD_BAR_WORDS 3456
#define XB_SPIN_CAP (1u << 20)
__device__ __forceinline__ unsigned xb_ld(unsigned* p)              { return __hip_atomic_load(p, __ATOMIC_RELAXED, __HIP_MEMORY_SCOPE_AGENT); }
__device__ __forceinline__ unsigned xb_add(unsigned* p, unsigned v) { return __hip_atomic_fetch_add(p, v, __ATOMIC_RELAXED, __HIP_MEMORY_SCOPE_AGENT); }
__device__ __forceinline__ unsigned xb_xcc_id() { return (unsigned)__builtin_amdgcn_s_getreg((3 << 11) | 20) & 0xFu; }
#define XB_SPIN(cond, bar) do { unsigned _sp = 0; while (cond) { __builtin_amdgcn_s_sleep(1); \
    if ((++_sp & 255u) == 0u) { if (xb_ld(&(bar)[XB_TMO])) break; if (_sp > XB_SPIN_CAP) { atomicAdd(&(bar)[XB_TMO], 1u); break; } } } } while (0)
struct XcdBarrier { unsigned* bar; unsigned x; volatile LAS unsigned* st; };
__device__ __forceinline__ XcdBarrier xcd_barrier_post(unsigned* bar, volatile LAS unsigned* st) {
    XcdBarrier b; b.bar = bar; b.x = xb_xcc_id(); b.st = st;
    if (threadIdx.x == 0) (void)xb_add(&bar[XB_XCNT(b.x)], 1u);
    return b;
}
__device__ __forceinline__ void xcd_barrier_complete(unsigned* bar, unsigned x, unsigned& nloc, unsigned& nx) {
    const unsigned G = gridDim.x * gridDim.y * gridDim.z;
    unsigned sum, cnt, mine, sp = 0u;
    for (;;) {
        sum = 0u; cnt = 0u; mine = 0u;
#pragma unroll
        for (unsigned j = 0; j < 16; ++j) { const unsigned c = xb_ld(&bar[XB_XCNT(j)]); sum += c; cnt += (c > 0u) ? 1u : 0u; mine = (j == x) ? c : mine; }
        if (sum == G) break;
        __builtin_amdgcn_s_sleep(1);
        if ((++sp & 255u) == 0u) { if (xb_ld(&bar[XB_TMO])) break; if (sp > XB_SPIN_CAP) { atomicAdd(&bar[XB_TMO], 1u); break; } }
    }
    nloc = mine > 0u ? mine : 1u; nx = cnt > 0u ? cnt : 1u;
}
__device__ __forceinline__ void xcd_barrier(const XcdBarrier& b) {
    asm volatile("s_waitcnt vmcnt(0)" ::: "memory");
    __syncthreads();
    if (threadIdx.x == 0) {
        unsigned* bar = b.bar;
        __builtin_amdgcn_s_waitcnt(0);
        unsigned nloc = b.st[0], nx = b.st[1];
        if (nloc == 0u) { xcd_barrier_complete(bar, b.x, nloc, nx); b.st[0] = nloc; b.st[1] = nx; }
        const unsigned old = xb_add(&bar[XB_XSUB(b.x)], 1u);
        const unsigned gen = old / nloc;
        if (old + 1u == (gen + 1u) * nloc) {
            __builtin_amdgcn_fence(__ATOMIC_RELEASE, "agent");
            asm volatile("s_waitcnt vmcnt(0)" ::: "memory");
            const unsigned og = xb_add(&bar[XB_TOP], 1u);
            const unsigned tg = og / nx;
            if (og + 1u == (tg + 1u) * nx) xb_add(&bar[XB_TOPGEN], 1u);
            else XB_SPIN(xb_ld(&bar[XB_TOPGEN]) == tg, bar);
            __builtin_amdgcn_fence(__ATOMIC_ACQUIRE, "agent");
            xb_add(&bar[XB_XGEN(b.x)], 1u);
            asm volatile("s_waitcnt vmcnt(0)" ::: "memory");
        } else {
            XB_SPIN(xb_ld(&bar[XB_XGEN(b.x)]) == gen, bar);
            __builtin_amdgcn_fence(__ATOMIC_ACQUIRE, "agent");
            asm volatile("s_waitcnt vmcnt(0)" ::: "memory");
        }
    }
    __syncthreads();
}

#ifndef PROBE_PHASE
#define PROBE_PHASE -1
#endif
constexpr int LDS_BYTES = 159744;
constexpr int LDS_MISC = 159744 - 256;
struct Args { const float* in[18]; float* out; unsigned char* ws; int ph_lo, ph_hi; };
enum { I_X = 0, I_MEM, I_WIN, I_WPOOL, I_PSCALE, I_WOUT, I_LN1G, I_LN1B, I_WXQ, I_WXKV, I_WXO, I_LN2G, I_LN2B, I_WGATE, I_WUP, I_WDOWN, I_LN3G, I_LN3B };
constexpr int N_PHASES = 13;

struct Ctx {
    const float* const* in; LAS unsigned char* lds; unsigned char* ws; float* H;
    int tid, lane, wave, G, bx, vcu, gw, NGW;
};
#define WSP(T, off) ((T*)(c.ws + (off)))

template <int PH> __device__ __forceinline__ void run_phase(const Ctx& c) {
    const int lane = c.lane, wave = c.wave, G = c.G, bx = c.bx, vcu = c.vcu, gw = c.gw, NGW = c.NGW, tid = c.tid;
    LAS unsigned char* lds = c.lds;
    float* KM = WSP(float, WS_KM);
    bf16_t* Win_t = WSP(bf16_t, WS_WIN); bf16_t* Wout_t = WSP(bf16_t, WS_WOUT); bf16_t* Wxq_t = WSP(bf16_t, WS_WXQ); bf16_t* Wxkv_t = WSP(bf16_t, WS_WXKV);
    bf16_t* Wxo_t = WSP(bf16_t, WS_WXO); bf16_t* Wgu_t = WSP(bf16_t, WS_WGU); bf16_t* Wdn_t = WSP(bf16_t, WS_WDN); bf16_t* Wpool_t = WSP(bf16_t, WS_WPOOL);
    bf16_t* MEMB = WSP(bf16_t, WS_MEMB); bf16_t* MEMKV = WSP(bf16_t, WS_MEMKV);
    bf16_t* XB = WSP(bf16_t, WS_XB); bf16_t* Z = WSP(bf16_t, WS_Z); bf16_t* MIX = WSP(bf16_t, WS_MIX); bf16_t* HF = WSP(bf16_t, WS_HF);
    bf16_t* XQ = MIX; bf16_t* XO = Z;
    float* H = c.H; float* PST1 = WSP(float, WS_PST1); float* PST2 = WSP(float, WS_PST2);
    if constexpr (PH == 0) {
        if (bx < 208) {
            const float* W; int N, n0, mode; const float* gg; const float* bb; float* cd; int cdn;
            if (bx < 32) { W = c.in[I_WXQ]; N = DM; n0 = 32 * bx; mode = 0; gg = c.in[I_LN1G]; bb = c.in[I_LN1B]; cd = WSP(float, WS_CDX); cdn = DM; }
            else if (bx < 120) { W = c.in[I_WGATE]; N = DFF; n0 = 32 * (bx - 32); mode = 1; gg = c.in[I_LN2G]; bb = c.in[I_LN2B]; cd = WSP(float, WS_CDG); cdn = 2 * DFF; }
            else { W = c.in[I_WUP]; N = DFF; n0 = 32 * (bx - 120); mode = 2; gg = c.in[I_LN2G]; bb = c.in[I_LN2B]; cd = WSP(float, WS_CDG); cdn = 2 * DFF; }
            const int col = n0 + (lane & 31), kbeg = wave * 128 + (lane >> 5) * 64;
            float cs = 0.f, ds = 0.f;
#pragma unroll 8
            for (int k = kbeg; k < kbeg + 64; ++k) { const float wv = W[(size_t)k * N + col]; cs += gg[k] * wv; ds += bb[k] * wv; }
            cs += __shfl_xor(cs, 32); ds += __shfl_xor(ds, 32);
            LAS float* red = (LAS float*)(lds + 131072);
            if (lane < 32) { red[(wave * 32 + lane) * 2] = cs; red[(wave * 32 + lane) * 2 + 1] = ds; }
            __syncthreads();
            if (tid < 32) { float ct = 0.f, dt = 0.f;
#pragma unroll
                for (int w8 = 0; w8 < 8; ++w8) { ct += red[(w8 * 32 + tid) * 2]; dt += red[(w8 * 32 + tid) * 2 + 1]; }
                const int oi = (mode == 0) ? col : (32 * (col >> 4) + (col & 15) + (mode == 2 ? 16 : 0));
                cd[oi] = ct; cd[cdn + oi] = dt; }
        }
        LAS float* scr = (LAS float*)(lds + wave * 16384);
        constexpr int I_IN = (DM / 64) * (INW / 32), I_SQ = (DM / 64) * (DM / 32), I_KV = (DM / 64) * (2048 / 32), I_GU = (DM / 64) * (DFF / 32), I_DN = (DFF / 64) * (DM / 32), I_PL = 2 * 4;
        constexpr int NITEMS = I_IN + 3 * I_SQ + I_KV + 2 * I_GU + I_DN + 4 * I_PL;
        for (int it = gw; it < NITEMS; it += NGW) {
            int r = it;
            if (r < I_IN) { p0_transpose_item(c.in[I_WIN], DM, INW, Win_t, 0, scr, r, lane); continue; } r -= I_IN;
            if (r < I_SQ) { if (r >= 8 * (DM / 32)) p0_transpose_item(c.in[I_WOUT], DM, DM, Wout_t, 0, scr, r, lane); continue; } r -= I_SQ;
            if (r < I_SQ) { continue; } r -= I_SQ;
            if (r < I_SQ) { p0_transpose_item(c.in[I_WXO], DM, DM, Wxo_t, 0, scr, r, lane); continue; } r -= I_SQ;
            if (r < I_KV) { p0_transpose_item(c.in[I_WXKV], DM, 2048, Wxkv_t, 0, scr, r, lane); continue; } r -= I_KV;
            if (r < I_GU) { p0_transpose_item(c.in[I_WGATE], DM, DFF, Wgu_t, 1, scr, r, lane, c.in[I_LN2G]); continue; } r -= I_GU;
            if (r < I_GU) { p0_transpose_item(c.in[I_WUP], DM, DFF, Wgu_t, 2, scr, r, lane, c.in[I_LN2G]); continue; } r -= I_GU;
            if (r < I_DN) { p0_transpose_item(c.in[I_WDOWN], DFF, DM, Wdn_t, 0, scr, r, lane); continue; } r -= I_DN;
            { const int gidx = r / I_PL; p0_transpose_item(c.in[I_WPOOL] + gidx * 16384, 128, 128, Wpool_t + gidx * 16384, 0, scr, r % I_PL, lane); }
        }
        const size_t gtid = (size_t)vcu * 512 + tid, nthr = (size_t)G * 512;
        for (size_t idx = gtid; idx < (size_t)512 * DM; idx += nthr) {
            const int n = (int)(idx & (DM - 1)), k = (int)(idx >> 10), gidx = k >> 7;
            const float* wp = c.in[I_WPOOL] + (size_t)k * 128;
            const float* ps = c.in[I_PSCALE] + gidx * 128;
            const float* wo = c.in[I_WOUT] + (size_t)(gidx * 128) * DM + n;
            float a = 0.f;
#pragma unroll 8
            for (int d = 0; d < 128; ++d) a += wp[d] * ps[d] * wo[(size_t)d * DM];
            const unsigned pk = cvt_pk_bf16(a, 0.f);
            Wout_t[(size_t)n * DM + k] = (bf16_t)(pk & 0xffffu);
        }
        for (size_t i8 = gtid; i8 < (size_t)DM * DM / 8; i8 += nthr) {
            const float gsc = c.in[I_LN1G][(i8 * 8) >> 10]; const f32x4 a = *(const f32x4*)(c.in[I_WXQ] + i8 * 8) * gsc, b4 = *(const f32x4*)(c.in[I_WXQ] + i8 * 8 + 4) * gsc;
            u32x4 o; o.x = cvt_pk_bf16(a[0], a[1]); o.y = cvt_pk_bf16(a[2], a[3]); o.z = cvt_pk_bf16(b4[0], b4[1]); o.w = cvt_pk_bf16(b4[2], b4[3]); *(u32x4*)(Wxq_t + i8 * 8) = o; }
        for (size_t i4 = gtid; i4 < (size_t)BATCH * 8 * NBLK * 64 / 4; i4 += nthr) *((f32x4*)KM + i4) = (f32x4){0.f, 0.f, 0.f, 0.f};
        cvt_rows_bf16(c.in[I_X], XB, (size_t)TOK * DM / 8, gtid, nthr);
        cvt_rows_bf16(c.in[I_MEM], MEMB, (size_t)MEMROWS * DM / 8, gtid, nthr);
    }
    if constexpr (PH == 1) {
        { pg8::Gemm g{XB, Win_t, TOK, INW, DM}; pg8::StaticOrder S; S.init(TOK, INW, G, bx); pg8::EpiBf16 E{Z, INW, KM}; pg8::gemm_phase(lds, g, S, E); }
        { pg8::Gemm g{MEMB, Wxkv_t, MEMROWS, 2048, DM}; pg8::StaticOrder S; S.init(MEMROWS, 2048, G, bx); pg8::EpiBf16 E{MEMKV, 2048}; pg8::gemm_phase(lds, g, S, E); }
    }
    if constexpr (PH == 2) {
        for (int run = gw; run < TOK / 32; run += NGW) {
            const int wdw = 2 << (lane >> 4);
            const size_t t0 = (size_t)run * 32; const int tpos0 = (int)(t0 & (SEQ - 1));
            const bf16_t* up = Z + t0 * INW + lane * 8;
            bf16_t* op = MIX + t0 * DM + lane * 8;
            float sacc[8] = {0.f, 0.f, 0.f, 0.f, 0.f, 0.f, 0.f, 0.f};
#pragma unroll 1
            for (int ib = 1; ib <= 16; ib += 8) { bf16x8 ui[8]; bool ok[8];
#pragma unroll
                for (int q = 0; q < 8; ++q) { const int i = ib + q; ok[q] = (i <= wdw && tpos0 - i >= 0); ui[q] = *(const bf16x8*)(up - (size_t)(ok[q] ? i : 0) * INW); }
#pragma unroll
                for (int q = 0; q < 8; ++q) if (ok[q]) {
#pragma unroll
                    for (int e8 = 0; e8 < 8; ++e8) sacc[e8] += bf2f((unsigned short)ui[q][e8]); } }
#pragma unroll 1
            for (int tb = 0; tb < 32; tb += 8) {
                bf16x8 un[8], uo[8];
#pragma unroll
                for (int i = 0; i < 8; ++i) { un[i] = *(const bf16x8*)(up + (size_t)(tb + i) * INW);
                    const int told = tpos0 + tb + i - wdw; uo[i] = *(const bf16x8*)(up + (size_t)(tb + i - (told >= 0 ? wdw : 0)) * INW); }
#pragma unroll
                for (int i = 0; i < 8; ++i) { const int tpos = tpos0 + tb + i; const bool sub = tpos - wdw >= 0;
                    const float rc = 1.0f / (float)((tpos + 1 < wdw) ? tpos + 1 : wdw); float p[8];
#pragma unroll
                    for (int e8 = 0; e8 < 8; ++e8) { const float uv = bf2f((unsigned short)un[i][e8]); sacc[e8] += uv; if (sub) sacc[e8] -= bf2f((unsigned short)uo[i][e8]); p[e8] = sacc[e8] * rc - uv; }
                    u32x4 pw; pw.x = cvt_pk_bf16(p[0], p[1]); pw.y = cvt_pk_bf16(p[2], p[3]); pw.z = cvt_pk_bf16(p[4], p[5]); pw.w = cvt_pk_bf16(p[6], p[7]);
                    *(u32x4*)(op + (size_t)(tb + i) * DM) = pw; }
            }
        }
    }
    if constexpr (PH == 2) {
        bf16_t* BtM = WSP(bf16_t, WS_BTM); bf16_t* BtN = WSP(bf16_t, WS_BTN); float* CB = WSP(float, WS_CDB); float* DB = CB + 16 * 1024;
        { pg8::Gemm g{MEMKV, Wxq_t, 64 * 256, 1024, 256, 2048, 1024, 2}; pg8::StaticOrder S; S.init(64 * 256, 1024, G, bx); pg8::EpiPrep E{BtM, 0.0625f, 0}; pg8::gemm_phase(lds, g, S, E); }
        { pg8::Gemm g{Wxo_t, MEMKV + 1024, 64 * 256, 1024, 256, 1024, 2048, 3}; pg8::StaticOrder S; S.init(64 * 256, 1024, G, bx); pg8::EpiPrep E{BtN, 1.0f, 1}; pg8::gemm_phase(lds, g, S, E); }
        const float* cx = WSP(float, WS_CDX); const float* dx = cx + DM;
        for (int o8 = vcu * 512 + tid; o8 < 16 * 1024 * 8; o8 += G * 512) {
            const int o = o8 >> 3, part = o8 & 7;
            const int bt = o >> 10, hm = o & 1023, hh = hm >> 8, mm = hm & 255;
            const bf16_t* kr = MEMKV + (size_t)(bt * 256 + mm) * 2048 + hh * 256; float ca = 0.f, da = 0.f;
#pragma unroll
            for (int it = 0; it < 4; ++it) { const int d8 = part + 8 * it; const bf16x8 kv = *(const bf16x8*)(kr + d8 * 8);
                const f32x4 c0 = *(const f32x4*)(cx + hh * 256 + d8 * 8), c1 = *(const f32x4*)(cx + hh * 256 + d8 * 8 + 4), d0 = *(const f32x4*)(dx + hh * 256 + d8 * 8), d1 = *(const f32x4*)(dx + hh * 256 + d8 * 8 + 4);
#pragma unroll
                for (int e8 = 0; e8 < 8; ++e8) { const float kf = bf2f((unsigned short)kv[e8]); ca += (e8 < 4 ? c0[e8 & 3] : c1[e8 & 3]) * kf; da += (e8 < 4 ? d0[e8 & 3] : d1[e8 & 3]) * kf; } }
            ca += __shfl_xor(ca, 1); ca += __shfl_xor(ca, 2); ca += __shfl_xor(ca, 4); da += __shfl_xor(da, 1); da += __shfl_xor(da, 2); da += __shfl_xor(da, 4);
            if (part == 0) { CB[o] = ca * 0.0625f; DB[o] = da * 0.0625f; }
        }
    }
    if constexpr (PH == 3) {
        for (int it = 0; it * G < BATCH * 8 * NBLK; ++it) {
            const int u = it * G + vcu; if (u >= BATCH * 8 * NBLK) break;
            int bh = u >> 4, blk = u & 15;
            if (G == 256) { bh = it * 16 + (vcu >> 4); blk = ((vcu & 15) + 2 * it) & 15; }
            moba_unit(bh >> 3, bh & 7, blk, Z, KM, MIX, lds);
        }
    }
    if constexpr (PH == 4) { pg8::Gemm g{MIX, Wout_t, TOK, DM, DM}; pg8::StaticOrder S; S.init(TOK, DM, G, bx); pg8::EpiResStat<false, true> E{XB, XB, DM, ALPHA, nullptr, nullptr, nullptr, PST1}; pg8::gemm_phase(lds, g, S, E); }
    if constexpr (PH == 5) { }
    if constexpr (PH == 6) { pg8::Gemm g{XB, WSP(bf16_t, WS_BTM), TOK, DM, DM, 0, 0, 1, (size_t)DM * DM * 2}; pg8::StaticOrder S; S.init(TOK, DM, G, bx); pg8::EpiSoftmaxP E{XQ, PST1, WSP(float, WS_CDB), WSP(float, WS_CDB) + 16 * 1024, (LAS float*)(lds + 131072)}; pg8::gemm_phase(lds, g, S, E); }
    if constexpr (PH == 7) { for (int u = vcu; u < (TOK / 128) * 4; u += G) xattn_unit(u >> 2, u & 3, XQ, MEMKV, XO, lds); }
    if constexpr (PH == 8) { pg8::Gemm g{XQ, WSP(bf16_t, WS_BTN), TOK, DM, DM, 0, 0, 1, (size_t)DM * DM * 2}; pg8::StaticOrder S; S.init(TOK, DM, G, bx); pg8::EpiResStat<true, true> E{XB, XB, DM, ALPHA, PST1, c.in[I_LN1G], c.in[I_LN1B], PST2}; pg8::gemm_phase(lds, g, S, E); }
    if constexpr (PH == 9) { }
    if constexpr (PH == 10) { pg8::Gemm g{XB, Wgu_t, TOK, 2 * DFF, DM}; pg8::StaticOrder S; S.init(TOK, 2 * DFF, G, bx); pg8::EpiLnSwiGLU E{HF, DFF, PST2, WSP(float, WS_CDG), WSP(float, WS_CDG) + 2 * DFF}; pg8::gemm_phase(lds, g, S, E); }
    if constexpr (PH == 11) { pg8::Gemm g{HF, Wdn_t, TOK, DM, DFF}; pg8::StaticOrder S; S.init(TOK, DM, G, bx, 1); pg8::EpiResStat<true, false> E{XB, XB, DM, ALPHA, PST2, c.in[I_LN2G], c.in[I_LN2B], nullptr}; pg8::gemm_phase(lds, g, S, E); }
    if constexpr (PH == 12) { for (int r = gw * 4; r < TOK; r += NGW * 4) ln_rows4_bf16in(XB + (size_t)r * DM, c.in[I_LN3G], c.in[I_LN3B], H + (size_t)r * DM, DM, lane); }
}

__global__ void __launch_bounds__(512, 2) fwd_kernel(Args args) {
    extern __shared__ __attribute__((aligned(16))) unsigned char lds_raw[];
    Ctx c;
    c.in = args.in; c.lds = (LAS unsigned char*)lds_raw; c.ws = args.ws; c.H = args.out;
    c.tid = threadIdx.x; c.lane = c.tid & 63; c.wave = __builtin_amdgcn_readfirstlane(c.tid >> 6);
    c.G = gridDim.x; c.bx = blockIdx.x;
    c.vcu = (c.G % 8 == 0) ? (c.bx % 8) * (c.G / 8) + c.bx / 8 : c.bx;
    c.gw = c.vcu * 8 + c.wave; c.NGW = c.G * 8;
    const int lo = args.ph_lo, hi = args.ph_hi;
    volatile LAS unsigned* MISC = (volatile LAS unsigned*)(c.lds + LDS_MISC);
    if (c.tid < 2) MISC[c.tid] = 0u;
    __syncthreads();
    XcdBarrier bar; bar.bar = (unsigned*)(args.ws + WS_CTL); bar.x = 0; bar.st = MISC;
    if (hi - lo > 1) bar = xcd_barrier_post((unsigned*)(args.ws + WS_CTL), MISC);
    if (hi < 0) cg::this_grid().sync();
#define IN(k) (lo <= (k) && (k) < hi)
#define PHASE(k) do { if (IN(k)) { run_phase<k>(c); if (PROBE_PHASE == (k)) { xcd_barrier(bar); run_phase<k>(c); } } \
        if (IN(k) && IN((k) + 1)) { xcd_barrier(bar); } } while (0)
    PHASE(0); PHASE(1);
    if (IN(3)) run_phase<3>(c);
    __syncthreads();
    if (IN(2)) run_phase<2>(c);
    if (IN(3) && IN(4)) xcd_barrier(bar);
    PHASE(4); PHASE(6); PHASE(8); PHASE(10); PHASE(11); PHASE(12);
#undef IN
#undef PHASE
}

extern "C" void kernel_launch(void* const* d_in, const int* in_sizes, int n_in, void* d_out, int out_size, void* d_ws, size_t ws_size, hipStream_t stream) {
    static int grid = 0;
    if (grid == 0) {
        if (n_in != 18 || out_size != TOK * DM || ws_size < WS_END) { fprintf(stderr, "kernel_launch: unexpected shapes (n_in %d, out %d, ws %zu)\n", n_in, out_size, ws_size); grid = -1; return; }
        int dev = 0, cus = 0, per_cu = 0;
        (void)hipGetDevice(&dev); (void)hipDeviceGetAttribute(&cus, hipDeviceAttributeMultiprocessorCount, dev);
        if (hipFuncSetAttribute((const void*)fwd_kernel, hipFuncAttributeMaxDynamicSharedMemorySize, LDS_BYTES) != hipSuccess) { fprintf(stderr, "kernel_launch: hipFuncSetAttribute failed\n"); grid = -1; return; }
        if (hipOccupancyMaxActiveBlocksPerMultiprocessor(&per_cu, (const void*)fwd_kernel, 512, LDS_BYTES) != hipSuccess || per_cu < 1) { fprintf(stderr, "kernel_launch: occupancy query says %d\n", per_cu); per_cu = 1; }
        (void)hipGetLastError();
        grid = cus * 1;
        if (grid <= 0) grid = 256;
    }
    if (grid < 0) return;
    Args a{};
    for (int i = 0; i < 18; ++i) a.in[i] = (const float*)d_in[i];
    a.out = (float*)d_out; a.ws = (unsigned char*)d_ws;
#if N_LAUNCH_MODE == 1
    for (int p = 0; p < N_PHASES; ++p) { a.ph_lo = p; a.ph_hi = p + 1; hipLaunchKernelGGL(fwd_kernel, dim3(grid), dim3(512), LDS_BYTES, stream, a); }
#else
    a.ph_lo = 0; a.ph_hi = N_PHASES;
    (void)hipMemsetAsync((unsigned char*)d_ws + WS_CTL, 0, CTL_BYTES, stream);
    void* kargs[] = {&a};
    hipError_t e = hipLaunchCooperativeKernel((const void*)fwd_kernel, dim3(grid), dim3(512), kargs, LDS_BYTES, stream);
    if (e != hipSuccess) fprintf(stderr, "kernel_launch: cooperative launch failed: %s (grid %d)\n", hipGetErrorString(e), grid);
#endif
}
```

```cpp
#include <hip/hip_runtime.h>
#include <hip/hip_cooperative_groups.h>
#include <cstdio>
#include <cstdint>
namespace cg = cooperative_groups;

#ifndef N_LAUNCH_MODE
#define N_LAUNCH_MODE 0
#endif

#define LAS __attribute__((address_space(3)))
typedef unsigned short bf16_t;
typedef short bf16x8 __attribute__((ext_vector_type(8)));
typedef short s16x4 __attribute__((ext_vector_type(4)));
typedef float f32x4 __attribute__((ext_vector_type(4)));
typedef float f32x2 __attribute__((ext_vector_type(2)));
typedef unsigned u32x4 __attribute__((ext_vector_type(4)));
typedef unsigned u32x2 __attribute__((ext_vector_type(2)));

constexpr int BATCH = 16, SEQ = 4096, DM = 1024, TOK = BATCH * SEQ;
constexpr int MEMLEN = 256, MEMROWS = BATCH * MEMLEN;
constexpr int INW = 2048, DFF = 2816, NBLK = SEQ / 256;
constexpr float ALPHA = 1.189207115002721f;
constexpr float LN_EPS = 1e-5f;
constexpr float LOG2E = 1.4426950408889634f;

constexpr size_t MiB = 1u << 20;
constexpr size_t WS_KM = 0;
constexpr size_t WS_CTL = 1 * MiB, CTL_BYTES = 16384;
constexpr size_t WS_WIN = 2 * MiB, WS_WOUT = 6 * MiB, WS_WXQ = 8 * MiB, WS_WXKV = 10 * MiB, WS_WXO = 14 * MiB, WS_WGU = 16 * MiB, WS_WDN = 27 * MiB, WS_WPOOL = 33 * MiB;
constexpr size_t WS_MEMB = 34 * MiB, WS_MEMKV = 42 * MiB;
constexpr size_t WS_XB = 64 * MiB;
constexpr size_t WS_Z = 192 * MiB;
constexpr size_t WS_MIX = 448 * MiB;
constexpr size_t WS_HF = 192 * MiB;
constexpr size_t WS_PST1 = 576 * MiB, WS_PST2 = 584 * MiB;
constexpr size_t WS_CDX = 60 * MiB, WS_CDG = 60 * MiB + 65536;
constexpr size_t WS_CDB = 60 * MiB + 131072;
constexpr size_t WS_BTM = 592 * MiB, WS_BTN = 624 * MiB;
constexpr size_t WS_END = 656 * MiB;

typedef __bf16 bf16x2_t __attribute__((ext_vector_type(2)));
__device__ __forceinline__ unsigned cvt_pk_bf16(float lo, float hi) { f32x2 v = {lo, hi}; bf16x2_t b = __builtin_convertvector(v, bf16x2_t); return __builtin_bit_cast(unsigned, b); }
__device__ __forceinline__ float xmax16(float v) { auto r = __builtin_amdgcn_permlane16_swap(__float_as_uint(v), __float_as_uint(v), false, false); return fmaxf(__uint_as_float(r[0]), __uint_as_float(r[1])); }
__device__ __forceinline__ float xmax32(float v) { auto r = __builtin_amdgcn_permlane32_swap(__float_as_uint(v), __float_as_uint(v), false, false); return fmaxf(__uint_as_float(r[0]), __uint_as_float(r[1])); }
__device__ __forceinline__ float xsum16(float v) { auto r = __builtin_amdgcn_permlane16_swap(__float_as_uint(v), __float_as_uint(v), false, false); return __uint_as_float(r[0]) + __uint_as_float(r[1]); }
__device__ __forceinline__ float xsum32(float v) { auto r = __builtin_amdgcn_permlane32_swap(__float_as_uint(v), __float_as_uint(v), false, false); return __uint_as_float(r[0]) + __uint_as_float(r[1]); }
__device__ __forceinline__ float bf2f(unsigned short b) { return __uint_as_float(((unsigned)b) << 16); }
__device__ __forceinline__ float wave_sum(float v) {
#pragma unroll
    for (int o = 1; o < 64; o <<= 1) v += __shfl_xor(v, o);
    return v;
}

namespace pg8 {
constexpr int BM = 256, BK = 64, HALF = 128, HTB = HALF * BK * 2, STAGE_BYTES = 8 * HTB, NXCD = 8, WGM = 4;
__host__ __device__ __forceinline__ int lds_byte(int r, int c) { const int st = (r >> 4) * 2 + (c >> 5), rr = r & 15, cc = c & 31, ob = rr * 64 + cc * 2; return st * 1024 + (ob ^ (((ob >> 9) & 1) << 5)); }
__host__ __device__ __forceinline__ void stage_rc(int b, int& R, int& C) { const int st = b / 1024, sb = b % 1024, swz = sb ^ (((sb >> 9) & 1) << 5); R = (st >> 1) * 16 + swz / 64; C = (st & 1) * 32 + (swz % 64) / 2; }
__host__ __device__ __forceinline__ int perm32(int rho) { const int n = rho >> 4, i = rho & 15; return 8 * (i >> 2) + 4 * n + (i & 3); }

struct Unit { int pm, pn; };
struct Gemm { const bf16_t* A; const bf16_t* Bt; int M, N, K; int lda = 0, ldb = 0, mode = 0; size_t s1 = 0; };
__device__ __forceinline__ void unit_ptrs(const Gemm& g, const Unit& u, const char*& cA, const char*& cB) {
    const int lda = g.lda ? g.lda : g.K, ldb = g.ldb ? g.ldb : g.K;
    if (g.mode <= 1) { cA = (const char*)g.A + (size_t)u.pm * BM * lda * 2; cB = (const char*)g.Bt + (size_t)u.pn * BM * ldb * 2 + (g.mode == 1 ? (size_t)(u.pm >> 4) * g.s1 : 0); }
    else if (g.mode == 2) { cA = (const char*)g.A + (size_t)(u.pm >> 2) * 256 * lda * 2 + (size_t)(u.pm & 3) * 512; cB = (const char*)g.Bt + (size_t)u.pn * BM * ldb * 2 + (size_t)(u.pm & 3) * 512; }
    else { cA = (const char*)g.A + (size_t)u.pn * BM * lda * 2 + (size_t)(u.pm & 3) * 512; cB = (const char*)g.Bt + (size_t)(u.pm >> 2) * 256 * ldb * 2 + (size_t)(u.pm & 3) * 512; }
}

struct StaticOrder {
    int nM, nN, nwg, G, c, rev;
    __device__ void init(int M, int N, int G_, int c_, int rev_ = 0) { nM = M / BM; nN = N / BM; nwg = nM * nN; G = G_; c = c_; rev = rev_; }
    __device__ bool next(int i, Unit& u) const {
        const long L = (long)i * G + c; if (L >= nwg) return false;
        int wgid = (int)L; { const int q = nwg / NXCD, r = nwg % NXCD, xcd = wgid % NXCD; int off = wgid / NXCD; if (rev && r == 0) off = q - 1 - off; wgid = (xcd < r ? xcd * (q + 1) : r * (q + 1) + (xcd - r) * q) + off; }
        const int nig = WGM * nN, gid = wgid / nig, fm = gid * WGM, gsz = (nM - fm) < WGM ? (nM - fm) : WGM;
        u.pm = fm + ((wgid % nig) % gsz); u.pn = (wgid % nig) / gsz; return true;
    }
};

struct EpiBf16 {
    static constexpr bool PERM = true;
    bf16_t* O; int ldc; float* km = nullptr;
    __device__ __forceinline__ void operator()(const f32x4 (&acc)[2][2][4][2], const Unit& u, int wr, int wc, int fr, int fq) const {
        const int row0 = u.pm * BM + wr * 64 + fr; const int col0 = u.pn * BM + wc * 32 + 8 * fq;
#pragma unroll
        for (int ai = 0; ai < 2; ++ai)
#pragma unroll
            for (int m = 0; m < 4; ++m) { bf16_t* rowp = O + (size_t)(row0 + ai * HALF + m * 16) * ldc + col0;
#pragma unroll
                for (int bj = 0; bj < 2; ++bj) { const f32x4 v0 = acc[ai][bj][m][0], v1 = acc[ai][bj][m][1];
                    u32x4 w; w.x = cvt_pk_bf16(v0[0], v0[1]); w.y = cvt_pk_bf16(v0[2], v0[3]); w.z = cvt_pk_bf16(v1[0], v1[1]); w.w = cvt_pk_bf16(v1[2], v1[3]);
                    *(u32x4*)(rowp + bj * HALF) = w; } }
        if (km && (u.pn == 4 || u.pn == 5)) {
#pragma unroll
            for (int bj = 0; bj < 2; ++bj)
#pragma unroll
                for (int n = 0; n < 2; ++n) { f32x4 cs = (f32x4){0.f, 0.f, 0.f, 0.f};
#pragma unroll
                    for (int ai = 0; ai < 2; ++ai)
#pragma unroll
                        for (int m = 0; m < 4; ++m) cs = cs + acc[ai][bj][m][n];
#pragma unroll
                    for (int j = 0; j < 4; ++j) { float v = cs[j]; v += __shfl_xor(v, 1); v += __shfl_xor(v, 2); v += __shfl_xor(v, 4); v += __shfl_xor(v, 8);
                        if (fr == 0) { const int kc = (u.pn - 4) * 256 + bj * HALF + wc * 32 + 8 * fq + 4 * n + j;
                            __hip_atomic_fetch_add(km + (size_t)(((u.pm >> 4) * 8 + (kc >> 6)) * 16 + (u.pm & 15)) * 64 + (kc & 63), v * (1.0f / 256.0f), __ATOMIC_RELAXED, __HIP_MEMORY_SCOPE_AGENT); } } }
        }
    }
};
__device__ __forceinline__ void row_stats(const float* pst, int row, int fq, float& mu, float& rstd) {
    const f32x4 a = *(const f32x4*)(pst + (size_t)row * 32 + 8 * fq), b = *(const f32x4*)(pst + (size_t)row * 32 + 8 * fq + 4);
    float s1 = (a[0] + a[2]) + (b[0] + b[2]), s2 = (a[1] + a[3]) + (b[1] + b[3]);
    s1 = xsum32(xsum16(s1)); s2 = xsum32(xsum16(s2));
    mu = s1 * (1.0f / 1024.0f); const float var = s2 * (1.0f / 1024.0f) - mu * mu; rstd = 1.0f / sqrtf(var + LN_EPS);
}
template <bool HAS_LN, bool HAS_OUT> struct EpiResStat {
    static constexpr bool PERM = true;
    const bf16_t* R; bf16_t* YB; int ldc; float alpha; const float* st_in; const float* g; const float* b; float* st_out;
    __device__ __forceinline__ void operator()(const f32x4 (&acc)[2][2][4][2], const Unit& u, int wr, int wc, int fr, int fq) const {
        const int row0 = u.pm * BM + wr * 64 + fr; const int col0 = u.pn * BM + wc * 32 + 8 * fq;
        f32x4 gv[2][2], bv[2][2];
        if (HAS_LN) {
#pragma unroll
            for (int bj = 0; bj < 2; ++bj)
#pragma unroll
                for (int n = 0; n < 2; ++n) { gv[bj][n] = *(const f32x4*)(g + col0 + bj * HALF + 4 * n); bv[bj][n] = *(const f32x4*)(b + col0 + bj * HALF + 4 * n); }
        }
#pragma unroll
        for (int ai = 0; ai < 2; ++ai)
#pragma unroll
            for (int m = 0; m < 4; ++m) { const int row = row0 + ai * HALF + m * 16; const size_t off = (size_t)row * ldc + col0;
                float mu = 0.f, rs = 1.f; if (HAS_LN) row_stats(st_in, row, fq, mu, rs);
                float s1 = 0.f, s2 = 0.f;
#pragma unroll
                for (int bj = 0; bj < 2; ++bj) { const u32x4 rr = *(const u32x4*)(R + off + bj * HALF);
                    f32x4 v0 = (f32x4){__uint_as_float(rr.x << 16), __uint_as_float(rr.x & 0xffff0000u), __uint_as_float(rr.y << 16), __uint_as_float(rr.y & 0xffff0000u)};
                    f32x4 v1 = (f32x4){__uint_as_float(rr.z << 16), __uint_as_float(rr.z & 0xffff0000u), __uint_as_float(rr.w << 16), __uint_as_float(rr.w & 0xffff0000u)};
                    if (HAS_LN) { v0 = (v0 - mu) * rs * gv[bj][0] + bv[bj][0]; v1 = (v1 - mu) * rs * gv[bj][1] + bv[bj][1]; }
                    const f32x4 y0 = v0 * alpha + acc[ai][bj][m][0], y1 = v1 * alpha + acc[ai][bj][m][1];
                    u32x4 w; w.x = cvt_pk_bf16(y0[0], y0[1]); w.y = cvt_pk_bf16(y0[2], y0[3]); w.z = cvt_pk_bf16(y1[0], y1[1]); w.w = cvt_pk_bf16(y1[2], y1[3]);
                    *(u32x4*)(YB + off + bj * HALF) = w;
                    s1 += ((y0[0] + y0[1]) + (y0[2] + y0[3])) + ((y1[0] + y1[1]) + (y1[2] + y1[3]));
                    s2 += ((y0[0] * y0[0] + y0[1] * y0[1]) + (y0[2] * y0[2] + y0[3] * y0[3])) + ((y1[0] * y1[0] + y1[1] * y1[1]) + (y1[2] * y1[2] + y1[3] * y1[3])); }
                if (HAS_OUT) { s1 = xsum32(xsum16(s1)); s2 = xsum32(xsum16(s2));
                    if (fq == 0) *(f32x2*)(st_out + (size_t)row * 32 + (u.pn * 4 + wc) * 2) = (f32x2){s1, s2}; } }
    }
};
struct EpiLnBf16 {
    static constexpr bool PERM = true;
    bf16_t* O; int ldc; const float* st_in; const float* cvec; const float* dvec;
    __device__ __forceinline__ void operator()(const f32x4 (&acc)[2][2][4][2], const Unit& u, int wr, int wc, int fr, int fq) const {
        const int row0 = u.pm * BM + wr * 64 + fr; const int col0 = u.pn * BM + wc * 32 + 8 * fq;
        f32x4 cv[2][2], dv[2][2];
#pragma unroll
        for (int bj = 0; bj < 2; ++bj)
#pragma unroll
            for (int n = 0; n < 2; ++n) { cv[bj][n] = *(const f32x4*)(cvec + col0 + bj * HALF + 4 * n); dv[bj][n] = *(const f32x4*)(dvec + col0 + bj * HALF + 4 * n); }
#pragma unroll
        for (int ai = 0; ai < 2; ++ai)
#pragma unroll
            for (int m = 0; m < 4; ++m) { const int row = row0 + ai * HALF + m * 16; bf16_t* rowp = O + (size_t)row * ldc + col0;
                float mu, rs; row_stats(st_in, row, fq, mu, rs);
#pragma unroll
                for (int bj = 0; bj < 2; ++bj) { const f32x4 v0 = (acc[ai][bj][m][0] - cv[bj][0] * mu) * rs + dv[bj][0], v1 = (acc[ai][bj][m][1] - cv[bj][1] * mu) * rs + dv[bj][1];
                    u32x4 w; w.x = cvt_pk_bf16(v0[0], v0[1]); w.y = cvt_pk_bf16(v0[2], v0[3]); w.z = cvt_pk_bf16(v1[0], v1[1]); w.w = cvt_pk_bf16(v1[2], v1[3]);
                    *(u32x4*)(rowp + bj * HALF) = w; } }
    }
};
struct EpiLnSwiGLU {
    static constexpr bool PERM = false;
    bf16_t* O; int ldc; const float* st_in; const float* cvec; const float* dvec;
    __device__ __forceinline__ void operator()(const f32x4 (&acc)[2][2][4][2], const Unit& u, int wr, int wc, int fr, int fq) const {
        const int row0 = u.pm * BM + wr * 64 + fr; const int col0 = u.pn * HALF + wc * 16 + 4 * fq; const int gcol0 = u.pn * BM + wc * 32 + 4 * fq;
        f32x4 cv[2][2], dv[2][2];
#pragma unroll
        for (int bj = 0; bj < 2; ++bj)
#pragma unroll
            for (int n = 0; n < 2; ++n) { cv[bj][n] = *(const f32x4*)(cvec + gcol0 + bj * HALF + 16 * n); dv[bj][n] = *(const f32x4*)(dvec + gcol0 + bj * HALF + 16 * n); }
#pragma unroll
        for (int ai = 0; ai < 2; ++ai)
#pragma unroll
            for (int m = 0; m < 4; ++m) { const int row = row0 + ai * HALF + m * 16; bf16_t* rowp = O + (size_t)row * ldc + col0;
                float mu, rs; row_stats(st_in, row, fq, mu, rs);
#pragma unroll
                for (int bj = 0; bj < 2; ++bj) { const f32x4 g = (acc[ai][bj][m][0] - cv[bj][0] * mu) * rs + dv[bj][0], up = (acc[ai][bj][m][1] - cv[bj][1] * mu) * rs + dv[bj][1]; float h[4];
#pragma unroll
                    for (int j = 0; j < 4; ++j) { const float s = g[j] * __builtin_amdgcn_rcpf(1.0f + __builtin_amdgcn_exp2f(-g[j] * LOG2E)); h[j] = s * up[j]; }
                    u32x2 w; w.x = cvt_pk_bf16(h[0], h[1]); w.y = cvt_pk_bf16(h[2], h[3]);
                    *(u32x2*)(rowp + bj * 64) = w; } }
    }
};

struct EpiPrep {
    static constexpr bool PERM = true;
    bf16_t* O; float scale; int omode;
    __device__ __forceinline__ void operator()(const f32x4 (&acc)[2][2][4][2], const Unit& u, int wr, int wc, int fr, int fq) const {
        bf16_t* base = (omode == 0) ? O + (size_t)u.pm * 256 * 1024 + u.pn * 256 : O + (size_t)(u.pm >> 2) * 1048576 + (size_t)u.pn * 256 * 1024 + (u.pm & 3) * 256;
        base += (size_t)(wr * 64 + fr) * 1024 + wc * 32 + 8 * fq;
#pragma unroll
        for (int ai = 0; ai < 2; ++ai)
#pragma unroll
            for (int m = 0; m < 4; ++m) { bf16_t* rowp = base + (size_t)(ai * HALF + m * 16) * 1024;
#pragma unroll
                for (int bj = 0; bj < 2; ++bj) { const f32x4 v0 = acc[ai][bj][m][0] * scale, v1 = acc[ai][bj][m][1] * scale;
                    u32x4 w; w.x = cvt_pk_bf16(v0[0], v0[1]); w.y = cvt_pk_bf16(v0[2], v0[3]); w.z = cvt_pk_bf16(v1[0], v1[1]); w.w = cvt_pk_bf16(v1[2], v1[3]);
                    *(u32x4*)(rowp + bj * HALF) = w; } }
    }
};
struct EpiSoftmaxP {
    static constexpr bool PERM = true;
    bf16_t* P; const float* st_in; const float* cb; const float* db; LAS float* xb;
    __device__ __forceinline__ void operator()(f32x4 (&acc)[2][2][4][2], const Unit& u, int wr, int wc, int fr, int fq) const {
        const int rl0 = wr * 64 + fr; const int col0 = u.pn * BM + wc * 32 + 8 * fq; const int bt = u.pm >> 4;
        {
            f32x4 cv[2][2], dv[2][2];
#pragma unroll
            for (int bj = 0; bj < 2; ++bj)
#pragma unroll
                for (int n = 0; n < 2; ++n) { cv[bj][n] = *(const f32x4*)(cb + bt * 1024 + col0 + bj * HALF + 4 * n); dv[bj][n] = *(const f32x4*)(db + bt * 1024 + col0 + bj * HALF + 4 * n); }
#pragma unroll
            for (int ai = 0; ai < 2; ++ai)
#pragma unroll
                for (int m = 0; m < 4; ++m) { const int rl = rl0 + ai * HALF + m * 16;
                    float mu, rs; row_stats(st_in, u.pm * BM + rl, fq, mu, rs);
                    float mx = -INFINITY;
#pragma unroll
                    for (int bj = 0; bj < 2; ++bj)
#pragma unroll
                        for (int n = 0; n < 2; ++n) { const f32x4 s = (acc[ai][bj][m][n] - cv[bj][n] * mu) * rs + dv[bj][n]; acc[ai][bj][m][n] = s;
                            mx = fmaxf(fmaxf(mx, s[0]), fmaxf(s[1], fmaxf(s[2], s[3]))); }
                    mx = xmax32(xmax16(mx));
                    if (fq == 0) xb[rl * 4 + wc] = mx; }
        }
        asm volatile("s_waitcnt lgkmcnt(0)" ::: "memory"); __builtin_amdgcn_s_barrier(); asm volatile("" ::: "memory");
#pragma unroll
        for (int ai = 0; ai < 2; ++ai)
#pragma unroll
            for (int m = 0; m < 4; ++m) { const int rl = rl0 + ai * HALF + m * 16;
                const f32x4 mm = *(const LAS f32x4*)(xb + rl * 4); const float rmax = fmaxf(fmaxf(mm[0], mm[1]), fmaxf(mm[2], mm[3])) * LOG2E;
                float sm = 0.f;
#pragma unroll
                for (int bj = 0; bj < 2; ++bj)
#pragma unroll
                    for (int n = 0; n < 2; ++n) { f32x4 p;
#pragma unroll
                        for (int j = 0; j < 4; ++j) p[j] = __builtin_amdgcn_exp2f(__builtin_fmaf(acc[ai][bj][m][n][j], LOG2E, -rmax));
                        acc[ai][bj][m][n] = p; sm += (p[0] + p[1]) + (p[2] + p[3]); }
                sm = xsum32(xsum16(sm));
                if (fq == 0) xb[1024 + rl * 4 + wc] = sm; }
        asm volatile("s_waitcnt lgkmcnt(0)" ::: "memory"); __builtin_amdgcn_s_barrier(); asm volatile("" ::: "memory");
#pragma unroll
        for (int ai = 0; ai < 2; ++ai)
#pragma unroll
            for (int m = 0; m < 4; ++m) { const int rl = rl0 + ai * HALF + m * 16;
                const f32x4 ss = *(const LAS f32x4*)(xb + 1024 + rl * 4); const float inv = 1.0f / ((ss[0] + ss[1]) + (ss[2] + ss[3]));
                bf16_t* rowp = P + (size_t)(u.pm * BM + rl) * 1024 + col0;
#pragma unroll
                for (int bj = 0; bj < 2; ++bj) { const f32x4 v0 = acc[ai][bj][m][0] * inv, v1 = acc[ai][bj][m][1] * inv;
                    u32x4 w; w.x = cvt_pk_bf16(v0[0], v0[1]); w.y = cvt_pk_bf16(v0[2], v0[3]); w.z = cvt_pk_bf16(v1[0], v1[1]); w.w = cvt_pk_bf16(v1[2], v1[3]);
                    *(u32x4*)(rowp + bj * HALF) = w; } }
    }
};

template <class Epi, class Sched>
__device__ __forceinline__ void gemm_phase(LAS unsigned char* lds, const Gemm g, const Sched S, const Epi E) {
    const int tid = threadIdx.x, wid = __builtin_amdgcn_readfirstlane(tid >> 6), lane = tid & 63, wr = wid >> 2, wc = wid & 3, fr = lane & 15, fq = lane >> 4;
    const int K = g.K, nt = K / BK;
    const int lda = g.lda ? g.lda : K, ldb = g.ldb ? g.ldb : K;
    unsigned voffA[2], voffB[2];
#pragma unroll
    for (int i = 0; i < 2; ++i) { int R, C; stage_rc(tid * 16 + i * 8192, R, C); const int Rb = Epi::PERM ? ((R & ~31) + perm32(R & 31)) : R;
        voffA[i] = (unsigned)(R * lda + C) * 2u; voffB[i] = (unsigned)(Rb * ldb + C) * 2u; }
    const size_t kstep = (size_t)(BK * 2);
    const size_t hstepA = (size_t)HALF * lda * 2, hstepB = (size_t)HALF * ldb * 2;
    const unsigned ldsw = (unsigned)wid * 1024u;
    const int aoff = lds_byte(wr * 64 + fr, fq * 8), boff = lds_byte(wc * 32 + fr, fq * 8);
#define PG8_SA(b, h) (((b) * 2 + (h)) * HTB)
#define PG8_SB(b, h) ((4 + (b) * 2 + (h)) * HTB)
#define PG8_STAGE(bufoff, gbase, voff) do { _Pragma("unroll") for (int _i = 0; _i < 2; ++_i) \
        __builtin_amdgcn_global_load_lds((const unsigned*)((const char*)(gbase) + (voff)[_i]), (LAS unsigned*)(lds + (bufoff) + ldsw + _i * 8192), 16, 0, 0); } while (0)
#define PG8_LDA(dst, b, h) do { _Pragma("unroll") for (int m = 0; m < 4; ++m) _Pragma("unroll") for (int k = 0; k < 2; ++k) dst[m][k] = *(const LAS bf16x8*)(lds + PG8_SA(b, h) + aoff + m * 2048 + k * 1024); } while (0)
#define PG8_LDB(dst, b, h) do { _Pragma("unroll") for (int n = 0; n < 2; ++n) _Pragma("unroll") for (int k = 0; k < 2; ++k) dst[n][k] = *(const LAS bf16x8*)(lds + PG8_SB(b, h) + boff + n * 2048 + k * 1024); } while (0)
#define PG8_MMA(ai, bj, At, Bt) do { __builtin_amdgcn_s_setprio(1); _Pragma("unroll") for (int m = 0; m < 4; ++m) _Pragma("unroll") for (int n = 0; n < 2; ++n) _Pragma("unroll") for (int k = 0; k < 2; ++k) \
        acc[ai][bj][m][n] = __builtin_amdgcn_mfma_f32_16x16x32_bf16(Bt[n][k], At[m][k], acc[ai][bj][m][n], 0, 0, 0); __builtin_amdgcn_s_setprio(0); } while (0)
#define PG8_WAIT_V(n) asm volatile("s_waitcnt vmcnt(" #n ")" ::: "memory")
#define PG8_WAIT_L(n) asm volatile("s_waitcnt lgkmcnt(" #n ")" ::: "memory")
#define PG8_BAR __builtin_amdgcn_s_barrier()
#define PG8_SCHED __builtin_amdgcn_sched_barrier(0)
    Unit cur, nxt; int ui = 0;
    if (!S.next(0, cur)) return;
    f32x4 acc[2][2][4][2];
#pragma unroll
    for (int a = 0; a < 2; ++a)
#pragma unroll
        for (int b = 0; b < 2; ++b)
#pragma unroll
            for (int m = 0; m < 4; ++m)
#pragma unroll
                for (int n = 0; n < 2; ++n) acc[a][b][m][n] = (f32x4){0.f, 0.f, 0.f, 0.f};
    bf16x8 At[4][2], B0[2][2], B1[2][2];
    const char* cA; const char* cB; unit_ptrs(g, cur, cA, cB);
    PG8_STAGE(PG8_SB(0, 0), cB, voffB); PG8_STAGE(PG8_SB(0, 1), cB + hstepB, voffB); PG8_STAGE(PG8_SA(0, 0), cA, voffA); PG8_STAGE(PG8_SA(0, 1), cA + hstepA, voffA);
    if (wr == 1) PG8_BAR;
    PG8_WAIT_V(2); PG8_BAR;
    PG8_STAGE(PG8_SB(1, 0), cB + kstep, voffB); PG8_STAGE(PG8_SA(1, 0), cA + kstep, voffA); PG8_STAGE(PG8_SB(1, 1), cB + hstepB + kstep, voffB);
    PG8_WAIT_V(6); PG8_BAR;
    for (;;) {
        const bool has_next = S.next(ui + 1, nxt);
        const char* nA = cA; const char* nB = cB; if (has_next) unit_ptrs(g, nxt, nA, nB);
#pragma unroll 1
        for (int t = 0; t < nt; t += 2) {
            const bool last = (t == nt - 2);
            const char* a1 = cA + (size_t)(t + 1) * kstep;
            const char* a2 = last ? nA : cA + (size_t)(t + 2) * kstep; const char* b2 = last ? nB : cB + (size_t)(t + 2) * kstep;
            const char* a3 = a2 + kstep; const char* b3 = b2 + kstep;
            PG8_LDB(B0, 0, 0); PG8_LDB(B1, 0, 1); PG8_SCHED; PG8_LDA(At, 0, 0); PG8_STAGE(PG8_SA(1, 1), a1 + hstepA, voffA);
            PG8_WAIT_V(8); PG8_WAIT_L(0); PG8_BAR; PG8_MMA(0, 0, At, B0); PG8_MMA(0, 1, At, B1); PG8_BAR; PG8_SCHED;
            PG8_LDA(At, 0, 1); PG8_STAGE(PG8_SB(0, 0), b2, voffB); PG8_STAGE(PG8_SB(0, 1), b2 + hstepB, voffB); PG8_STAGE(PG8_SA(0, 0), a2, voffA);
            PG8_WAIT_V(8); PG8_WAIT_L(0); PG8_BAR; PG8_MMA(1, 0, At, B0); PG8_MMA(1, 1, At, B1); PG8_BAR; PG8_SCHED;
            PG8_LDB(B0, 1, 0); PG8_LDB(B1, 1, 1); PG8_SCHED; PG8_LDA(At, 1, 0); PG8_STAGE(PG8_SA(0, 1), a2 + hstepA, voffA);
            PG8_WAIT_V(8); PG8_WAIT_L(0); PG8_BAR; PG8_MMA(0, 0, At, B0); PG8_MMA(0, 1, At, B1); PG8_BAR; PG8_SCHED;
            PG8_LDA(At, 1, 1); PG8_STAGE(PG8_SB(1, 0), b3, voffB); PG8_STAGE(PG8_SB(1, 1), b3 + hstepB, voffB); PG8_STAGE(PG8_SA(1, 0), a3, voffA);
            PG8_WAIT_V(8); PG8_WAIT_L(0); PG8_BAR; PG8_MMA(1, 0, At, B0); PG8_MMA(1, 1, At, B1); PG8_BAR; PG8_SCHED;
        }
        if (wr == 0) PG8_BAR;
        E(acc, cur, wr, wc, fr, fq);
        if (!has_next) break;
#pragma unroll
        for (int a = 0; a < 2; ++a)
#pragma unroll
            for (int b = 0; b < 2; ++b)
#pragma unroll
                for (int m = 0; m < 4; ++m)
#pragma unroll
                    for (int n = 0; n < 2; ++n) acc[a][b][m][n] = (f32x4){0.f, 0.f, 0.f, 0.f};
        cur = nxt; cA = nA; cB = nB; ++ui;
        if (wr == 1) PG8_BAR;
    }
    PG8_WAIT_V(0);
    PG8_BAR;
#undef PG8_SA
#undef PG8_SB
#undef PG8_STAGE
#undef PG8_LDA
#undef PG8_LDB
#undef PG8_MMA
#undef PG8_WAIT_V
#undef PG8_WAIT_L
#undef PG8_BAR
#undef PG8_SCHED
}
}

__device__ __forceinline__ s16x4 tr_read(const LAS unsigned char* p) { return __builtin_bit_cast(s16x4, __builtin_amdgcn_ds_read_tr16_b64_v4i16((LAS s16x4*)p)); }

template <int HD, int QI, int KT16 = 4>
__device__ __forceinline__ void attn_tile(const LAS unsigned char* Ks, const LAS unsigned char* Vs, const bf16x8 (&qf)[QI][HD / 32],
                                          float (&m)[QI], float (&l)[QI], f32x4 (&o)[QI][HD / 16], float sc,
                                          int maskmode, const int (&qloc)[QI], int kbase, const bool (&keep)[QI], int fr, int fq) {
    constexpr int KP = 2 * HD + 32;
    f32x4 s[QI][KT16];
#pragma unroll
    for (int qi = 0; qi < QI; ++qi)
#pragma unroll
        for (int kt = 0; kt < KT16; ++kt) s[qi][kt] = (f32x4){0.f, 0.f, 0.f, 0.f};
#pragma unroll
    for (int kt = 0; kt < KT16; ++kt)
#pragma unroll
        for (int dk = 0; dk < HD / 32; ++dk) {
            const bf16x8 kf = *(const LAS bf16x8*)(Ks + (16 * kt + fr) * KP + (32 * dk + 8 * fq) * 2);
#pragma unroll
            for (int qi = 0; qi < QI; ++qi) s[qi][kt] = __builtin_amdgcn_mfma_f32_16x16x32_bf16(kf, qf[qi][dk], s[qi][kt], 0, 0, 0);
        }
    float mxs[QI]; bool need = false;
#pragma unroll
    for (int qi = 0; qi < QI; ++qi) {
        if (maskmode == 1) {
#pragma unroll
            for (int kt = 0; kt < KT16; ++kt)
#pragma unroll
                for (int r = 0; r < 4; ++r) if (kbase + 16 * kt + 4 * fq + r > qloc[qi]) s[qi][kt][r] = -INFINITY;
        }
        float mx = fmaxf(fmaxf(s[qi][0][0], s[qi][0][1]), fmaxf(s[qi][0][2], s[qi][0][3]));
#pragma unroll
        for (int kt = 1; kt < KT16; ++kt) { mx = fmaxf(fmaxf(mx, s[qi][kt][0]), s[qi][kt][1]); mx = fmaxf(fmaxf(mx, s[qi][kt][2]), s[qi][kt][3]); }
        mx = xmax32(xmax16(mx));
        mxs[qi] = mx * sc;
        need = need || (keep[qi] && mxs[qi] > m[qi] + 8.0f);
    }
    if (__ballot(need) != 0ull) {
#pragma unroll
        for (int qi = 0; qi < QI; ++qi) {
            const bool upd = keep[qi] && mxs[qi] > m[qi] + 8.0f;
            const float mn = upd ? mxs[qi] : m[qi];
            const float al = __builtin_amdgcn_exp2f(m[qi] - mn); m[qi] = mn; l[qi] *= al;
#pragma unroll
            for (int dt = 0; dt < HD / 16; ++dt) o[qi][dt] = o[qi][dt] * al;
        }
    }
    bf16x8 pf[QI][KT16 / 2];
#pragma unroll
    for (int qi = 0; qi < QI; ++qi) {
        const float moff = keep[qi] ? -m[qi] : -INFINITY;
        float rs = 0.f;
#pragma unroll
        for (int kt = 0; kt < KT16; ++kt)
#pragma unroll
            for (int r = 0; r < 4; ++r) { const float p = __builtin_amdgcn_exp2f(__builtin_fmaf(s[qi][kt][r], sc, moff)); s[qi][kt][r] = p; rs += p; }
        l[qi] += rs;
#pragma unroll
        for (int p2 = 0; p2 < KT16 / 2; ++p2) {
            u32x4 w; w.x = cvt_pk_bf16(s[qi][2 * p2][0], s[qi][2 * p2][1]); w.y = cvt_pk_bf16(s[qi][2 * p2][2], s[qi][2 * p2][3]);
            w.z = cvt_pk_bf16(s[qi][2 * p2 + 1][0], s[qi][2 * p2 + 1][1]); w.w = cvt_pk_bf16(s[qi][2 * p2 + 1][2], s[qi][2 * p2 + 1][3]);
            pf[qi][p2] = __builtin_bit_cast(bf16x8, w);
        }
    }
    const LAS unsigned char* vb = Vs + (4 * fq + (fr >> 2)) * KP + (4 * (fr & 3)) * 2;
#pragma unroll
    for (int dt = 0; dt < HD / 16; ++dt)
#pragma unroll
        for (int p2 = 0; p2 < KT16 / 2; ++p2) {
            const s16x4 lo = tr_read(vb + (32 * p2) * KP + 32 * dt);
            const s16x4 hi = tr_read(vb + (32 * p2 + 16) * KP + 32 * dt);
            const bf16x8 vf = (bf16x8){lo[0], lo[1], lo[2], lo[3], hi[0], hi[1], hi[2], hi[3]};
#pragma unroll
            for (int qi = 0; qi < QI; ++qi) o[qi][dt] = __builtin_amdgcn_mfma_f32_16x16x32_bf16(vf, pf[qi][p2], o[qi][dt], 0, 0, 0);
        }
}

template <int HD, int QI, int KT16 = 4>
__device__ __forceinline__ void attn_tile_pl(const LAS unsigned char* Ks, const LAS unsigned char* Vs, const bf16x8 (&qf)[QI][HD / 32],
                                          float (&m)[QI], float (&l)[QI], f32x4 (&o)[QI][HD / 16], float sc,
                                          int maskmode, const int (&qloc)[QI], int kbase, const bool (&keep)[QI], int fr, int fq) {
    constexpr int KP = 2 * HD + 32;
    constexpr int NF = (HD / 32) * KT16, CH = 4, NCH = NF / CH;
    static_assert(NF % CH == 0, "fragment chunking");
    f32x4 s[QI][KT16];
#pragma unroll
    for (int qi = 0; qi < QI; ++qi)
#pragma unroll
        for (int kt = 0; kt < KT16; ++kt) s[qi][kt] = (f32x4){0.f, 0.f, 0.f, 0.f};
    const LAS unsigned char* kb = Ks + fr * KP + 16 * fq;
#define KFRAG(f) (*(const LAS bf16x8*)(kb + (16 * ((f) % KT16)) * KP + 64 * ((f) / KT16)))
    bf16x8 kf[2][CH];
#pragma unroll
    for (int i = 0; i < CH; ++i) kf[0][i] = KFRAG(i);
#pragma unroll
    for (int c = 0; c < NCH; ++c) {
        if (c + 1 < NCH) {
#pragma unroll
            for (int i = 0; i < CH; ++i) kf[(c + 1) & 1][i] = KFRAG((c + 1) * CH + i);
        }
        __builtin_amdgcn_sched_barrier(0);
#pragma unroll
        for (int i = 0; i < CH; ++i) { const int f = c * CH + i, kt = f % KT16, dk = f / KT16;
#pragma unroll
            for (int qi = 0; qi < QI; ++qi) s[qi][kt] = __builtin_amdgcn_mfma_f32_16x16x32_bf16(kf[c & 1][i], qf[qi][dk], s[qi][kt], 0, 0, 0); }
        __builtin_amdgcn_sched_barrier(0);
    }
#undef KFRAG
    constexpr int NV = (KT16 / 2) * (HD / 16), NVC = NV / CH;
    static_assert(NV % CH == 0, "V fragment chunking");
    const LAS unsigned char* vb = Vs + (4 * fq + (fr >> 2)) * KP + (4 * (fr & 3)) * 2;
#define VLO(g) tr_read(vb + (32 * ((g) / (HD / 16))) * KP + 32 * ((g) % (HD / 16)))
#define VHI(g) tr_read(vb + (32 * ((g) / (HD / 16)) + 16) * KP + 32 * ((g) % (HD / 16)))
    s16x4 vlo[2][CH], vhi[2][CH];
#pragma unroll
    for (int i = 0; i < CH; ++i) { vlo[0][i] = VLO(i); vhi[0][i] = VHI(i); }
    __builtin_amdgcn_sched_barrier(0);
    float mxs[QI]; bool need = false;
#pragma unroll
    for (int qi = 0; qi < QI; ++qi) {
        if (maskmode == 1) {
#pragma unroll
            for (int kt = 0; kt < KT16; ++kt)
#pragma unroll
                for (int r = 0; r < 4; ++r) if (kbase + 16 * kt + 4 * fq + r > qloc[qi]) s[qi][kt][r] = -INFINITY;
        }
        float mx = fmaxf(fmaxf(s[qi][0][0], s[qi][0][1]), fmaxf(s[qi][0][2], s[qi][0][3]));
#pragma unroll
        for (int kt = 1; kt < KT16; ++kt) { mx = fmaxf(fmaxf(mx, s[qi][kt][0]), s[qi][kt][1]); mx = fmaxf(fmaxf(mx, s[qi][kt][2]), s[qi][kt][3]); }
        mx = xmax32(xmax16(mx));
        mxs[qi] = mx * sc;
        need = need || (keep[qi] && mxs[qi] > m[qi] + 8.0f);
    }
    if (__ballot(need) != 0ull) {
#pragma unroll
        for (int qi = 0; qi < QI; ++qi) {
            const bool upd = keep[qi] && mxs[qi] > m[qi] + 8.0f;
            const float mn = upd ? mxs[qi] : m[qi];
            const float al = __builtin_amdgcn_exp2f(m[qi] - mn); m[qi] = mn; l[qi] *= al;
#pragma unroll
            for (int dt = 0; dt < HD / 16; ++dt) o[qi][dt] = o[qi][dt] * al;
        }
    }
    bf16x8 pf[QI][KT16 / 2];
#pragma unroll
    for (int qi = 0; qi < QI; ++qi) {
        const float moff = keep[qi] ? -m[qi] : -INFINITY;
        float rs = 0.f;
#pragma unroll
        for (int kt = 0; kt < KT16; ++kt)
#pragma unroll
            for (int r = 0; r < 4; ++r) { const float p = __builtin_amdgcn_exp2f(__builtin_fmaf(s[qi][kt][r], sc, moff)); s[qi][kt][r] = p; rs += p; }
        l[qi] += rs;
#pragma unroll
        for (int p2 = 0; p2 < KT16 / 2; ++p2) {
            u32x4 w; w.x = cvt_pk_bf16(s[qi][2 * p2][0], s[qi][2 * p2][1]); w.y = cvt_pk_bf16(s[qi][2 * p2][2], s[qi][2 * p2][3]);
            w.z = cvt_pk_bf16(s[qi][2 * p2 + 1][0], s[qi][2 * p2 + 1][1]); w.w = cvt_pk_bf16(s[qi][2 * p2 + 1][2], s[qi][2 * p2 + 1][3]);
            pf[qi][p2] = __builtin_bit_cast(bf16x8, w);
        }
    }
    __builtin_amdgcn_sched_barrier(0);
#pragma unroll
    for (int c = 0; c < NVC; ++c) {
        if (c + 1 < NVC) {
#pragma unroll
            for (int i = 0; i < CH; ++i) { vlo[(c + 1) & 1][i] = VLO((c + 1) * CH + i); vhi[(c + 1) & 1][i] = VHI((c + 1) * CH + i); }
        }
        __builtin_amdgcn_sched_barrier(0);
#pragma unroll
        for (int i = 0; i < CH; ++i) { const int g = c * CH + i, p2 = g / (HD / 16), dt = g % (HD / 16);
            const s16x4 lo = vlo[c & 1][i], hi = vhi[c & 1][i];
            const bf16x8 vf = (bf16x8){lo[0], lo[1], lo[2], lo[3], hi[0], hi[1], hi[2], hi[3]};
#pragma unroll
            for (int qi = 0; qi < QI; ++qi) o[qi][dt] = __builtin_amdgcn_mfma_f32_16x16x32_bf16(vf, pf[qi][p2], o[qi][dt], 0, 0, 0); }
        __builtin_amdgcn_sched_barrier(0);
    }
#undef VLO
#undef VHI
}

template <int HD> struct Stage { static constexpr int CH = HD / 8, NLD = 64 * CH / 512, KP = 2 * HD + 32, TILE_B = 64 * KP; u32x4 k[NLD], v[NLD]; };
template <int HD>
__device__ __forceinline__ void stage_load(Stage<HD>& st, const bf16_t* Kg, const bf16_t* Vg, int gp, int tid) {
#pragma unroll
    for (int i = 0; i < Stage<HD>::NLD; ++i) { const int idx = tid + 512 * i, row = idx / Stage<HD>::CH, ch = idx % Stage<HD>::CH;
        st.k[i] = *(const u32x4*)(Kg + (size_t)row * gp + ch * 8); st.v[i] = *(const u32x4*)(Vg + (size_t)row * gp + ch * 8); }
}
template <int HD>
__device__ __forceinline__ void stage_store(const Stage<HD>& st, LAS unsigned char* buf, int tid) {
#pragma unroll
    for (int i = 0; i < Stage<HD>::NLD; ++i) { const int idx = tid + 512 * i, row = idx / Stage<HD>::CH, ch = idx % Stage<HD>::CH;
        *(LAS u32x4*)(buf + row * Stage<HD>::KP + ch * 16) = st.k[i]; *(LAS u32x4*)(buf + Stage<HD>::TILE_B + row * Stage<HD>::KP + ch * 16) = st.v[i]; }
}

namespace moba {
constexpr int HD = 64, KP = 2 * HD + 32, BLKB = 256 * KP;
constexpr int L_K = 0, L_V = BLKB, L_O = 2 * BLKB, L_M = L_O + 256 * 128, L_L = L_M + 1024, L_LIST = L_L + 1024, L_CNT = L_LIST + 15 * 256, L_Q = L_CNT + 64, L_END = L_Q + 256 * 128;
struct BlkStage { u32x4 k[4], v[4]; };
__device__ __forceinline__ void blk_load(BlkStage& st, const bf16_t* Kg, const bf16_t* Vg, int tid) {
#pragma unroll
    for (int i = 0; i < 4; ++i) { const int idx = tid + 512 * i, row = idx >> 3, ch = idx & 7;
        st.k[i] = *(const u32x4*)(Kg + (size_t)row * INW + ch * 8); st.v[i] = *(const u32x4*)(Vg + (size_t)row * INW + ch * 8); }
}
__device__ __forceinline__ void blk_store(const BlkStage& st, LAS unsigned char* lds, int tid) {
#pragma unroll
    for (int i = 0; i < 4; ++i) { const int idx = tid + 512 * i, row = idx >> 3, ch = idx & 7;
        *(LAS u32x4*)(lds + L_K + row * KP + ch * 16) = st.k[i]; *(LAS u32x4*)(lds + L_V + row * KP + ch * 16) = st.v[i]; }
}
template <int QI>
__device__ __forceinline__ void past_tiles(LAS unsigned char* lds, const int (&rows)[QI], const bool (&valid)[QI], float sc, int fr, int fq) {
    bf16x8 qf[QI][2]; float m[QI], l[QI]; f32x4 o[QI][4]; int qloc[QI];
#pragma unroll
    for (int qi = 0; qi < QI; ++qi) {
#pragma unroll
        for (int dk = 0; dk < 2; ++dk) qf[qi][dk] = *(const LAS bf16x8*)(lds + L_Q + rows[qi] * 128 + (32 * dk + 8 * fq) * 2);
        m[qi] = *(const LAS float*)(lds + L_M + rows[qi] * 4);
        l[qi] = (fq == 0) ? *(const LAS float*)(lds + L_L + rows[qi] * 4) : 0.f;
        qloc[qi] = 0;
#pragma unroll
        for (int dt = 0; dt < 4; ++dt) { const u32x2 ov = *(const LAS u32x2*)(lds + L_O + rows[qi] * 128 + (16 * dt + 4 * fq) * 2);
            o[qi][dt] = (f32x4){__uint_as_float(ov.x << 16), __uint_as_float(ov.x & 0xffff0000u), __uint_as_float(ov.y << 16), __uint_as_float(ov.y & 0xffff0000u)}; }
    }
    if constexpr (QI == 1) attn_tile_pl<HD, 1, 16>(lds + L_K, lds + L_V, qf, m, l, o, sc, 0, qloc, 0, valid, fr, fq);
    else {
#pragma unroll 1
        for (int half = 0; half < 2; ++half)
            attn_tile<HD, QI, 8>(lds + L_K + half * 128 * KP, lds + L_V + half * 128 * KP, qf, m, l, o, sc, 0, qloc, 0, valid, fr, fq);
    }
#pragma unroll
    for (int qi = 0; qi < QI; ++qi) {
        const float lt = xsum32(xsum16(l[qi]));
        if (valid[qi]) {
            if (fq == 0) { *(LAS float*)(lds + L_M + rows[qi] * 4) = m[qi]; *(LAS float*)(lds + L_L + rows[qi] * 4) = lt; }
#pragma unroll
            for (int dt = 0; dt < 4; ++dt) { u32x2 ov; ov.x = cvt_pk_bf16(o[qi][dt][0], o[qi][dt][1]); ov.y = cvt_pk_bf16(o[qi][dt][2], o[qi][dt][3]);
                *(LAS u32x2*)(lds + L_O + rows[qi] * 128 + (16 * dt + 4 * fq) * 2) = ov; }
        }
    }
}
}

__device__ __forceinline__ void moba_unit(int b, int h, int blk, const bf16_t* Z, const float* KM, bf16_t* MIX, LAS unsigned char* lds) {
    using namespace moba;
    constexpr int QI = 2;
    const int tid = threadIdx.x, lane = tid & 63, w = __builtin_amdgcn_readfirstlane(tid >> 6), fr = lane & 15, fq = lane >> 4;
    const size_t rowb = (size_t)b * SEQ;
    const int q0 = 256 * blk + 32 * w;
    const bf16_t* Kh = Z + rowb * INW + 1024 + h * 64; const bf16_t* Vh = Z + rowb * INW + 1536 + h * 64;
    const bf16_t* Qblk = Z + (rowb + 256 * blk) * INW + 512 + h * 64;
    BlkStage st;
    blk_load(st, Kh + (size_t)(256 * blk) * INW, Vh + (size_t)(256 * blk) * INW, tid);
    bf16x8 qf[QI][2];
#pragma unroll
    for (int qi = 0; qi < QI; ++qi)
#pragma unroll
        for (int dk = 0; dk < 2; ++dk) qf[qi][dk] = *(const bf16x8*)(Qblk + (size_t)(32 * w + 16 * qi + fr) * INW + 32 * dk + 8 * fq);
    __syncthreads();
    if (tid < 16) *(LAS unsigned*)(lds + L_CNT + tid * 4) = 0u;
    if (blk > 0) {
#pragma unroll
        for (int i = 0; i < 4; ++i) { const int idx = tid + 512 * i, row = idx >> 3, ch = idx & 7;
            *(LAS u32x4*)(lds + L_Q + row * 128 + ch * 16) = *(const u32x4*)(Qblk + (size_t)row * INW + ch * 8); }
    }
    __syncthreads();
    {
        float v1[QI], v2[QI], v3[QI]; int i1[QI], i2[QI], i3[QI];
#pragma unroll
        for (int qi = 0; qi < QI; ++qi) { v1[qi] = v2[qi] = v3[qi] = -INFINITY; i1[qi] = i2[qi] = i3[qi] = -1; }
        const float* kmb = KM + (size_t)((b * 8 + h) * NBLK) * 64;
        for (int j = 0; j < blk; ++j) {
            f32x4 km[2][2];
#pragma unroll
            for (int dk = 0; dk < 2; ++dk) { km[dk][0] = *(const f32x4*)(kmb + j * 64 + 32 * dk + 8 * fq); km[dk][1] = *(const f32x4*)(kmb + j * 64 + 32 * dk + 8 * fq + 4); }
#pragma unroll
            for (int qi = 0; qi < QI; ++qi) {
                float g = 0.f;
#pragma unroll
                for (int dk = 0; dk < 2; ++dk)
#pragma unroll
                    for (int e = 0; e < 8; ++e) g += bf2f((unsigned short)qf[qi][dk][e]) * km[dk][e >> 2][e & 3];
                g = xsum32(xsum16(g));
                if (g > v1[qi]) { v3[qi] = v2[qi]; i3[qi] = i2[qi]; v2[qi] = v1[qi]; i2[qi] = i1[qi]; v1[qi] = g; i1[qi] = j; }
                else if (g > v2[qi]) { v3[qi] = v2[qi]; i3[qi] = i2[qi]; v2[qi] = g; i2[qi] = j; }
                else if (g > v3[qi]) { v3[qi] = g; i3[qi] = j; }
            }
        }
        if (fq == 0) {
#pragma unroll
            for (int qi = 0; qi < QI; ++qi) { const int row = 32 * w + 16 * qi + fr; const int ids[3] = {i1[qi], i2[qi], i3[qi]};
#pragma unroll
                for (int k3 = 0; k3 < 3; ++k3) if (ids[k3] >= 0) {
                    const unsigned pos = __hip_atomic_fetch_add((LAS unsigned*)(lds + L_CNT + ids[k3] * 4), 1u, __ATOMIC_RELAXED, __HIP_MEMORY_SCOPE_WORKGROUP);
                    *(LAS unsigned char*)(lds + L_LIST + ids[k3] * 256 + pos) = (unsigned char)row; } }
        }
    }
    blk_store(st, lds, tid);
    __syncthreads();
    { const int jn = blk > 0 ? 0 : blk; blk_load(st, Kh + (size_t)(256 * jn) * INW, Vh + (size_t)(256 * jn) * INW, tid); }
    const float sc = 0.125f * LOG2E;
    {
        float m[QI], l[QI]; f32x4 o[QI][4]; int qloc[QI]; bool keep[QI];
#pragma unroll
        for (int qi = 0; qi < QI; ++qi) { m[qi] = -1e30f; l[qi] = 0.f; qloc[qi] = 32 * w + 16 * qi + fr; keep[qi] = true;
#pragma unroll
            for (int dt = 0; dt < 4; ++dt) o[qi][dt] = (f32x4){0.f, 0.f, 0.f, 0.f}; }
#pragma unroll 1
        for (int half = 0; half < 2; ++half)
            if (128 * half <= 32 * w) attn_tile<HD, QI, 8>(lds + L_K + half * 128 * KP, lds + L_V + half * 128 * KP, qf, m, l, o, sc, 1, qloc, 128 * half, keep, fr, fq);
#pragma unroll
        for (int qi = 0; qi < QI; ++qi) {
            const float lt = xsum32(xsum16(l[qi])); const int row = 32 * w + 16 * qi + fr;
            if (blk == 0) {
                const float inv = 1.0f / lt; bf16_t* op = MIX + (rowb + q0 + 16 * qi + fr) * DM + 512 + h * 64 + 4 * fq;
#pragma unroll
                for (int dt = 0; dt < 4; ++dt) { const f32x4 v = o[qi][dt] * inv; u32x2 wv; wv.x = cvt_pk_bf16(v[0], v[1]); wv.y = cvt_pk_bf16(v[2], v[3]); *(u32x2*)(op + 16 * dt) = wv; }
            } else {
                if (fq == 0) { *(LAS float*)(lds + L_M + row * 4) = m[qi]; *(LAS float*)(lds + L_L + row * 4) = lt; }
#pragma unroll
                for (int dt = 0; dt < 4; ++dt) { u32x2 ov; ov.x = cvt_pk_bf16(o[qi][dt][0], o[qi][dt][1]); ov.y = cvt_pk_bf16(o[qi][dt][2], o[qi][dt][3]);
                    *(LAS u32x2*)(lds + L_O + row * 128 + (16 * dt + 4 * fq) * 2) = ov; }
            }
        }
    }
    for (int j = 0; j < blk; ++j) {
        __syncthreads();
        blk_store(st, lds, tid);
        __syncthreads();
        { const int jn = (j + 1 < blk) ? j + 1 : j; blk_load(st, Kh + (size_t)(256 * jn) * INW, Vh + (size_t)(256 * jn) * INW, tid); }
        const int n = (int)*(const LAS unsigned*)(lds + L_CNT + j * 4);
        const int tiles = (n + 15) >> 4;
        for (int tw = w; tw < tiles; tw += 8) {
            int rows[1]; bool valid[1];
            { const int idx = 16 * tw + fr; valid[0] = idx < n; rows[0] = *(const LAS unsigned char*)(lds + L_LIST + j * 256 + (valid[0] ? idx : 0)); }
            past_tiles<1>(lds, rows, valid, sc, fr, fq);
        }
    }
    if (blk > 0) {
        __syncthreads();
#pragma unroll
        for (int qi = 0; qi < QI; ++qi) {
            const int row = 32 * w + 16 * qi + fr;
            const float inv = 1.0f / *(const LAS float*)(lds + L_L + row * 4);
            bf16_t* op = MIX + (rowb + q0 + 16 * qi + fr) * DM + 512 + h * 64 + 4 * fq;
#pragma unroll
            for (int dt = 0; dt < 4; ++dt) { const u32x2 ov = *(const LAS u32x2*)(lds + L_O + row * 128 + (16 * dt + 4 * fq) * 2);
                const f32x4 v = (f32x4){__uint_as_float(ov.x << 16), __uint_as_float(ov.x & 0xffff0000u), __uint_as_float(ov.y << 16), __uint_as_float(ov.y & 0xffff0000u)} * inv;
                u32x2 wv; wv.x = cvt_pk_bf16(v[0], v[1]); wv.y = cvt_pk_bf16(v[2], v[3]); *(u32x2*)(op + 16 * dt) = wv; }
        }
    }
}

__device__ __forceinline__ void xattn_unit(int qt, int hd, const bf16_t* XQ, const bf16_t* MEMKV, bf16_t* XO, LAS unsigned char* lds) {
    constexpr int HD = 256, QI = 1, TB = Stage<HD>::TILE_B;
    const int tid = threadIdx.x, lane = tid & 63, w = __builtin_amdgcn_readfirstlane(tid >> 6), fr = lane & 15, fq = lane >> 4;
    const int b = qt >> 5;
    const size_t qrow = (size_t)qt * 128 + 16 * w + fr;
    bf16x8 qf[QI][HD / 32];
#pragma unroll
    for (int dk = 0; dk < HD / 32; ++dk) qf[0][dk] = *(const bf16x8*)(XQ + qrow * DM + hd * 256 + 32 * dk + 8 * fq);
    float m[QI] = {-1e30f}, l[QI] = {0.f}; f32x4 o[QI][HD / 16]; int qloc[QI] = {0}; bool keep[QI] = {true};
#pragma unroll
    for (int dt = 0; dt < HD / 16; ++dt) o[0][dt] = (f32x4){0.f, 0.f, 0.f, 0.f};
    const float sc = 0.0625f * LOG2E;
    const bf16_t* Kh = MEMKV + (size_t)b * MEMLEN * 2048 + hd * 256; const bf16_t* Vh = Kh + 1024;
    Stage<HD> st;
    __syncthreads();
    stage_load<HD>(st, Kh, Vh, 2048, tid);
    stage_store<HD>(st, lds, tid);
    __syncthreads();
    for (int t = 0; t < 4; ++t) {
        if (t + 1 < 4) stage_load<HD>(st, Kh + (size_t)(64 * (t + 1)) * 2048, Vh + (size_t)(64 * (t + 1)) * 2048, 2048, tid);
        const LAS unsigned char* buf = lds + (t & 1) * 2 * TB;
        attn_tile<HD, QI>(buf, buf + TB, qf, m, l, o, sc, 0, qloc, 0, keep, fr, fq);
        if (t + 1 < 4) stage_store<HD>(st, lds + ((t + 1) & 1) * 2 * TB, tid);
        __syncthreads();
    }
    float ls = xsum32(xsum16(l[0]));
    const float inv = 1.0f / ls;
    bf16_t* op = XO + qrow * DM + hd * 256 + 4 * fq;
#pragma unroll
    for (int dt = 0; dt < HD / 16; ++dt) { const f32x4 v = o[0][dt] * inv; u32x2 wv; wv.x = cvt_pk_bf16(v[0], v[1]); wv.y = cvt_pk_bf16(v[2], v[3]); *(u32x2*)(op + 16 * dt) = wv; }
}

__device__ __forceinline__ void p0_transpose_item(const float* W, int K, int N, bf16_t* WT, int mode, LAS float* scr, int item, int lane, const float* ks = nullptr) {
    const int nblk = N / 32, kb = item / nblk, nb = item % nblk, k0 = 64 * kb, n0 = 32 * nb;
    float wv[32];
#pragma unroll
    for (int i = 0; i < 32; ++i) wv[i] = __builtin_nontemporal_load(&W[(size_t)(k0 + 2 * i + (lane >> 5)) * N + n0 + (lane & 31)]);
#pragma unroll
    for (int i = 0; i < 32; ++i) { const int kk = 2 * i + (lane >> 5); scr[kk * 33 + (lane & 31)] = ks ? wv[i] * ks[k0 + kk] : wv[i]; }
    asm volatile("s_waitcnt lgkmcnt(0)" ::: "memory");
    const int c = lane & 7;
#pragma unroll
    for (int j = 0; j < 4; ++j) { const int n = (lane >> 3) + 8 * j; const LAS float* s = scr + (8 * c) * 33 + n;
        u32x4 o; o.x = cvt_pk_bf16(s[0 * 33], s[1 * 33]); o.y = cvt_pk_bf16(s[2 * 33], s[3 * 33]); o.z = cvt_pk_bf16(s[4 * 33], s[5 * 33]); o.w = cvt_pk_bf16(s[6 * 33], s[7 * 33]);
        const int gn = n0 + n; const int row = (mode == 0) ? gn : (32 * (gn >> 4) + (gn & 15) + (mode == 2 ? 16 : 0));
        *(u32x4*)(WT + (size_t)row * K + k0 + 8 * c) = o; }
    asm volatile("s_waitcnt lgkmcnt(0)" ::: "memory");
}
__device__ __forceinline__ void cvt_rows_bf16(const float* src, bf16_t* dst, size_t n8, size_t gtid, size_t nthr) {
    size_t i = gtid;
    for (; i + 3 * nthr < n8; i += 4 * nthr) {
        f32x4 a[4], b[4];
#pragma unroll
        for (int q = 0; q < 4; ++q) { a[q] = __builtin_nontemporal_load((const f32x4*)(src + (i + q * nthr) * 8)); b[q] = __builtin_nontemporal_load((const f32x4*)(src + (i + q * nthr) * 8 + 4)); }
#pragma unroll
        for (int q = 0; q < 4; ++q) { u32x4 o; o.x = cvt_pk_bf16(a[q][0], a[q][1]); o.y = cvt_pk_bf16(a[q][2], a[q][3]); o.z = cvt_pk_bf16(b[q][0], b[q][1]); o.w = cvt_pk_bf16(b[q][2], b[q][3]); *(u32x4*)(dst + (i + q * nthr) * 8) = o; }
    }
    for (; i < n8; i += nthr) { const f32x4 a = *(const f32x4*)(src + i * 8), b = *(const f32x4*)(src + i * 8 + 4);
        u32x4 o; o.x = cvt_pk_bf16(a[0], a[1]); o.y = cvt_pk_bf16(a[2], a[3]); o.z = cvt_pk_bf16(b[0], b[1]); o.w = cvt_pk_bf16(b[2], b[3]); *(u32x4*)(dst + i * 8) = o; }
}
__device__ __forceinline__ void ln_row(const float* yrow, const float* g, const float* bta, float* hrow, bf16_t* brow, int lane) {
    f32x4 v[4]; float s = 0.f;
#pragma unroll
    for (int j = 0; j < 4; ++j) { v[j] = *((const f32x4*)yrow + lane + 64 * j); s += (v[j][0] + v[j][1]) + (v[j][2] + v[j][3]); }
    const float mean = wave_sum(s) * (1.f / DM); float s2 = 0.f;
#pragma unroll
    for (int j = 0; j < 4; ++j) { v[j] = v[j] - mean; s2 += (v[j][0] * v[j][0] + v[j][1] * v[j][1]) + (v[j][2] * v[j][2] + v[j][3] * v[j][3]); }
    const float rstd = 1.f / sqrtf(wave_sum(s2) * (1.f / DM) + LN_EPS);
#pragma unroll
    for (int j = 0; j < 4; ++j) { const f32x4 gg = *((const f32x4*)g + lane + 64 * j), bb = *((const f32x4*)bta + lane + 64 * j);
        const f32x4 r = v[j] * rstd * gg + bb; *((f32x4*)hrow + lane + 64 * j) = r;
        if (brow) { u32x2 wv; wv.x = cvt_pk_bf16(r[0], r[1]); wv.y = cvt_pk_bf16(r[2], r[3]); *((u32x2*)brow + lane + 64 * j) = wv; } }
}

__device__ __forceinline__ void ln_row_bf16in(const bf16_t* yrow, const float* g, const float* bta, float* orow, int lane) {
    f32x4 v[4]; float s = 0.f;
#pragma unroll
    for (int j = 0; j < 2; ++j) { const u32x4 rr = *((const u32x4*)yrow + lane + 64 * j);
        v[2 * j] = (f32x4){__uint_as_float(rr.x << 16), __uint_as_float(rr.x & 0xffff0000u), __uint_as_float(rr.y << 16), __uint_as_float(rr.y & 0xffff0000u)};
        v[2 * j + 1] = (f32x4){__uint_as_float(rr.z << 16), __uint_as_float(rr.z & 0xffff0000u), __uint_as_float(rr.w << 16), __uint_as_float(rr.w & 0xffff0000u)};
        s += ((v[2 * j][0] + v[2 * j][1]) + (v[2 * j][2] + v[2 * j][3])) + ((v[2 * j + 1][0] + v[2 * j + 1][1]) + (v[2 * j + 1][2] + v[2 * j + 1][3])); }
    const float mean = wave_sum(s) * (1.f / DM); float s2 = 0.f;
#pragma unroll
    for (int j = 0; j < 4; ++j) { v[j] = v[j] - mean; s2 += (v[j][0] * v[j][0] + v[j][1] * v[j][1]) + (v[j][2] * v[j][2] + v[j][3] * v[j][3]); }
    const float rstd = 1.f / sqrtf(wave_sum(s2) * (1.f / DM) + LN_EPS);
#pragma unroll
    for (int q = 0; q < 4; ++q) { const int ci = 512 * (q >> 1) + 8 * lane + 4 * (q & 1);
        const f32x4 gg = *(const f32x4*)(g + ci), bb = *(const f32x4*)(bta + ci);
        *(f32x4*)(orow + ci) = v[q] * rstd * gg + bb; }
}

__device__ __forceinline__ void ln_rows4_bf16in(const bf16_t* y, const float* g, const float* bta, float* o, int ld, int lane) {
    u32x4 rr[4][2];
#pragma unroll
    for (int q = 0; q < 4; ++q)
#pragma unroll
        for (int j = 0; j < 2; ++j) rr[q][j] = *((const u32x4*)(y + (size_t)q * ld) + lane + 64 * j);
    f32x4 gg[4], bb[4];
#pragma unroll
    for (int c4 = 0; c4 < 4; ++c4) { const int ci = 512 * (c4 >> 1) + 8 * lane + 4 * (c4 & 1); gg[c4] = *(const f32x4*)(g + ci); bb[c4] = *(const f32x4*)(bta + ci); }
#pragma unroll
    for (int q = 0; q < 4; ++q) {
        f32x4 v[4]; float s = 0.f;
#pragma unroll
        for (int j = 0; j < 2; ++j) { const u32x4 w = rr[q][j];
            v[2 * j] = (f32x4){__uint_as_float(w.x << 16), __uint_as_float(w.x & 0xffff0000u), __uint_as_float(w.y << 16), __uint_as_float(w.y & 0xffff0000u)};
            v[2 * j + 1] = (f32x4){__uint_as_float(w.z << 16), __uint_as_float(w.z & 0xffff0000u), __uint_as_float(w.w << 16), __uint_as_float(w.w & 0xffff0000u)}; }
#pragma unroll
        for (int c4 = 0; c4 < 4; ++c4) s += (v[c4][0] + v[c4][1]) + (v[c4][2] + v[c4][3]);
        const float mean = wave_sum(s) * (1.f / DM); float s2 = 0.f;
#pragma unroll
        for (int c4 = 0; c4 < 4; ++c4) { v[c4] = v[c4] - mean; s2 += (v[c4][0] * v[c4][0] + v[c4][1] * v[c4][1]) + (v[c4][2] * v[c4][2] + v[c4][3] * v[c4][3]); }
        const float rstd = 1.f / sqrtf(wave_sum(s2) * (1.f / DM) + LN_EPS);
#pragma unroll
        for (int c4 = 0; c4 < 4; ++c4) { const int ci = 512 * (c4 >> 1) + 8 * lane + 4 * (c4 & 1); *(f32x4*)(o + (size_t)q * ld + ci) = v[c4] * rstd * gg[c4] + bb[c4]; }
    }
}

#define XB_TMO      128
#define XB_XCNT(j)  (256  + 64 * (j))
#define XB_XSUB(j)  (1280 + 64 * (j))
#define XB_XGEN(j)  (2304 + 64 * (j))
#define XB_TOP      3328
#define XB_TOPGEN   3392
#define XCD_BAR_WORDS 3456
#define XB_SPIN_CAP (1u << 20)
__device__ __forceinline__ unsigned xb_ld(unsigned* p)              { return __hip_atomic_load(p, __ATOMIC_RELAXED, __HIP_MEMORY_SCOPE_AGENT); }
__device__ __forceinline__ unsigned xb_add(unsigned* p, unsigned v) { return __hip_atomic_fetch_add(p, v, __ATOMIC_RELAXED, __HIP_MEMORY_SCOPE_AGENT); }
__device__ __forceinline__ unsigned xb_xcc_id() { return (unsigned)__builtin_amdgcn_s_getreg((3 << 11) | 20) & 0xFu; }
#define XB_SPIN(cond, bar) do { unsigned _sp = 0; while (cond) { __builtin_amdgcn_s_sleep(1); \
    if ((++_sp & 255u) == 0u) { if (xb_ld(&(bar)[XB_TMO])) break; if (_sp > XB_SPIN_CAP) { atomicAdd(&(bar)[XB_TMO], 1u); break; } } } } while (0)
struct XcdBarrier { unsigned* bar; unsigned x; volatile LAS unsigned* st; };
__device__ __forceinline__ XcdBarrier xcd_barrier_post(unsigned* bar, volatile LAS unsigned* st) {
    XcdBarrier b; b.bar = bar; b.x = xb_xcc_id(); b.st = st;
    if (threadIdx.x == 0) (void)xb_add(&bar[XB_XCNT(b.x)], 1u);
    return b;
}
__device__ __forceinline__ void xcd_barrier_complete(unsigned* bar, unsigned x, unsigned& nloc, unsigned& nx) {
    const unsigned G = gridDim.x * gridDim.y * gridDim.z;
    unsigned sum, cnt, mine, sp = 0u;
    for (;;) {
        sum = 0u; cnt = 0u; mine = 0u;
#pragma unroll
        for (unsigned j = 0; j < 16; ++j) { const unsigned c = xb_ld(&bar[XB_XCNT(j)]); sum += c; cnt += (c > 0u) ? 1u : 0u; mine = (j == x) ? c : mine; }
        if (sum == G) break;
        __builtin_amdgcn_s_sleep(1);
        if ((++sp & 255u) == 0u) { if (xb_ld(&bar[XB_TMO])) break; if (sp > XB_SPIN_CAP) { atomicAdd(&bar[XB_TMO], 1u); break; } }
    }
    nloc = mine > 0u ? mine : 1u; nx = cnt > 0u ? cnt : 1u;
}
__device__ __forceinline__ void xcd_barrier(const XcdBarrier& b) {
    asm volatile("s_waitcnt vmcnt(0)" ::: "memory");
    __syncthreads();
    if (threadIdx.x == 0) {
        unsigned* bar = b.bar;
        __builtin_amdgcn_s_waitcnt(0);
        unsigned nloc = b.st[0], nx = b.st[1];
        if (nloc == 0u) { xcd_barrier_complete(bar, b.x, nloc, nx); b.st[0] = nloc; b.st[1] = nx; }
        const unsigned old = xb_add(&bar[XB_XSUB(b.x)], 1u);
        const unsigned gen = old / nloc;
        if (old + 1u == (gen + 1u) * nloc) {
            __builtin_amdgcn_fence(__ATOMIC_RELEASE, "agent");
            asm volatile("s_waitcnt vmcnt(0)" ::: "memory");
            const unsigned og = xb_add(&bar[XB_TOP], 1u);
            const unsigned tg = og / nx;
            if (og + 1u == (tg + 1u) * nx) xb_add(&bar[XB_TOPGEN], 1u);
            else XB_SPIN(xb_ld(&bar[XB_TOPGEN]) == tg, bar);
            __builtin_amdgcn_fence(__ATOMIC_ACQUIRE, "agent");
            xb_add(&bar[XB_XGEN(b.x)], 1u);
            asm volatile("s_waitcnt vmcnt(0)" ::: "memory");
        } else {
            XB_SPIN(xb_ld(&bar[XB_XGEN(b.x)]) == gen, bar);
            __builtin_amdgcn_fence(__ATOMIC_ACQUIRE, "agent");
            asm volatile("s_waitcnt vmcnt(0)" ::: "memory");
        }
    }
    __syncthreads();
}

#ifndef PROBE_PHASE
#define PROBE_PHASE -1
#endif
constexpr int LDS_BYTES = 159744;
constexpr int LDS_MISC = 159744 - 256;
struct Args { const float* in[18]; float* out; unsigned char* ws; int ph_lo, ph_hi; };
enum { I_X = 0, I_MEM, I_WIN, I_WPOOL, I_PSCALE, I_WOUT, I_LN1G, I_LN1B, I_WXQ, I_WXKV, I_WXO, I_LN2G, I_LN2B, I_WGATE, I_WUP, I_WDOWN, I_LN3G, I_LN3B };
constexpr int N_PHASES = 13;

struct Ctx {
    const float* const* in; LAS unsigned char* lds; unsigned char* ws; float* H;
    int tid, lane, wave, G, bx, vcu, gw, NGW;
};
#define WSP(T, off) ((T*)(c.ws + (off)))

template <int PH> __device__ __forceinline__ void run_phase(const Ctx& c) {
    const int lane = c.lane, wave = c.wave, G = c.G, bx = c.bx, vcu = c.vcu, gw = c.gw, NGW = c.NGW, tid = c.tid;
    LAS unsigned char* lds = c.lds;
    float* KM = WSP(float, WS_KM);
    bf16_t* Win_t = WSP(bf16_t, WS_WIN); bf16_t* Wout_t = WSP(bf16_t, WS_WOUT); bf16_t* Wxq_t = WSP(bf16_t, WS_WXQ); bf16_t* Wxkv_t = WSP(bf16_t, WS_WXKV);
    bf16_t* Wxo_t = WSP(bf16_t, WS_WXO); bf16_t* Wgu_t = WSP(bf16_t, WS_WGU); bf16_t* Wdn_t = WSP(bf16_t, WS_WDN); bf16_t* Wpool_t = WSP(bf16_t, WS_WPOOL);
    bf16_t* MEMB = WSP(bf16_t, WS_MEMB); bf16_t* MEMKV = WSP(bf16_t, WS_MEMKV);
    bf16_t* XB = WSP(bf16_t, WS_XB); bf16_t* Z = WSP(bf16_t, WS_Z); bf16_t* MIX = WSP(bf16_t, WS_MIX); bf16_t* HF = WSP(bf16_t, WS_HF);
    bf16_t* XQ = MIX; bf16_t* XO = Z;
    float* H = c.H; float* PST1 = WSP(float, WS_PST1); float* PST2 = WSP(float, WS_PST2);
    if constexpr (PH == 0) {
        if (bx < 208) {
            const float* W; int N, n0, mode; const float* gg; const float* bb; float* cd; int cdn;
            if (bx < 32) { W = c.in[I_WXQ]; N = DM; n0 = 32 * bx; mode = 0; gg = c.in[I_LN1G]; bb = c.in[I_LN1B]; cd = WSP(float, WS_CDX); cdn = DM; }
            else if (bx < 120) { W = c.in[I_WGATE]; N = DFF; n0 = 32 * (bx - 32); mode = 1; gg = c.in[I_LN2G]; bb = c.in[I_LN2B]; cd = WSP(float, WS_CDG); cdn = 2 * DFF; }
            else { W = c.in[I_WUP]; N = DFF; n0 = 32 * (bx - 120); mode = 2; gg = c.in[I_LN2G]; bb = c.in[I_LN2B]; cd = WSP(float, WS_CDG); cdn = 2 * DFF; }
            const int col = n0 + (lane & 31), kbeg = wave * 128 + (lane >> 5) * 64;
            float cs = 0.f, ds = 0.f;
#pragma unroll 8
            for (int k = kbeg; k < kbeg + 64; ++k) { const float wv = W[(size_t)k * N + col]; cs += gg[k] * wv; ds += bb[k] * wv; }
            cs += __shfl_xor(cs, 32); ds += __shfl_xor(ds, 32);
            LAS float* red = (LAS float*)(lds + 131072);
            if (lane < 32) { red[(wave * 32 + lane) * 2] = cs; red[(wave * 32 + lane) * 2 + 1] = ds; }
            __syncthreads();
            if (tid < 32) { float ct = 0.f, dt = 0.f;
#pragma unroll
                for (int w8 = 0; w8 < 8; ++w8) { ct += red[(w8 * 32 + tid) * 2]; dt += red[(w8 * 32 + tid) * 2 + 1]; }
                const int oi = (mode == 0) ? col : (32 * (col >> 4) + (col & 15) + (mode == 2 ? 16 : 0));
                cd[oi] = ct; cd[cdn + oi] = dt; }
        }
        LAS float* scr = (LAS float*)(lds + wave * 16384);
        constexpr int I_IN = (DM / 64) * (INW / 32), I_SQ = (DM / 64) * (DM / 32), I_KV = (DM / 64) * (2048 / 32), I_GU = (DM / 64) * (DFF / 32), I_DN = (DFF / 64) * (DM / 32), I_PL = 2 * 4;
        constexpr int NITEMS = I_IN + 3 * I_SQ + I_KV + 2 * I_GU + I_DN + 4 * I_PL;
        for (int it = gw; it < NITEMS; it += NGW) {
            int r = it;
            if (r < I_IN) { p0_transpose_item(c.in[I_WIN], DM, INW, Win_t, 0, scr, r, lane); continue; } r -= I_IN;
            if (r < I_SQ) { if (r >= 8 * (DM / 32)) p0_transpose_item(c.in[I_WOUT], DM, DM, Wout_t, 0, scr, r, lane); continue; } r -= I_SQ;
            if (r < I_SQ) { continue; } r -= I_SQ;
            if (r < I_SQ) { p0_transpose_item(c.in[I_WXO], DM, DM, Wxo_t, 0, scr, r, lane); continue; } r -= I_SQ;
            if (r < I_KV) { p0_transpose_item(c.in[I_WXKV], DM, 2048, Wxkv_t, 0, scr, r, lane); continue; } r -= I_KV;
            if (r < I_GU) { p0_transpose_item(c.in[I_WGATE], DM, DFF, Wgu_t, 1, scr, r, lane, c.in[I_LN2G]); continue; } r -= I_GU;
            if (r < I_GU) { p0_transpose_item(c.in[I_WUP], DM, DFF, Wgu_t, 2, scr, r, lane, c.in[I_LN2G]); continue; } r -= I_GU;
            if (r < I_DN) { p0_transpose_item(c.in[I_WDOWN], DFF, DM, Wdn_t, 0, scr, r, lane); continue; } r -= I_DN;
            { const int gidx = r / I_PL; p0_transpose_item(c.in[I_WPOOL] + gidx * 16384, 128, 128, Wpool_t + gidx * 16384, 0, scr, r % I_PL, lane); }
        }
        const size_t gtid = (size_t)vcu * 512 + tid, nthr = (size_t)G * 512;
        for (size_t idx = gtid; idx < (size_t)512 * DM; idx += nthr) {
            const int n = (int)(idx & (DM - 1)), k = (int)(idx >> 10), gidx = k >> 7;
            const float* wp = c.in[I_WPOOL] + (size_t)k * 128;
            const float* ps = c.in[I_PSCALE] + gidx * 128;
            const float* wo = c.in[I_WOUT] + (size_t)(gidx * 128) * DM + n;
            float a = 0.f;
#pragma unroll 8
            for (int d = 0; d < 128; ++d) a += wp[d] * ps[d] * wo[(size_t)d * DM];
            const unsigned pk = cvt_pk_bf16(a, 0.f);
            Wout_t[(size_t)n * DM + k] = (bf16_t)(pk & 0xffffu);
        }
        for (size_t i8 = gtid; i8 < (size_t)DM * DM / 8; i8 += nthr) {
            const float gsc = c.in[I_LN1G][(i8 * 8) >> 10]; const f32x4 a = *(const f32x4*)(c.in[I_WXQ] + i8 * 8) * gsc, b4 = *(const f32x4*)(c.in[I_WXQ] + i8 * 8 + 4) * gsc;
            u32x4 o; o.x = cvt_pk_bf16(a[0], a[1]); o.y = cvt_pk_bf16(a[2], a[3]); o.z = cvt_pk_bf16(b4[0], b4[1]); o.w = cvt_pk_bf16(b4[2], b4[3]); *(u32x4*)(Wxq_t + i8 * 8) = o; }
        for (size_t i4 = gtid; i4 < (size_t)BATCH * 8 * NBLK * 64 / 4; i4 += nthr) *((f32x4*)KM + i4) = (f32x4){0.f, 0.f, 0.f, 0.f};
        cvt_rows_bf16(c.in[I_X], XB, (size_t)TOK * DM / 8, gtid, nthr);
        cvt_rows_bf16(c.in[I_MEM], MEMB, (size_t)MEMROWS * DM / 8, gtid, nthr);
    }
    if constexpr (PH == 1) {
        { pg8::Gemm g{XB, Win_t, TOK, INW, DM}; pg8::StaticOrder S; S.init(TOK, INW, G, bx); pg8::EpiBf16 E{Z, INW, KM}; pg8::gemm_phase(lds, g, S, E); }
        { pg8::Gemm g{MEMB, Wxkv_t, MEMROWS, 2048, DM}; pg8::StaticOrder S; S.init(MEMROWS, 2048, G, bx); pg8::EpiBf16 E{MEMKV, 2048}; pg8::gemm_phase(lds, g, S, E); }
    }
    if constexpr (PH == 2) {
        for (int run = gw; run < TOK / 32; run += NGW) {
            const int wdw = 2 << (lane >> 4);
            const size_t t0 = (size_t)run * 32; const int tpos0 = (int)(t0 & (SEQ - 1));
            const bf16_t* up = Z + t0 * INW + lane * 8;
            bf16_t* op = MIX + t0 * DM + lane * 8;
            float sacc[8] = {0.f, 0.f, 0.f, 0.f, 0.f, 0.f, 0.f, 0.f};
#pragma unroll 1
            for (int ib = 1; ib <= 16; ib += 8) { bf16x8 ui[8]; bool ok[8];
#pragma unroll
                for (int q = 0; q < 8; ++q) { const int i = ib + q; ok[q] = (i <= wdw && tpos0 - i >= 0); ui[q] = *(const bf16x8*)(up - (size_t)(ok[q] ? i : 0) * INW); }
#pragma unroll
                for (int q = 0; q < 8; ++q) if (ok[q]) {
#pragma unroll
                    for (int e8 = 0; e8 < 8; ++e8) sacc[e8] += bf2f((unsigned short)ui[q][e8]); } }
#pragma unroll 1
            for (int tb = 0; tb < 32; tb += 8) {
                bf16x8 un[8], uo[8];
#pragma unroll
                for (int i = 0; i < 8; ++i) { un[i] = *(const bf16x8*)(up + (size_t)(tb + i) * INW);
                    const int told = tpos0 + tb + i - wdw; uo[i] = *(const bf16x8*)(up + (size_t)(tb + i - (told >= 0 ? wdw : 0)) * INW); }
#pragma unroll
                for (int i = 0; i < 8; ++i) { const int tpos = tpos0 + tb + i; const bool sub = tpos - wdw >= 0;
                    const float rc = 1.0f / (float)((tpos + 1 < wdw) ? tpos + 1 : wdw); float p[8];
#pragma unroll
                    for (int e8 = 0; e8 < 8; ++e8) { const float uv = bf2f((unsigned short)un[i][e8]); sacc[e8] += uv; if (sub) sacc[e8] -= bf2f((unsigned short)uo[i][e8]); p[e8] = sacc[e8] * rc - uv; }
                    u32x4 pw; pw.x = cvt_pk_bf16(p[0], p[1]); pw.y = cvt_pk_bf16(p[2], p[3]); pw.z = cvt_pk_bf16(p[4], p[5]); pw.w = cvt_pk_bf16(p[6], p[7]);
                    *(u32x4*)(op + (size_t)(tb + i) * DM) = pw; }
            }
        }
    }
    if constexpr (PH == 2) {
        bf16_t* BtM = WSP(bf16_t, WS_BTM); bf16_t* BtN = WSP(bf16_t, WS_BTN); float* CB = WSP(float, WS_CDB); float* DB = CB + 16 * 1024;
        { pg8::Gemm g{MEMKV, Wxq_t, 64 * 256, 1024, 256, 2048, 1024, 2}; pg8::StaticOrder S; S.init(64 * 256, 1024, G, bx); pg8::EpiPrep E{BtM, 0.0625f, 0}; pg8::gemm_phase(lds, g, S, E); }
        { pg8::Gemm g{Wxo_t, MEMKV + 1024, 64 * 256, 1024, 256, 1024, 2048, 3}; pg8::StaticOrder S; S.init(64 * 256, 1024, G, bx); pg8::EpiPrep E{BtN, 1.0f, 1}; pg8::gemm_phase(lds, g, S, E); }
        const float* cx = WSP(float, WS_CDX); const float* dx = cx + DM;
        for (int o8 = vcu * 512 + tid; o8 < 16 * 1024 * 8; o8 += G * 512) {
            const int o = o8 >> 3, part = o8 & 7;
            const int bt = o >> 10, hm = o & 1023, hh = hm >> 8, mm = hm & 255;
            const bf16_t* kr = MEMKV + (size_t)(bt * 256 + mm) * 2048 + hh * 256; float ca = 0.f, da = 0.f;
#pragma unroll
            for (int it = 0; it < 4; ++it) { const int d8 = part + 8 * it; const bf16x8 kv = *(const bf16x8*)(kr + d8 * 8);
                const f32x4 c0 = *(const f32x4*)(cx + hh * 256 + d8 * 8), c1 = *(const f32x4*)(cx + hh * 256 + d8 * 8 + 4), d0 = *(const f32x4*)(dx + hh * 256 + d8 * 8), d1 = *(const f32x4*)(dx + hh * 256 + d8 * 8 + 4);
#pragma unroll
                for (int e8 = 0; e8 < 8; ++e8) { const float kf = bf2f((unsigned short)kv[e8]); ca += (e8 < 4 ? c0[e8 & 3] : c1[e8 & 3]) * kf; da += (e8 < 4 ? d0[e8 & 3] : d1[e8 & 3]) * kf; } }
            ca += __shfl_xor(ca, 1); ca += __shfl_xor(ca, 2); ca += __shfl_xor(ca, 4); da += __shfl_xor(da, 1); da += __shfl_xor(da, 2); da += __shfl_xor(da, 4);
            if (part == 0) { CB[o] = ca * 0.0625f; DB[o] = da * 0.0625f; }
        }
    }
    if constexpr (PH == 3) {
        for (int it = 0; it * G < BATCH * 8 * NBLK; ++it) {
            const int u = it * G + vcu; if (u >= BATCH * 8 * NBLK) break;
            int bh = u >> 4, blk = u & 15;
            if (G == 256) { bh = it * 16 + (vcu >> 4); blk = ((vcu & 15) + 2 * it) & 15; }
            moba_unit(bh >> 3, bh & 7, blk, Z, KM, MIX, lds);
        }
    }
    if constexpr (PH == 4) { pg8::Gemm g{MIX, Wout_t, TOK, DM, DM}; pg8::StaticOrder S; S.init(TOK, DM, G, bx); pg8::EpiResStat<false, true> E{XB, XB, DM, ALPHA, nullptr, nullptr, nullptr, PST1}; pg8::gemm_phase(lds, g, S, E); }
    if constexpr (PH == 5) { }
    if constexpr (PH == 6) { pg8::Gemm g{XB, WSP(bf16_t, WS_BTM), TOK, DM, DM, 0, 0, 1, (size_t)DM * DM * 2}; pg8::StaticOrder S; S.init(TOK, DM, G, bx); pg8::EpiSoftmaxP E{XQ, PST1, WSP(float, WS_CDB), WSP(float, WS_CDB) + 16 * 1024, (LAS float*)(lds + 131072)}; pg8::gemm_phase(lds, g, S, E); }
    if constexpr (PH == 7) { for (int u = vcu; u < (TOK / 128) * 4; u += G) xattn_unit(u >> 2, u & 3, XQ, MEMKV, XO, lds); }
    if constexpr (PH == 8) { pg8::Gemm g{XQ, WSP(bf16_t, WS_BTN), TOK, DM, DM, 0, 0, 1, (size_t)DM * DM * 2}; pg8::StaticOrder S; S.init(TOK, DM, G, bx); pg8::EpiResStat<true, true> E{XB, XB, DM, ALPHA, PST1, c.in[I_LN1G], c.in[I_LN1B], PST2}; pg8::gemm_phase(lds, g, S, E); }
    if constexpr (PH == 9) { }
    if constexpr (PH == 10) { pg8::Gemm g{XB, Wgu_t, TOK, 2 * DFF, DM}; pg8::StaticOrder S; S.init(TOK, 2 * DFF, G, bx); pg8::EpiLnSwiGLU E{HF, DFF, PST2, WSP(float, WS_CDG), WSP(float, WS_CDG) + 2 * DFF}; pg8::gemm_phase(lds, g, S, E); }
    if constexpr (PH == 11) { pg8::Gemm g{HF, Wdn_t, TOK, DM, DFF}; pg8::StaticOrder S; S.init(TOK, DM, G, bx, 1); pg8::EpiResStat<true, false> E{XB, XB, DM, ALPHA, PST2, c.in[I_LN2G], c.in[I_LN2B], nullptr}; pg8::gemm_phase(lds, g, S, E); }
    if constexpr (PH == 12) { for (int r = gw * 4; r < TOK; r += NGW * 4) ln_rows4_bf16in(XB + (size_t)r * DM, c.in[I_LN3G], c.in[I_LN3B], H + (size_t)r * DM, DM, lane); }
}

__global__ void __launch_bounds__(512, 2) fwd_kernel(Args args) {
    extern __shared__ __attribute__((aligned(16))) unsigned char lds_raw[];
    Ctx c;
    c.in = args.in; c.lds = (LAS unsigned char*)lds_raw; c.ws = args.ws; c.H = args.out;
    c.tid = threadIdx.x; c.lane = c.tid & 63; c.wave = __builtin_amdgcn_readfirstlane(c.tid >> 6);
    c.G = gridDim.x; c.bx = blockIdx.x;
    c.vcu = (c.G % 8 == 0) ? (c.bx % 8) * (c.G / 8) + c.bx / 8 : c.bx;
    c.gw = c.vcu * 8 + c.wave; c.NGW = c.G * 8;
    const int lo = args.ph_lo, hi = args.ph_hi;
    volatile LAS unsigned* MISC = (volatile LAS unsigned*)(c.lds + LDS_MISC);
    if (c.tid < 2) MISC[c.tid] = 0u;
    __syncthreads();
    XcdBarrier bar; bar.bar = (unsigned*)(args.ws + WS_CTL); bar.x = 0; bar.st = MISC;
    if (hi - lo > 1) bar = xcd_barrier_post((unsigned*)(args.ws + WS_CTL), MISC);
    if (hi < 0) cg::this_grid().sync();
#define IN(k) (lo <= (k) && (k) < hi)
#define PHASE(k) do { if (IN(k)) { run_phase<k>(c); if (PROBE_PHASE == (k)) { xcd_barrier(bar); run_phase<k>(c); } } \
        if (IN(k) && IN((k) + 1)) { xcd_barrier(bar); } } while (0)
    PHASE(0); PHASE(1);
    if (IN(3)) run_phase<3>(c);
    __syncthreads();
    if (IN(2)) run_phase<2>(c);
    if (IN(3) && IN(4)) xcd_barrier(bar);
    PHASE(4); PHASE(6); PHASE(8); PHASE(10); PHASE(11); PHASE(12);
#undef IN
#undef PHASE
}

extern "C" void kernel_launch(void* const* d_in, const int* in_sizes, int n_in, void* d_out, int out_size, void* d_ws, size_t ws_size, hipStream_t stream) {
    static int grid = 0;
    if (grid == 0) {
        if (n_in != 18 || out_size != TOK * DM || ws_size < WS_END) { fprintf(stderr, "kernel_launch: unexpected shapes (n_in %d, out %d, ws %zu)\n", n_in, out_size, ws_size); grid = -1; return; }
        int dev = 0, cus = 0, per_cu = 0;
        (void)hipGetDevice(&dev); (void)hipDeviceGetAttribute(&cus, hipDeviceAttributeMultiprocessorCount, dev);
        if (hipFuncSetAttribute((const void*)fwd_kernel, hipFuncAttributeMaxDynamicSharedMemorySize, LDS_BYTES) != hipSuccess) { fprintf(stderr, "kernel_launch: hipFuncSetAttribute failed\n"); grid = -1; return; }
        if (hipOccupancyMaxActiveBlocksPerMultiprocessor(&per_cu, (const void*)fwd_kernel, 512, LDS_BYTES) != hipSuccess || per_cu < 1) { fprintf(stderr, "kernel_launch: occupancy query says %d\n", per_cu); per_cu = 1; }
        (void)hipGetLastError();
        grid = cus * 1;
        if (grid <= 0) grid = 256;
    }
    if (grid < 0) return;
    Args a{};
    for (int i = 0; i < 18; ++i) a.in[i] = (const float*)d_in[i];
    a.out = (float*)d_out; a.ws = (unsigned char*)d_ws;
#if N_LAUNCH_MODE == 1
    for (int p = 0; p < N_PHASES; ++p) { a.ph_lo = p; a.ph_hi = p + 1; hipLaunchKernelGGL(fwd_kernel, dim3(grid), dim3(512), LDS_BYTES, stream, a); }
#else
    a.ph_lo = 0; a.ph_hi = N_PHASES;
    (void)hipMemsetAsync((unsigned char*)d_ws + WS_CTL, 0, CTL_BYTES, stream);
    void* kargs[] = {&a};
    hipError_t e = hipLaunchCooperativeKernel((const void*)fwd_kernel, dim3(grid), dim3(512), kargs, LDS_BYTES, stream);
    if (e != hipSuccess) fprintf(stderr, "kernel_launch: cooperative launch failed: %s (grid %d)\n", hipGetErrorString(e), grid);
#endif
}
```
